# Optimizing an MI355X kernel written in HIP

```python
import math
import jax, jax.numpy as jnp
from jax import lax
import numpy as np

D_MODEL = 1024
BATCH = 16
SEQ = 4096
DEPTH = 4

N_EVEN = (DEPTH + 1) // 2
N_ODD = DEPTH // 2

DN_ALPHA = (2.0 * DEPTH) ** 0.25
DN_BETA = (8.0 * DEPTH) ** -0.25
LN_EPS = 1e-5

MIX_WIDTH_A = D_MODEL // 2
MIX_WIDTH_B = D_MODEL // 2
CHUNK = 128
GM_GROUPS = 4
GM_GROUP_DIM = MIX_WIDTH_A // GM_GROUPS
DA_HEADS = 4
DA_HEAD_DIM = MIX_WIDTH_B // DA_HEADS // 2
DA_V_DIM = 2 * DA_HEAD_DIM
Q_BLOCK = 128
EVEN_IN = 2 * MIX_WIDTH_A + 3 * MIX_WIDTH_B

RET_HEADS = 4
RET_QK_DIM = D_MODEL // RET_HEADS
RET_V_DIM = 2 * D_MODEL // RET_HEADS
RET_CHUNK = 128
ODD_IN = 2 * D_MODEL + 4 * D_MODEL

D_FF = 7 * D_MODEL // 2
N_EXPERTS = 8
TOP_K = 2

kernel_name = 'hybrid_gmlp_diffattn_retention_moe_deepnorm'

F32 = jnp.float32


def layer_norm(x, g, b):
    xf = x.astype(F32)
    mu = jnp.mean(xf, axis=-1, keepdims=True)
    var = jnp.mean(jnp.square(xf - mu), axis=-1, keepdims=True)
    return ((xf - mu) * lax.rsqrt(var + LN_EPS) * g + b).astype(x.dtype)


def swiglu(x, w1, w3, w2):
    return (jax.nn.silu(x @ w1) * (x @ w3)) @ w2


def chunked_spatial_gating(u, v, w_s, b_s, ln_g, ln_b):
    bsz, s, _ = u.shape
    nc = s // CHUNK
    v = v.reshape(bsz, nc, CHUNK, GM_GROUPS, GM_GROUP_DIM)
    v = layer_norm(v, ln_g, ln_b)
    causal = jnp.tril(jnp.ones((CHUNK, CHUNK), dtype=bool))
    w = jnp.where(causal, w_s, jnp.zeros_like(w_s))
    mixed = jnp.einsum('gts,bcsgd->bctgd', w, v) + b_s.T[None, None, :, :, None]
    return u * mixed.reshape(bsz, s, MIX_WIDTH_A)


def diff_attention(q, k, v, lam_q1, lam_k1, lam_q2, lam_k2, subln_g, layer_idx):
    bsz, s = q.shape[0], q.shape[1]
    lam_init = 0.8 - 0.6 * math.exp(-0.3 * layer_idx)
    lam = (jnp.exp(jnp.sum(lam_q1.astype(F32) * lam_k1.astype(F32)))
           - jnp.exp(jnp.sum(lam_q2.astype(F32) * lam_k2.astype(F32))) + lam_init)
    slopes = 2.0 ** (-8.0 * jnp.arange(1, DA_HEADS + 1, dtype=F32) / DA_HEADS)
    scale = DA_HEAD_DIM ** -0.5
    nb = s // Q_BLOCK
    qb = q.reshape(bsz, nb, Q_BLOCK, DA_HEADS, 2, DA_HEAD_DIM).transpose(1, 0, 2, 3, 4, 5)
    kpos = jnp.arange(s)
    vf = v.astype(F32)

    def block(args):
        i, qi = args
        qpos = i * Q_BLOCK + jnp.arange(Q_BLOCK)
        dist = (qpos[:, None] - kpos[None, :]).astype(F32)
        bias = -slopes[:, None, None] * dist
        scores = jnp.einsum('bqhcd,bkhcd->cbhqk', qi, k, preferred_element_type=F32) * scale + bias
        scores = jnp.where(dist >= 0, scores, -jnp.inf)
        p = jax.nn.softmax(scores, axis=-1)
        attn = p[0] - lam * p[1]
        return jnp.einsum('bhqk,bkhe->bqhe', attn, vf)

    o = lax.map(block, (jnp.arange(nb), qb))
    o = o.transpose(1, 0, 2, 3, 4).reshape(bsz, s, DA_HEADS, DA_V_DIM)
    o = o * lax.rsqrt(jnp.mean(jnp.square(o), axis=-1, keepdims=True) + LN_EPS) * subln_g.astype(F32)
    o = o * (1.0 - lam_init)
    return o.reshape(bsz, s, MIX_WIDTH_B).astype(v.dtype)


def retention(q, k, v):
    bsz, s = q.shape[0], q.shape[1]
    nc = s // RET_CHUNK
    log_g = jnp.log1p(-(2.0 ** (-5.0 - jnp.arange(RET_HEADS, dtype=F32))))
    idx = jnp.arange(RET_CHUNK, dtype=F32)
    rel = idx[:, None] - idx[None, :]
    inner_decay = jnp.where(rel >= 0, jnp.exp(log_g[:, None, None] * jnp.maximum(rel, 0.0)), 0.0)
    q_decay = jnp.exp(log_g[None, :] * (idx[:, None] + 1.0))
    k_decay = jnp.exp(log_g[None, :] * (RET_CHUNK - 1.0 - idx[:, None]))
    chunk_decay = jnp.exp(log_g * RET_CHUNK)

    def to_chunks(t):
        return t.reshape(bsz, nc, RET_CHUNK, RET_HEADS, t.shape[-1]).transpose(1, 0, 2, 3, 4)

    def step(state, xs):
        qc, kc, vc = xs
        scores = jnp.einsum('bqhd,bkhd->bhqk', qc, kc) * inner_decay
        inner = jnp.einsum('bhqk,bkhe->bqhe', scores, vc)
        cross = jnp.einsum('bqhd,bhde->bqhe', qc, state) * q_decay[None, :, :, None]
        new_state = (state * chunk_decay[None, :, None, None]
                     + jnp.einsum('bkhd,bkhe->bhde', kc * k_decay[None, :, :, None], vc))
        return new_state, inner + cross

    state0 = jnp.zeros((bsz, RET_HEADS, RET_QK_DIM, RET_V_DIM), F32)
    _, o = lax.scan(step, state0, (to_chunks(q), to_chunks(k), to_chunks(v)))
    return o.transpose(1, 0, 2, 3, 4).reshape(bsz, s, RET_HEADS, RET_V_DIM)


def even_mixer(x, w_in, w_s, b_s, v_ln_g, v_ln_b, lam_q1, lam_k1, lam_q2, lam_k2, subln_g, w_o, layer_idx):
    bsz, s, _ = x.shape
    h = x @ w_in
    a = MIX_WIDTH_A
    bw = MIX_WIDTH_B
    u, v, q, k, va = jnp.split(h, [a, 2 * a, 2 * a + bw, 2 * a + 2 * bw], axis=-1)
    a_out = chunked_spatial_gating(jax.nn.gelu(u, approximate=False), jax.nn.gelu(v, approximate=False),
                                   w_s, b_s, v_ln_g, v_ln_b)
    q = q.reshape(bsz, s, DA_HEADS, 2, DA_HEAD_DIM)
    k = k.reshape(bsz, s, DA_HEADS, 2, DA_HEAD_DIM)
    va = va.reshape(bsz, s, DA_HEADS, DA_V_DIM)
    b_out = diff_attention(q, k, va, lam_q1, lam_k1, lam_q2, lam_k2, subln_g, layer_idx)
    return jnp.concatenate([a_out, b_out], axis=-1) @ w_o


def odd_mixer(x, w_in, gn_g, w_o):
    bsz, s, _ = x.shape
    h = x @ w_in
    q, k, v, g = jnp.split(h, [D_MODEL, 2 * D_MODEL, 4 * D_MODEL], axis=-1)
    q = q.reshape(bsz, s, RET_HEADS, RET_QK_DIM).astype(F32)
    k = k.reshape(bsz, s, RET_HEADS, RET_QK_DIM).astype(F32) * (RET_QK_DIM ** -0.5)
    v = v.reshape(bsz, s, RET_HEADS, RET_V_DIM).astype(F32)
    o = retention(q, k, v)
    mu = jnp.mean(o, axis=-1, keepdims=True)
    var = jnp.mean(jnp.square(o - mu), axis=-1, keepdims=True)
    o = (o - mu) * lax.rsqrt(var + LN_EPS) * gn_g.astype(F32)
    o = jax.nn.silu(g) * o.reshape(bsz, s, 2 * D_MODEL).astype(x.dtype)
    return o @ w_o


def moe_swiglu(x, w_router, b_router, w1, w3, w2):
    bsz, s, d = x.shape
    xt = x.reshape(-1, d)
    logits = (xt @ w_router).astype(F32) + b_router.astype(F32)
    top_val, top_idx = lax.top_k(logits, TOP_K)
    top_w = jax.nn.softmax(top_val, axis=-1)
    gates = jnp.sum(jax.nn.one_hot(top_idx, N_EXPERTS, dtype=F32) * top_w[..., None], axis=1)
    y = jnp.zeros(xt.shape, F32)
    for e in range(N_EXPERTS):
        y = y + gates[:, e:e + 1] * swiglu(xt, w1[e], w3[e], w2[e])
    return y.astype(x.dtype).reshape(bsz, s, d)


def setup_inputs(seed: int = 0) -> dict:
    key = jax.random.key(seed)
    ks = jax.random.split(key, 32)
    d = D_MODEL

    def nrm(k, shape, scale):
        return jax.random.normal(k, shape, F32) * scale

    def gain(k, shape):
        return 1.0 + 0.05 * jax.random.normal(k, shape, F32)

    return {
        'x': jax.random.normal(ks[0], (BATCH, SEQ, d), F32),
        'even_w_in': nrm(ks[1], (N_EVEN, d, EVEN_IN), d ** -0.5),
        'even_w_s': nrm(ks[2], (N_EVEN, GM_GROUPS, CHUNK, CHUNK), 0.5 * CHUNK ** -0.5),
        'even_b_s': gain(ks[3], (N_EVEN, GM_GROUPS, CHUNK)),
        'even_v_ln_g': gain(ks[4], (N_EVEN, GM_GROUPS, GM_GROUP_DIM)),
        'even_v_ln_b': nrm(ks[5], (N_EVEN, GM_GROUPS, GM_GROUP_DIM), 0.02),
        'even_lam_q1': nrm(ks[6], (N_EVEN, DA_HEAD_DIM), 0.1),
        'even_lam_k1': nrm(ks[7], (N_EVEN, DA_HEAD_DIM), 0.1),
        'even_lam_q2': nrm(ks[8], (N_EVEN, DA_HEAD_DIM), 0.1),
        'even_lam_k2': nrm(ks[9], (N_EVEN, DA_HEAD_DIM), 0.1),
        'even_subln_g': gain(ks[10], (N_EVEN, DA_V_DIM)),
        'even_w_o': nrm(ks[11], (N_EVEN, d, d), DN_BETA * d ** -0.5),
        'even_ln1_g': gain(ks[12], (N_EVEN, d)),
        'even_ln1_b': nrm(ks[13], (N_EVEN, d), 0.02),
        'ffn_w1': nrm(ks[14], (N_EVEN, d, D_FF), d ** -0.5),
        'ffn_w3': nrm(ks[15], (N_EVEN, d, D_FF), d ** -0.5),
        'ffn_w2': nrm(ks[16], (N_EVEN, D_FF, d), DN_BETA * D_FF ** -0.5),
        'even_ln2_g': gain(ks[17], (N_EVEN, d)),
        'even_ln2_b': nrm(ks[18], (N_EVEN, d), 0.02),
        'odd_w_in': nrm(ks[19], (N_ODD, d, ODD_IN), d ** -0.5),
        'odd_gn_g': gain(ks[20], (N_ODD, RET_HEADS, RET_V_DIM)),
        'odd_w_o': nrm(ks[21], (N_ODD, 2 * d, d), DN_BETA * (2 * d) ** -0.5),
        'odd_ln1_g': gain(ks[22], (N_ODD, d)),
        'odd_ln1_b': nrm(ks[23], (N_ODD, d), 0.02),
        'router_w': nrm(ks[24], (N_ODD, d, N_EXPERTS), d ** -0.5),
        'router_b': nrm(ks[25], (N_ODD, N_EXPERTS), 0.01),
        'moe_w1': nrm(ks[26], (N_ODD, N_EXPERTS, d, D_FF), d ** -0.5),
        'moe_w3': nrm(ks[27], (N_ODD, N_EXPERTS, d, D_FF), d ** -0.5),
        'moe_w2': nrm(ks[28], (N_ODD, N_EXPERTS, D_FF, d), DN_BETA * D_FF ** -0.5),
        'odd_ln2_g': gain(ks[29], (N_ODD, d)),
        'odd_ln2_b': nrm(ks[30], (N_ODD, d), 0.02),
    }


def reference(x, even_w_in, even_w_s, even_b_s, even_v_ln_g, even_v_ln_b, even_lam_q1, even_lam_k1,
              even_lam_q2, even_lam_k2, even_subln_g, even_w_o, even_ln1_g, even_ln1_b,
              ffn_w1, ffn_w3, ffn_w2, even_ln2_g, even_ln2_b,
              odd_w_in, odd_gn_g, odd_w_o, odd_ln1_g, odd_ln1_b,
              router_w, router_b, moe_w1, moe_w3, moe_w2, odd_ln2_g, odd_ln2_b):
    for l in range(DEPTH):
        i = l // 2
        if l % 2 == 0:
            mix = even_mixer(x, even_w_in[i], even_w_s[i], even_b_s[i], even_v_ln_g[i], even_v_ln_b[i],
                             even_lam_q1[i], even_lam_k1[i], even_lam_q2[i], even_lam_k2[i],
                             even_subln_g[i], even_w_o[i], l)
            x = layer_norm(DN_ALPHA * x + mix, even_ln1_g[i], even_ln1_b[i])
            x = layer_norm(DN_ALPHA * x + swiglu(x, ffn_w1[i], ffn_w3[i], ffn_w2[i]),
                           even_ln2_g[i], even_ln2_b[i])
        else:
            mix = odd_mixer(x, odd_w_in[i], odd_gn_g[i], odd_w_o[i])
            x = layer_norm(DN_ALPHA * x + mix, odd_ln1_g[i], odd_ln1_b[i])
            x = layer_norm(DN_ALPHA * x + moe_swiglu(x, router_w[i], router_b[i], moe_w1[i], moe_w3[i], moe_w2[i]),
                           odd_ln2_g[i], odd_ln2_b[i])
    return x
```

```cpp
#include <hip/hip_runtime.h>
#include <hip/hip_bf16.h>
#include <cstdio>
#include <cstdint>
#include <cmath>

#ifndef MK_ONE_LAUNCH
#define MK_ONE_LAUNCH 1
#endif

namespace pg8 {
#define PG8_LAS __attribute__((address_space(3)))
typedef unsigned short bf16_t;
typedef short bf16x8 __attribute__((ext_vector_type(8)));
typedef float f32x4 __attribute__((ext_vector_type(4)));
typedef float f32x2 __attribute__((ext_vector_type(2)));
typedef unsigned u32x4 __attribute__((ext_vector_type(4)));
typedef unsigned u32x2 __attribute__((ext_vector_type(2)));
typedef int v8i_t __attribute__((ext_vector_type(8)));
typedef int v4i_t __attribute__((ext_vector_type(4)));
constexpr int BM = 256, BK = 64, HALF = 128, HTB = HALF * BK * 2  , STAGE_BYTES = 8 * HTB, NXCD = 8, WGM = 8;

__host__ __device__ __forceinline__ int lds_byte(int r, int c) { const int st = (r >> 4) * 2 + (c >> 5), rr = r & 15, cc = c & 31, ob = rr * 64 + cc * 2; return st * 1024 + (ob ^ (((ob >> 9) & 1) << 5)); }
__host__ __device__ __forceinline__ void stage_rc(int b, int& R, int& C) { const int st = b / 1024, sb = b % 1024, swz = sb ^ (((sb >> 9) & 1) << 5); R = (st >> 1) * 16 + swz / 64; C = (st & 1) * 32 + (swz % 64) / 2; }
__host__ __device__ __forceinline__ int perm32(int rho) { const int n = rho >> 4, i = rho & 15; return 8 * (i >> 2) + 4 * n + (i & 3); }

struct Unit { int pm, pn, pb; };
struct Gemm { const bf16_t* A; const bf16_t* Bt; int M, N, K; };

struct StaticOrder {
    static constexpr bool GATHER = false;
    int nM, nN, nwg, G, c;
    __host__ __device__ void init(int M, int N, int G_, int c_) { nM = M / BM; nN = N / BM; nwg = nM * nN; G = G_; c = c_; }
    __host__ __device__ bool next(int i, Unit& u) const {
        const long L = (long)i * G + c; if (L >= nwg) return false;
        int wgid = (int)L; { const int q = nwg / NXCD, r = nwg % NXCD, xcd = wgid % NXCD, off = wgid / NXCD; wgid = (xcd < r ? xcd * (q + 1) : r * (q + 1) + (xcd - r) * q) + off; }
        const int nig = WGM * nN, gid = wgid / nig, fm = gid * WGM, gsz = (nM - fm) < WGM ? (nM - fm) : WGM;
        u.pm = fm + ((wgid % nig) % gsz); u.pn = (wgid % nig) / gsz; u.pb = u.pn; return true;
    }
    __device__ __forceinline__ unsigned a_row(const Unit& u, int r) const { return (unsigned)(u.pm * BM + r); }
};
struct PanelOrder {
    static constexpr bool GATHER = false;
    int nN, c;
    __device__ bool next(int i, Unit& u) const { if (i >= nN) return false; u.pm = c; u.pn = i; u.pb = i; return true; }
    __device__ __forceinline__ unsigned a_row(const Unit& u, int r) const { return (unsigned)(u.pm * BM + r); }
};
template <bool GATHER_> struct MoeOrder {
    static constexpr bool GATHER = GATHER_;
    int nM, nN, nwg, G, c; const int* tile_expert; const int* rowidx;
    __device__ void init(int nM_, int nN_, int G_, int c_, const int* te, const int* ri) { nM = nM_; nN = nN_; nwg = nM * nN; G = G_; c = c_; tile_expert = te; rowidx = ri; }
    __device__ bool next(int i, Unit& u) const {
        const long L = (long)i * G + c; if (L >= nwg) return false;
        int wgid = (int)L; { const int q = nwg / NXCD, r = nwg % NXCD, xcd = wgid % NXCD, off = wgid / NXCD; wgid = (xcd < r ? xcd * (q + 1) : r * (q + 1) + (xcd - r) * q) + off; }
        const int nig = WGM * nN, gid = wgid / nig, fm = gid * WGM, gsz = (nM - fm) < WGM ? (nM - fm) : WGM;
        u.pm = fm + ((wgid % nig) % gsz); u.pn = (wgid % nig) / gsz; u.pb = tile_expert[u.pm] * nN + u.pn; return true;
    }
    __device__ __forceinline__ unsigned a_row(const Unit& u, int r) const { return GATHER_ ? (unsigned)rowidx[u.pm * BM + r] : (unsigned)(u.pm * BM + r); }
};

__device__ __forceinline__ unsigned cvt_pk_bf16(float lo, float hi) { unsigned r; asm volatile("v_cvt_pk_bf16_f32 %0, %1, %2" : "=v"(r) : "v"(lo), "v"(hi)); return r; }
__device__ __forceinline__ f32x2 gelu_pk(f32x2 v) {
    const f32x2 av = __builtin_elementwise_abs(v), d = av * 0.2316418882f + 1.0f;
    f32x2 t; t.x = __builtin_amdgcn_rcpf(d.x); t.y = __builtin_amdgcn_rcpf(d.y);
    f32x2 q = t * 0.5307027145f + (-0.7265760135f); q = q * t + 0.7107068705f; q = q * t + (-0.142248368f); q = q * t + 0.127414796f; q = q * t;
    const f32x2 s = (v * v) * (-0.72134752044f);
    f32x2 e; e.x = __builtin_amdgcn_exp2f(s.x); e.y = __builtin_amdgcn_exp2f(s.y);
    const f32x2 m = v * (q * e), r = v - m;
    f32x2 o; o.x = v.x < 0.f ? m.x : r.x; o.y = v.y < 0.f ? m.y : r.y; return o;
}
__device__ __forceinline__ float silu_f(float v) { return v * __builtin_amdgcn_rcpf(1.0f + __builtin_amdgcn_exp2f(-1.4426950408889634f * v)); }


struct EpiRoute {
    static constexpr bool PERM = true, AFTER_DRAIN = false, LDS_SCALES = false;
    bf16_t* base[5]; int ldc[5]; int t0[5];
    int act[5];
    float scale[5]; int nseg;
    __device__ __forceinline__ void operator()(const f32x4 (&acc)[2][2][4][2], const Unit& u, int wr, int wc, int fr, int fq) const {
        bf16_t* O = base[0]; int ld = ldc[0], a = act[0], tt = t0[0]; float sc = scale[0];
#pragma unroll
        for (int k = 1; k < 5; ++k) if (k < nseg && u.pn >= t0[k]) { O = base[k]; ld = ldc[k]; a = act[k]; tt = t0[k]; sc = scale[k]; }
        const int row0 = u.pm * BM + wr * 64 + fr, col0 = (u.pn - tt) * BM + wc * 32 + 8 * fq;
#pragma unroll
        for (int ai = 0; ai < 2; ++ai)
#pragma unroll
            for (int m = 0; m < 4; ++m) { bf16_t* rowp = O + (size_t)(row0 + ai * HALF + m * 16) * ld + col0;
#pragma unroll
                for (int bj = 0; bj < 2; ++bj) { f32x4 v0 = acc[ai][bj][m][0], v1 = acc[ai][bj][m][1];
                    if (a == 1) { f32x2 p = gelu_pk((f32x2){v0[0], v0[1]}), q = gelu_pk((f32x2){v0[2], v0[3]}), r = gelu_pk((f32x2){v1[0], v1[1]}), t = gelu_pk((f32x2){v1[2], v1[3]});
                        v0 = (f32x4){p.x, p.y, q.x, q.y}; v1 = (f32x4){r.x, r.y, t.x, t.y}; }
                    else if (a == 2) {
#pragma unroll
                        for (int j = 0; j < 4; ++j) { v0[j] = silu_f(v0[j]); v1[j] = silu_f(v1[j]); } }
                    v0 = v0 * sc; v1 = v1 * sc; u32x4 w; w.x = cvt_pk_bf16(v0[0], v0[1]); w.y = cvt_pk_bf16(v0[2], v0[3]); w.z = cvt_pk_bf16(v1[0], v1[1]); w.w = cvt_pk_bf16(v1[2], v1[3]);
                    *(u32x4*)(rowp + bj * HALF) = w; } }
    }
};
struct EpiResF32 {
    static constexpr bool PERM = false, AFTER_DRAIN = false, LDS_SCALES = false;
    float* Y; const bf16_t* XB; int ldc; float alpha;
    __device__ __forceinline__ void operator()(const f32x4 (&acc)[2][2][4][2], const Unit& u, int wr, int wc, int fr, int fq) const {
        const int row0 = u.pm * BM + wr * 64 + fr, col0 = u.pn * BM + wc * 32 + 4 * fq;
#pragma unroll
        for (int ai = 0; ai < 2; ++ai)
#pragma unroll
            for (int m = 0; m < 4; ++m) { const size_t off = (size_t)(row0 + ai * HALF + m * 16) * ldc + col0;
#pragma unroll
                for (int bj = 0; bj < 2; ++bj)
#pragma unroll
                    for (int n = 0; n < 2; ++n) { const u32x2 xb = *(const u32x2*)(XB + off + bj * HALF + n * 16);
                        f32x4 r; r[0] = __uint_as_float(xb.x << 16); r[1] = __uint_as_float(xb.x & 0xffff0000u); r[2] = __uint_as_float(xb.y << 16); r[3] = __uint_as_float(xb.y & 0xffff0000u);
                        *(f32x4*)(Y + off + bj * HALF + n * 16) = r * alpha + acc[ai][bj][m][n]; } }
    }
};
struct EpiResFromF32 {
    static constexpr bool PERM = false, AFTER_DRAIN = false, LDS_SCALES = false;
    const float* XF; bf16_t* XB; int ldc; float alpha;
    __device__ __forceinline__ void operator()(const f32x4 (&acc)[2][2][4][2], const Unit& u, int wr, int wc, int fr, int fq) const {
        const int row0 = u.pm * BM + wr * 64 + fr, col0 = u.pn * BM + wc * 32 + 4 * fq;
#pragma unroll
        for (int ai = 0; ai < 2; ++ai)
#pragma unroll
            for (int m = 0; m < 4; ++m) { const size_t off = (size_t)(row0 + ai * HALF + m * 16) * ldc + col0;
#pragma unroll
                for (int bj = 0; bj < 2; ++bj)
#pragma unroll
                    for (int n = 0; n < 2; ++n) { f32x4 r = *(const f32x4*)(XF + off + bj * HALF + n * 16);
                        r = r * alpha + acc[ai][bj][m][n];
                        u32x2 w; w.x = cvt_pk_bf16(r[0], r[1]); w.y = cvt_pk_bf16(r[2], r[3]); *(u32x2*)(XB + off + bj * HALF + n * 16) = w; } }
    }
};
struct EpiResInplace {
    static constexpr bool PERM = false, AFTER_DRAIN = false, LDS_SCALES = false;
    bf16_t* XB; int ldc; float alpha; float inv;
    __device__ __forceinline__ void operator()(const f32x4 (&acc)[2][2][4][2], const Unit& u, int wr, int wc, int fr, int fq) const {
        const int row0 = u.pm * BM + wr * 64 + fr, col0 = u.pn * BM + wc * 32 + 4 * fq;
#pragma unroll
        for (int ai = 0; ai < 2; ++ai)
#pragma unroll
            for (int m = 0; m < 4; ++m) { const size_t off = (size_t)(row0 + ai * HALF + m * 16) * ldc + col0;
#pragma unroll
                for (int bj = 0; bj < 2; ++bj)
#pragma unroll
                    for (int n = 0; n < 2; ++n) { u32x2* p = (u32x2*)(XB + off + bj * HALF + n * 16); const u32x2 xb = *p;
                        f32x4 r; r[0] = __uint_as_float(xb.x << 16); r[1] = __uint_as_float(xb.x & 0xffff0000u); r[2] = __uint_as_float(xb.y << 16); r[3] = __uint_as_float(xb.y & 0xffff0000u);
                        r = r * alpha + acc[ai][bj][m][n] * inv;
                        u32x2 w; w.x = cvt_pk_bf16(r[0], r[1]); w.y = cvt_pk_bf16(r[2], r[3]); *p = w; } }
    }
};
struct EpiSwiglu {
    static constexpr bool PERM = true, AFTER_DRAIN = false, LDS_SCALES = false;
    bf16_t* H; int ldc;
    __device__ __forceinline__ void operator()(const f32x4 (&acc)[2][2][4][2], const Unit& u, int wr, int wc, int fr, int fq) const {
        const int row0 = u.pm * BM + wr * 64 + fr, col0 = u.pn * HALF + wc * 32 + 8 * fq;
#pragma unroll
        for (int ai = 0; ai < 2; ++ai)
#pragma unroll
            for (int m = 0; m < 4; ++m) { bf16_t* rowp = H + (size_t)(row0 + ai * HALF + m * 16) * ldc + col0;
                f32x4 v0, v1;
#pragma unroll
                for (int j = 0; j < 4; ++j) { v0[j] = silu_f(acc[ai][0][m][0][j]) * acc[ai][1][m][0][j]; v1[j] = silu_f(acc[ai][0][m][1][j]) * acc[ai][1][m][1][j]; }
                u32x4 w; w.x = cvt_pk_bf16(v0[0], v0[1]); w.y = cvt_pk_bf16(v0[2], v0[3]); w.z = cvt_pk_bf16(v1[0], v1[1]); w.w = cvt_pk_bf16(v1[2], v1[3]);
                *(u32x4*)rowp = w; }
    }
};
struct EpiSwiglu8 {
    static constexpr bool PERM = true, AFTER_DRAIN = false, LDS_SCALES = false;
    unsigned char* H; int ldc; float inv;
    __device__ __forceinline__ void operator()(const f32x4 (&acc)[2][2][4][2], const Unit& u, int wr, int wc, int fr, int fq) const {
        const int row0 = u.pm * BM + wr * 64 + fr, col0 = u.pn * HALF + wc * 32 + 8 * fq;
#pragma unroll
        for (int ai = 0; ai < 2; ++ai)
#pragma unroll
            for (int m = 0; m < 4; ++m) { unsigned char* rowp = H + (size_t)(row0 + ai * HALF + m * 16) * ldc + col0;
                float v[8];
#pragma unroll
                for (int j = 0; j < 4; ++j) { v[j] = silu_f(acc[ai][0][m][0][j] * inv) * (acc[ai][1][m][0][j] * inv); v[4 + j] = silu_f(acc[ai][0][m][1][j] * inv) * (acc[ai][1][m][1][j] * inv); }
                int w0 = 0, w1 = 0;
                w0 = __builtin_amdgcn_cvt_pk_fp8_f32(v[0], v[1], w0, false); w0 = __builtin_amdgcn_cvt_pk_fp8_f32(v[2], v[3], w0, true);
                w1 = __builtin_amdgcn_cvt_pk_fp8_f32(v[4], v[5], w1, false); w1 = __builtin_amdgcn_cvt_pk_fp8_f32(v[6], v[7], w1, true);
                u32x2 w; w.x = (unsigned)w0; w.y = (unsigned)w1; *(u32x2*)rowp = w; }
    }
};
__device__ __forceinline__ f32x4 i2f4(const f32x4& a) { const v4i_t i = __builtin_bit_cast(v4i_t, a); return (f32x4){(float)i[0], (float)i[1], (float)i[2], (float)i[3]}; }
struct EpiResInplaceQ {
    static constexpr bool PERM = false, AFTER_DRAIN = false, LDS_SCALES = true;
    bf16_t* XB; int ldc; float alpha; const float* sa; const float* sw; PG8_LAS unsigned char* sbuf;
    __device__ __forceinline__ const float* row_src(const Unit& u) const { return sa + u.pm * BM; }
    __device__ __forceinline__ const float* col_src(const Unit& u) const { return sw + u.pb * BM; }
    __device__ __forceinline__ void operator()(const f32x4 (&acc)[2][2][4][2], const Unit& u, int wr, int wc, int fr, int fq) const {
        const int row0 = u.pm * BM + wr * 64 + fr, col0 = u.pn * BM + wc * 32 + 4 * fq;
        const PG8_LAS float* LR = (const PG8_LAS float*)sbuf + wr * 64 + fr; const PG8_LAS float* LC = (const PG8_LAS float*)(sbuf + 1024) + wc * 32 + 4 * fq;
        f32x4 cw[2][2];
#pragma unroll
        for (int bj = 0; bj < 2; ++bj)
#pragma unroll
            for (int n = 0; n < 2; ++n) cw[bj][n] = *(const PG8_LAS f32x4*)(LC + bj * HALF + n * 16);
#pragma unroll
        for (int ai = 0; ai < 2; ++ai)
#pragma unroll
            for (int m = 0; m < 4; ++m) { const size_t off = (size_t)(row0 + ai * HALF + m * 16) * ldc + col0; const float rs = LR[ai * HALF + m * 16];
#pragma unroll
                for (int bj = 0; bj < 2; ++bj)
#pragma unroll
                    for (int n = 0; n < 2; ++n) { u32x2* p = (u32x2*)(XB + off + bj * HALF + n * 16); const u32x2 xb = *p;
                        f32x4 r; r[0] = __uint_as_float(xb.x << 16); r[1] = __uint_as_float(xb.x & 0xffff0000u); r[2] = __uint_as_float(xb.y << 16); r[3] = __uint_as_float(xb.y & 0xffff0000u);
                        r = r * alpha + i2f4(acc[ai][bj][m][n]) * rs * cw[bj][n];
                        u32x2 w; w.x = cvt_pk_bf16(r[0], r[1]); w.y = cvt_pk_bf16(r[2], r[3]); *p = w; } }
    }
};
struct EpiResFromF32Q {
    static constexpr bool PERM = false, AFTER_DRAIN = false, LDS_SCALES = true;
    const float* XF; bf16_t* XB; int ldc; float alpha; const float* sa; const float* sw; PG8_LAS unsigned char* sbuf;
    __device__ __forceinline__ const float* row_src(const Unit& u) const { return sa + u.pm * BM; }
    __device__ __forceinline__ const float* col_src(const Unit& u) const { return sw + u.pb * BM; }
    __device__ __forceinline__ void operator()(const f32x4 (&acc)[2][2][4][2], const Unit& u, int wr, int wc, int fr, int fq) const {
        const int row0 = u.pm * BM + wr * 64 + fr, col0 = u.pn * BM + wc * 32 + 4 * fq;
        const PG8_LAS float* LR = (const PG8_LAS float*)sbuf + wr * 64 + fr; const PG8_LAS float* LC = (const PG8_LAS float*)(sbuf + 1024) + wc * 32 + 4 * fq;
        f32x4 cw[2][2];
#pragma unroll
        for (int bj = 0; bj < 2; ++bj)
#pragma unroll
            for (int n = 0; n < 2; ++n) cw[bj][n] = *(const PG8_LAS f32x4*)(LC + bj * HALF + n * 16);
#pragma unroll
        for (int ai = 0; ai < 2; ++ai)
#pragma unroll
            for (int m = 0; m < 4; ++m) { const size_t off = (size_t)(row0 + ai * HALF + m * 16) * ldc + col0; const float rs = LR[ai * HALF + m * 16];
#pragma unroll
                for (int bj = 0; bj < 2; ++bj)
#pragma unroll
                    for (int n = 0; n < 2; ++n) { f32x4 r = *(const f32x4*)(XF + off + bj * HALF + n * 16);
                        r = r * alpha + i2f4(acc[ai][bj][m][n]) * rs * cw[bj][n];
                        u32x2 w; w.x = cvt_pk_bf16(r[0], r[1]); w.y = cvt_pk_bf16(r[2], r[3]); *(u32x2*)(XB + off + bj * HALF + n * 16) = w; } }
    }
};
struct EpiRouteQ {
    static constexpr bool PERM = true, AFTER_DRAIN = false, LDS_SCALES = true;
    bf16_t* base[5]; int ldc[5]; int t0[5]; int act[5]; float scale[5]; int nseg; const float* sa; const float* sw; PG8_LAS unsigned char* sbuf;
    int tiled = 0;
    __device__ __forceinline__ const float* row_src(const Unit& u) const { return sa + u.pm * BM; }
    __device__ __forceinline__ const float* col_src(const Unit& u) const { return sw + u.pb * BM; }
    __device__ __forceinline__ void operator()(const f32x4 (&acc)[2][2][4][2], const Unit& u, int wr, int wc, int fr, int fq) const {
        bf16_t* O = base[0]; int ld = ldc[0], a = act[0], tt = t0[0]; float sc = scale[0];
#pragma unroll
        for (int k = 1; k < 5; ++k) if (k < nseg && u.pn >= t0[k]) { O = base[k]; ld = ldc[k]; a = act[k]; tt = t0[k]; sc = scale[k]; }
        const int row0 = u.pm * BM + wr * 64 + fr, col0 = (u.pn - tt) * BM + wc * 32 + 8 * fq;
        const PG8_LAS float* LR = (const PG8_LAS float*)sbuf + wr * 64 + fr; const PG8_LAS float* LC = (const PG8_LAS float*)(sbuf + 1024) + wc * 32 + 8 * fq;
        const size_t rstride = tiled ? (size_t)32 : (size_t)ld, bjstep = tiled ? (size_t)32768 : (size_t)HALF;
        bf16_t* const p0 = tiled ? O + ((size_t)(u.pm * (ld >> 8) + (u.pn - tt)) * 8 + wc) * 8192 + (wr * 64 + fr) * 32 + 8 * fq : O + (size_t)row0 * ld + col0;
        f32x4 cw[2][2];
        const float csc = (a == 0) ? sc : 1.f;
#pragma unroll
        for (int bj = 0; bj < 2; ++bj)
#pragma unroll
            for (int n = 0; n < 2; ++n) cw[bj][n] = *(const PG8_LAS f32x4*)(LC + bj * HALF + 4 * n) * csc;
#pragma unroll
        for (int ai = 0; ai < 2; ++ai)
#pragma unroll
            for (int m = 0; m < 4; ++m) { const float rs = LR[ai * HALF + m * 16]; bf16_t* rowp = p0 + (size_t)(ai * HALF + m * 16) * rstride;
#pragma unroll
                for (int bj = 0; bj < 2; ++bj) { f32x4 v0 = i2f4(acc[ai][bj][m][0]) * rs * cw[bj][0], v1 = i2f4(acc[ai][bj][m][1]) * rs * cw[bj][1];
                    if (a == 1) { f32x2 p = gelu_pk((f32x2){v0[0], v0[1]}), q = gelu_pk((f32x2){v0[2], v0[3]}), r = gelu_pk((f32x2){v1[0], v1[1]}), t = gelu_pk((f32x2){v1[2], v1[3]});
                        v0 = (f32x4){p.x, p.y, q.x, q.y}; v1 = (f32x4){r.x, r.y, t.x, t.y}; }
                    else if (a == 2) {
#pragma unroll
                        for (int j = 0; j < 4; ++j) { v0[j] = silu_f(v0[j]); v1[j] = silu_f(v1[j]); } }
                    if (a != 0 && sc != 1.f) { v0 = v0 * sc; v1 = v1 * sc; } u32x4 w; w.x = cvt_pk_bf16(v0[0], v0[1]); w.y = cvt_pk_bf16(v0[2], v0[3]); w.z = cvt_pk_bf16(v1[0], v1[1]); w.w = cvt_pk_bf16(v1[2], v1[3]);
                    *(u32x4*)(rowp + bj * bjstep) = w; } }
    }
};
template <bool OUT8> struct EpiSwigluQ {
    static constexpr bool PERM = true, AFTER_DRAIN = false, LDS_SCALES = true;
    void* H; int ldc; const float* sa; const float* sw; PG8_LAS unsigned char* sbuf;
    __device__ __forceinline__ const float* row_src(const Unit& u) const { return sa + u.pm * BM; }
    __device__ __forceinline__ const float* col_src(const Unit& u) const { return sw + u.pb * BM; }
    __device__ __forceinline__ void operator()(const f32x4 (&acc)[2][2][4][2], const Unit& u, int wr, int wc, int fr, int fq) const {
        const int row0 = u.pm * BM + wr * 64 + fr, col0 = u.pn * HALF + wc * 32 + 8 * fq;
        const PG8_LAS float* LR = (const PG8_LAS float*)sbuf + wr * 64 + fr; const PG8_LAS float* LC = (const PG8_LAS float*)(sbuf + 1024) + wc * 32 + 8 * fq;
        f32x4 cw[2][2], cwl[2];
#pragma unroll
        for (int bj = 0; bj < 2; ++bj)
#pragma unroll
            for (int n = 0; n < 2; ++n) cw[bj][n] = *(const PG8_LAS f32x4*)(LC + bj * HALF + 4 * n);
        cwl[0] = cw[0][0] * -1.4426950408889634f; cwl[1] = cw[0][1] * -1.4426950408889634f;
        const f32x4 cab[2] = {cw[0][0] * cw[1][0], cw[0][1] * cw[1][1]};
        unsigned char* const hb = (unsigned char*)H + ((size_t)(u.pm * (ldc / HALF) + u.pn) * 4 + wc) * 8192 + (wr * 64 + fr) * 32 + 8 * fq;
        (void)hb;
#pragma unroll
        for (int ai = 0; ai < 2; ++ai)
#pragma unroll
            for (int m = 0; m < 4; ++m) { const int row = row0 + ai * HALF + m * 16; const float rs = LR[ai * HALF + m * 16], rs2 = rs * rs;
                float v[8];
#pragma unroll
                for (int n = 0; n < 2; ++n) { const f32x4 fa = i2f4(acc[ai][0][m][n]), fb = i2f4(acc[ai][1][m][n]); const f32x4 t = (fa * cwl[n]) * rs, mm = ((fa * fb) * cab[n]) * rs2;
                    f32x4 e; e[0] = __builtin_amdgcn_exp2f(t[0]); e[1] = __builtin_amdgcn_exp2f(t[1]); e[2] = __builtin_amdgcn_exp2f(t[2]); e[3] = __builtin_amdgcn_exp2f(t[3]);
                    e = e + 1.0f; f32x4 r; r[0] = __builtin_amdgcn_rcpf(e[0]); r[1] = __builtin_amdgcn_rcpf(e[1]); r[2] = __builtin_amdgcn_rcpf(e[2]); r[3] = __builtin_amdgcn_rcpf(e[3]);
                    const f32x4 o = mm * r; v[4 * n] = o[0]; v[4 * n + 1] = o[1]; v[4 * n + 2] = o[2]; v[4 * n + 3] = o[3]; }
                if constexpr (OUT8) { int w0 = 0, w1 = 0;
                    w0 = __builtin_amdgcn_cvt_pk_fp8_f32(v[0], v[1], w0, false); w0 = __builtin_amdgcn_cvt_pk_fp8_f32(v[2], v[3], w0, true);
                    w1 = __builtin_amdgcn_cvt_pk_fp8_f32(v[4], v[5], w1, false); w1 = __builtin_amdgcn_cvt_pk_fp8_f32(v[6], v[7], w1, true);
                    u32x2 w; w.x = (unsigned)w0; w.y = (unsigned)w1;
                    *(u32x2*)(hb + ai * 4096 + m * 512) = w; }
                else { u32x4 w; w.x = cvt_pk_bf16(v[0], v[1]); w.y = cvt_pk_bf16(v[2], v[3]); w.z = cvt_pk_bf16(v[4], v[5]); w.w = cvt_pk_bf16(v[6], v[7]);
                    *(u32x4*)((bf16_t*)H + (size_t)row * ldc + col0) = w; } }
    }
};
struct EpiMoeDown {
    static constexpr bool PERM = true, AFTER_DRAIN = false, LDS_SCALES = true;
    bf16_t* O; int ldc; const float* gate; float inv; PG8_LAS unsigned char* sbuf;
    __device__ __forceinline__ const float* row_src(const Unit& u) const { return gate + u.pm * BM; }
    __device__ __forceinline__ const float* col_src(const Unit& u) const { return gate + u.pm * BM; }
    __device__ __forceinline__ void operator()(const f32x4 (&acc)[2][2][4][2], const Unit& u, int wr, int wc, int fr, int fq) const {
        const int row0 = u.pm * BM + wr * 64 + fr, col0 = u.pn * BM + wc * 32 + 8 * fq;
        const PG8_LAS float* LR = (const PG8_LAS float*)sbuf + wr * 64 + fr;
#pragma unroll
        for (int ai = 0; ai < 2; ++ai)
#pragma unroll
            for (int m = 0; m < 4; ++m) { const int row = row0 + ai * HALF + m * 16; const float gt = LR[ai * HALF + m * 16] * inv; bf16_t* rowp = O + (size_t)row * ldc + col0;
#pragma unroll
                for (int bj = 0; bj < 2; ++bj) { const f32x4 v0 = acc[ai][bj][m][0] * gt, v1 = acc[ai][bj][m][1] * gt;
                    u32x4 w; w.x = cvt_pk_bf16(v0[0], v0[1]); w.y = cvt_pk_bf16(v0[2], v0[3]); w.z = cvt_pk_bf16(v1[0], v1[1]); w.w = cvt_pk_bf16(v1[2], v1[3]);
                    *(u32x4*)(rowp + bj * HALF) = w; } }
    }
};

template <class Epi, class Sched, bool ALIGN_EPI = false, bool SP2 = false, int MODE = 0, bool AT = false>
__device__ __forceinline__ void gemm_phase(PG8_LAS unsigned char* lds, const Gemm g, const Sched& S, Epi& E, int wave_) {
    int tid_; { int l_; asm volatile("v_mbcnt_lo_u32_b32 %0, -1, 0\n\tv_mbcnt_hi_u32_b32 %0, -1, %0" : "=v"(l_)); tid_ = wave_ * 64 + l_; }
    constexpr bool GATHER = Sched::GATHER;
    const int tid = tid_, wid = __builtin_amdgcn_readfirstlane(wave_), lane = tid & 63, wr = wid >> 2, wc = wid & 3, fr = lane & 15, fq = lane >> 4;
    constexpr bool FP8 = (MODE == 1), I8 = (MODE == 2); constexpr int ES = MODE ? 1 : 2;
    const int K = g.K, nt = K * ES / (BK * 2);
    unsigned voffA[2], voffB[2]; int RA[2], CA[2];
#pragma unroll
    for (int i = 0; i < 2; ++i) { int R, C; stage_rc(tid * 16 + i * 8192, R, C); const int Rb = Epi::PERM ? ((R & ~31) + perm32(R & 31)) : R;
        RA[i] = R; CA[i] = C * 2; voffA[i] = AT ? (unsigned)(((C * 2) >> 5) * 8192 + R * 32 + ((C * 2) & 16)) : (unsigned)(R * K * ES + C * 2); voffB[i] = (unsigned)(Rb * K * ES + C * 2); }
    const unsigned K2 = (unsigned)(K * ES);
#define PG8_MKVA(dst, u) do { if constexpr (GATHER) { _Pragma("unroll") for (int _h = 0; _h < 2; ++_h) _Pragma("unroll") for (int _i = 0; _i < 2; ++_i) dst[_h][_i] = S.a_row(u, _h * HALF + RA[_i]) * K2 + (unsigned)CA[_i]; } } while (0)
#define PG8_ABASE(u) (GATHER ? (const char*)g.A : (const char*)g.A + (size_t)(u).pm * tstep)
    const size_t kstep = (size_t)(BK * 2);
    const size_t hstep = (size_t)HALF * K * ES;
    const size_t kstepA = AT ? (size_t)32768 : kstep, hstepA = AT ? (size_t)HALF * 32 : hstep;
    const size_t tstep = 2 * hstep;
    const unsigned ldsw = (unsigned)wid * 1024u;
    const int aoff = lds_byte(wr * 64 + fr, fq * 8), boff = lds_byte(wc * 32 + fr, fq * 8);
#define PG8_SA(b, h) (((b) * 2 + (h)) * HTB)
#define PG8_SB(b, h) ((4 + (b) * 2 + (h)) * HTB)
#define PG8_STAGE(bufoff, gbase, voff) do { _Pragma("unroll") for (int _i = 0; _i < 2; ++_i) \
        __builtin_amdgcn_global_load_lds((const unsigned*)((const char*)(gbase) + (voff)[_i]), (PG8_LAS unsigned*)(lds + (bufoff) + ldsw + _i * 8192), 16, 0, 0); } while (0)
#define PG8_STAGE_A(bufoff, gbase, VA, h) do { if constexpr (GATHER) { _Pragma("unroll") for (int _i = 0; _i < 2; ++_i) \
        __builtin_amdgcn_global_load_lds((const unsigned*)((const char*)(gbase) + (VA)[h][_i]), (PG8_LAS unsigned*)(lds + (bufoff) + ldsw + _i * 8192), 16, 0, 0); } \
        else { _Pragma("unroll") for (int _i = 0; _i < 2; ++_i) \
        __builtin_amdgcn_global_load_lds((const unsigned*)((const char*)(gbase) + (h) * hstepA + voffA[_i]), (PG8_LAS unsigned*)(lds + (bufoff) + ldsw + _i * 8192), 16, 0, 0); } } while (0)
#define PG8_LDA(dst, b, h) do { _Pragma("unroll") for (int m = 0; m < 4; ++m) _Pragma("unroll") for (int k = 0; k < 2; ++k) dst[m][k] = *(const PG8_LAS bf16x8*)(lds + PG8_SA(b, h) + aoff + m * 2048 + k * 1024); } while (0)
#define PG8_LDB(dst, b, h) do { _Pragma("unroll") for (int n = 0; n < 2; ++n) _Pragma("unroll") for (int k = 0; k < 2; ++k) dst[n][k] = *(const PG8_LAS bf16x8*)(lds + PG8_SB(b, h) + boff + n * 2048 + k * 1024); } while (0)
#define PG8_CAT(x) __builtin_bit_cast(v8i_t, __builtin_shufflevector(x[0], x[1], 0, 1, 2, 3, 4, 5, 6, 7, 8, 9, 10, 11, 12, 13, 14, 15))
#define PG8_MMA(ai, bj, At, Bt) do { __builtin_amdgcn_s_setprio(1); if constexpr (FP8) { _Pragma("unroll") for (int m = 0; m < 4; ++m) _Pragma("unroll") for (int n = 0; n < 2; ++n) \
        { const v8i_t a8_ = PG8_CAT(Bt[n]), b8_ = PG8_CAT(At[m]); asm volatile("v_mfma_f32_16x16x128_f8f6f4 %0, %1, %2, %0" : "+v"(acc[ai][bj][m][n]) : "v"(a8_), "v"(b8_)); } } \
        else if constexpr (I8) { _Pragma("unroll") for (int m = 0; m < 4; ++m) _Pragma("unroll") for (int n = 0; n < 2; ++n) _Pragma("unroll") for (int k = 0; k < 2; ++k) \
        acc[ai][bj][m][n] = __builtin_bit_cast(f32x4, __builtin_amdgcn_mfma_i32_16x16x64_i8(__builtin_bit_cast(v4i_t, Bt[n][k]), __builtin_bit_cast(v4i_t, At[m][k]), __builtin_bit_cast(v4i_t, acc[ai][bj][m][n]), 0, 0, 0)); } \
        else { _Pragma("unroll") for (int m = 0; m < 4; ++m) _Pragma("unroll") for (int n = 0; n < 2; ++n) _Pragma("unroll") for (int k = 0; k < 2; ++k) \
        acc[ai][bj][m][n] = __builtin_amdgcn_mfma_f32_16x16x32_bf16(Bt[n][k], At[m][k], acc[ai][bj][m][n], 0, 0, 0); } __builtin_amdgcn_s_setprio(0); } while (0)
#define PG8_WAIT_V(n) asm volatile("s_waitcnt vmcnt(" #n ")" ::: "memory")
#define PG8_WAIT_L(n) asm volatile("s_waitcnt lgkmcnt(" #n ")" ::: "memory")
#define PG8_BAR __builtin_amdgcn_s_barrier()
#define PG8_SCHED __builtin_amdgcn_sched_barrier(0)
    Unit cur, nxt; int ui = 0;
    if (!S.next(0, cur)) return;
    f32x4 acc[2][2][4][2];
#pragma unroll
    for (int a = 0; a < 2; ++a)
#pragma unroll
        for (int b = 0; b < 2; ++b)
#pragma unroll
            for (int m = 0; m < 4; ++m)
#pragma unroll
                for (int n = 0; n < 2; ++n) acc[a][b][m][n] = (f32x4){0.f, 0.f, 0.f, 0.f};
    bf16x8 At[4][2], B0[2][2], B1[2][2];
    const char* cA = PG8_ABASE(cur); const char* cB = (const char*)g.Bt + (size_t)cur.pb * tstep;
    unsigned va[2][2] = {{0u, 0u}, {0u, 0u}}, nva[2][2] = {{0u, 0u}, {0u, 0u}}; PG8_MKVA(va, cur);
#define PG8_SCALES(u, b) do { if constexpr (Epi::LDS_SCALES) { if (wid < 2) { const float* s_ = (wid == 0) ? E.row_src(u) : E.col_src(u); \
        __builtin_amdgcn_global_load_lds((const unsigned*)(s_ + lane * 4), (PG8_LAS unsigned*)(lds + STAGE_BYTES + (b) * 2048 + wid * 1024), 16, 0, 0); } } } while (0)
    PG8_SCALES(cur, 0);
    if constexpr (SP2) {
        PG8_STAGE(PG8_SB(0, 0), cB, voffB); PG8_STAGE(PG8_SB(0, 1), cB + hstep, voffB); PG8_STAGE_A(PG8_SA(0, 0), cA, va, 0); PG8_STAGE_A(PG8_SA(0, 1), cA, va, 1);
        if (wr == 1) PG8_BAR;
        PG8_WAIT_V(2); PG8_BAR;
        PG8_STAGE(PG8_SB(1, 0), cB + kstep, voffB); PG8_STAGE_A(PG8_SA(1, 0), cA + kstepA, va, 0); PG8_STAGE(PG8_SB(1, 1), cB + hstep + kstep, voffB);
        PG8_WAIT_V(6); PG8_BAR;
    } else {
        PG8_STAGE(PG8_SB(0, 0), cB, voffB); PG8_STAGE_A(PG8_SA(0, 0), cA, va, 0); PG8_STAGE(PG8_SB(0, 1), cB + hstep, voffB); PG8_STAGE_A(PG8_SA(0, 1), cA, va, 1);
        if (wr == 1) PG8_BAR;
        PG8_WAIT_V(4); PG8_BAR;
        PG8_STAGE(PG8_SB(1, 0), cB + kstep, voffB); PG8_STAGE_A(PG8_SA(1, 0), cA + kstepA, va, 0); PG8_STAGE(PG8_SB(1, 1), cB + hstep + kstep, voffB);
        PG8_WAIT_V(6); PG8_BAR;
    }
    for (;;) {
        const bool has_next = S.next(ui + 1, nxt);
        const char* nA = has_next ? PG8_ABASE(nxt) : cA; const char* nB = has_next ? (const char*)g.Bt + (size_t)nxt.pb * tstep : cB;
        if (has_next) PG8_SCALES(nxt, (ui + 1) % 3);
        if constexpr (GATHER) { if (has_next) PG8_MKVA(nva, nxt); else { _Pragma("unroll") for (int _h = 0; _h < 2; ++_h) _Pragma("unroll") for (int _i = 0; _i < 2; ++_i) nva[_h][_i] = va[_h][_i]; } }
#pragma unroll 1
        for (int t = 0; t < nt; t += 2) {
            const bool last = (t == nt - 2);
            const char* a1 = cA + (size_t)(t + 1) * kstepA;
            const char* a2 = last ? nA : cA + (size_t)(t + 2) * kstepA; const char* b2 = last ? nB : cB + (size_t)(t + 2) * kstep;
            const char* a3 = a2 + kstepA; const char* b3 = b2 + kstep;
            unsigned o2[2][2] = {{0u, 0u}, {0u, 0u}};
            if constexpr (GATHER) {
#pragma unroll
                for (int _h = 0; _h < 2; ++_h)
#pragma unroll
                    for (int _i = 0; _i < 2; ++_i) o2[_h][_i] = last ? nva[_h][_i] : va[_h][_i]; }
            if constexpr (SP2) {
            PG8_LDB(B0, 0, 0); PG8_LDB(B1, 0, 1); PG8_SCHED; PG8_LDA(At, 0, 0); PG8_STAGE_A(PG8_SA(1, 1), a1, va, 1);
            PG8_WAIT_V(8); PG8_WAIT_L(0); PG8_BAR; PG8_MMA(0, 0, At, B0); PG8_MMA(0, 1, At, B1); PG8_BAR; PG8_SCHED;
            PG8_LDA(At, 0, 1); PG8_STAGE(PG8_SB(0, 0), b2, voffB); PG8_STAGE(PG8_SB(0, 1), b2 + hstep, voffB); PG8_STAGE_A(PG8_SA(0, 0), a2, o2, 0);
            PG8_WAIT_V(8); PG8_WAIT_L(0); PG8_BAR; PG8_MMA(1, 0, At, B0); PG8_MMA(1, 1, At, B1); PG8_BAR; PG8_SCHED;
            PG8_LDB(B0, 1, 0); PG8_LDB(B1, 1, 1); PG8_SCHED; PG8_LDA(At, 1, 0); PG8_STAGE_A(PG8_SA(0, 1), a2, o2, 1);
            PG8_WAIT_V(8); PG8_WAIT_L(0); PG8_BAR; PG8_MMA(0, 0, At, B0); PG8_MMA(0, 1, At, B1); PG8_BAR; PG8_SCHED;
            PG8_LDA(At, 1, 1); PG8_STAGE(PG8_SB(1, 0), b3, voffB); PG8_STAGE(PG8_SB(1, 1), b3 + hstep, voffB); PG8_STAGE_A(PG8_SA(1, 0), a3, o2, 0);
            PG8_WAIT_V(8); PG8_WAIT_L(0); PG8_BAR; PG8_MMA(1, 0, At, B0); PG8_MMA(1, 1, At, B1); PG8_BAR; PG8_SCHED;
            } else {
            PG8_LDB(B0, 0, 0); PG8_SCHED; PG8_LDA(At, 0, 0); PG8_STAGE_A(PG8_SA(1, 1), a1, va, 1);
            PG8_WAIT_L(8); PG8_BAR; PG8_WAIT_L(0); PG8_MMA(0, 0, At, B0); PG8_BAR; PG8_SCHED;
            PG8_LDB(B1, 0, 1); PG8_STAGE(PG8_SB(0, 0), b2, voffB);
            PG8_BAR; PG8_WAIT_L(0); PG8_MMA(0, 1, At, B1); PG8_BAR;
            PG8_LDA(At, 0, 1); PG8_STAGE_A(PG8_SA(0, 0), a2, o2, 0);
            PG8_BAR; PG8_WAIT_L(0); PG8_MMA(1, 0, At, B0); PG8_BAR; PG8_SCHED;
            PG8_STAGE(PG8_SB(0, 1), b2 + hstep, voffB);
            PG8_WAIT_V(6); PG8_BAR; PG8_MMA(1, 1, At, B1); PG8_BAR;
            PG8_LDB(B0, 1, 0); PG8_SCHED; PG8_LDA(At, 1, 0); PG8_STAGE_A(PG8_SA(0, 1), a2, o2, 1);
            PG8_WAIT_L(8); PG8_BAR; PG8_WAIT_L(0); PG8_MMA(0, 0, At, B0); PG8_BAR; PG8_SCHED;
            PG8_LDB(B1, 1, 1); PG8_STAGE(PG8_SB(1, 0), b3, voffB);
            PG8_BAR; PG8_WAIT_L(0); PG8_MMA(0, 1, At, B1); PG8_BAR;
            PG8_LDA(At, 1, 1); PG8_STAGE_A(PG8_SA(1, 0), a3, o2, 0);
            PG8_BAR; PG8_WAIT_L(0); PG8_MMA(1, 0, At, B0); PG8_BAR; PG8_SCHED;
            PG8_STAGE(PG8_SB(1, 1), b3 + hstep, voffB);
            PG8_WAIT_V(6); PG8_BAR; PG8_MMA(1, 1, At, B1); PG8_BAR;
            }
        }
        if constexpr (ALIGN_EPI) { if (wr == 0) PG8_BAR; }
        if constexpr (FP8) asm volatile("s_nop 15\n\ts_nop 7" ::: "memory");
        if constexpr (Epi::LDS_SCALES) E.sbuf = lds + STAGE_BYTES + (ui % 3) * 2048;
        E(acc, cur, wr, wc, fr, fq);
        if (!has_next) break;
#pragma unroll
        for (int a = 0; a < 2; ++a)
#pragma unroll
            for (int b = 0; b < 2; ++b)
#pragma unroll
                for (int m = 0; m < 4; ++m)
#pragma unroll
                    for (int n = 0; n < 2; ++n) acc[a][b][m][n] = (f32x4){0.f, 0.f, 0.f, 0.f};
        cur = nxt; cA = nA; cB = nB; ++ui;
        if constexpr (GATHER) {
#pragma unroll
            for (int _h = 0; _h < 2; ++_h)
#pragma unroll
                for (int _i = 0; _i < 2; ++_i) va[_h][_i] = nva[_h][_i]; }
        if constexpr (ALIGN_EPI) { if (wr == 1) PG8_BAR; }
    }
    PG8_WAIT_V(0);
    if constexpr (!ALIGN_EPI) { if (wr == 0) PG8_BAR; }
    PG8_BAR;
#undef PG8_SA
#undef PG8_SB
#undef PG8_STAGE
#undef PG8_STAGE_A
#undef PG8_MKVA
#undef PG8_ABASE
#undef PG8_LDA
#undef PG8_LDB
#undef PG8_MMA
#undef PG8_SCALES
#undef PG8_CAT
#undef PG8_WAIT_V
#undef PG8_WAIT_L
#undef PG8_BAR
#undef PG8_SCHED
}
}

#include <hip/hip_bf16.h>
#include <cmath>
namespace attn_body {
using bf16=__hip_bfloat16;
using bf16x8=__attribute__((ext_vector_type(8)))short;
using s16x4=__attribute__((ext_vector_type(4)))short;
using f32x16=__attribute__((ext_vector_type(16)))float;
using u32x4=__attribute__((ext_vector_type(4)))unsigned;
constexpr int SEQ=4096,D=64,DM=512;
constexpr int NW=8,QBLK=32,QB=QBLK*NW,KVBLK=64,NQB=SEQ/QB;
constexpr int ATTN_PITCH=DM, ATTN_UNIT_ROWS=QB;
__device__ __forceinline__ int crow(int r,int hi){return (r&3)+8*(r>>2)+4*hi;}
#define SBAR() __builtin_amdgcn_sched_barrier(0)
__device__ __forceinline__ void cmask(f32x16&p0,f32x16&p1,int jb,int qrel,int hi){
  const float NEG=-INFINITY; int kb=64*jb+4*hi;
  #pragma unroll
  for(int r=0;r<16;++r){int kv=kb+(r&3)+8*(r>>2); if(kv>qrel)p0[r]=NEG; if(kv+32>qrel)p1[r]=NEG;}
}

constexpr int NSLOT=3, SLOTB=8192;
constexpr int LDS_K=0, LDS_V=NSLOT*SLOTB, LDS_WS=3*NSLOT*SLOTB, LDS_OST=LDS_WS+NW*64*4, LDS_BYTES=LDS_OST+NW*8192;
constexpr float C2=0.125f*1.4426950408889634f;
__device__ __forceinline__ void glds16(const void*gsrc,unsigned lds_dst){unsigned keep;
  asm volatile("s_mov_b32 %0, m0\n\ts_mov_b32 m0, %2\n\ts_nop 0\n\tglobal_load_lds_dwordx4 %1, off\n\ts_mov_b32 m0, %0":"=&s"(keep):"v"(gsrc),"s"(lds_dst):"memory");}
__device__ __forceinline__ void glds16s(unsigned voff,const void*sbase,unsigned lds_dst){unsigned keep;
  const unsigned long long b=(unsigned long long)sbase; const unsigned blo=__builtin_amdgcn_readfirstlane((unsigned)b),bhi=__builtin_amdgcn_readfirstlane((unsigned)(b>>32));
  const unsigned long long sb=((unsigned long long)bhi<<32)|blo;
  asm volatile("s_mov_b32 %0, m0\n\ts_mov_b32 m0, %2\n\ts_nop 4\n\tglobal_load_lds_dwordx4 %1, %3\n\ts_mov_b32 m0, %0":"=&s"(keep):"v"(voff),"s"(lds_dst),"s"(sb):"memory");}
__device__ __forceinline__ float max3f(float a,float b,float c){float r;asm("v_max3_f32 %0, %1, %2, %3":"=v"(r):"v"(a),"v"(b),"v"(c));return r;}
__device__ __forceinline__ float max2f(float a,float b){float r;asm("v_max_f32_e32 %0, %1, %2":"=v"(r):"v"(a),"v"(b));return r;}
__device__ __forceinline__ float fadd_s(float a,float b){float r;asm("v_add_f32_e32 %0, %1, %2":"=v"(r):"v"(a),"v"(b));return r;}
__device__ __forceinline__ float fsub_s(float a,float b){float r;asm("v_sub_f32_e32 %0, %1, %2":"=v"(r):"v"(a),"v"(b));return r;}
typedef float f32x2_t __attribute__((ext_vector_type(2))); typedef __bf16 bf16x2_t __attribute__((ext_vector_type(2)));
__device__ __forceinline__ unsigned cvtpk_s(float lo,float hi){f32x2_t v={lo,hi};bf16x2_t b=__builtin_convertvector(v,bf16x2_t);return __builtin_bit_cast(unsigned,b);}
#define WAIT_BAR(N) asm volatile("s_waitcnt vmcnt(" #N ") lgkmcnt(0)\n\ts_barrier":::"memory")

__device__ __forceinline__ void qkt(f32x16&p0,f32x16&p1,const char*Kslot,const bf16x8*qr,const f32x16&c0,const f32x16&c1,int r32,int hi){
  const char*kb=Kslot+hi*1024+r32*16;
  #pragma unroll
  for(int d0=0;d0<4;++d0){
    const bf16x8 b0=*reinterpret_cast<const bf16x8*>(kb+d0*2048);
    const bf16x8 b1=*reinterpret_cast<const bf16x8*>(kb+d0*2048+512);
    if(d0==0){p0=__builtin_amdgcn_mfma_f32_32x32x16_bf16(b0,qr[0],c0,0,0,0);p1=__builtin_amdgcn_mfma_f32_32x32x16_bf16(b1,qr[0],c1,0,0,0);}
    else{p0=__builtin_amdgcn_mfma_f32_32x32x16_bf16(b0,qr[d0],p0,0,0,0);p1=__builtin_amdgcn_mfma_f32_32x32x16_bf16(b1,qr[d0],p1,0,0,0);}}
}
typedef __attribute__((address_space(3))) const char* lds_cptr;
typedef short v4i16_t __attribute__((ext_vector_type(4)));
__device__ __forceinline__ void kload8(bf16x8*kf,lds_cptr kp){
  kf[0]=*(const __attribute__((address_space(3))) bf16x8*)(kp);      kf[1]=*(const __attribute__((address_space(3))) bf16x8*)(kp+512);
  kf[2]=*(const __attribute__((address_space(3))) bf16x8*)(kp+2048); kf[3]=*(const __attribute__((address_space(3))) bf16x8*)(kp+2560);
  kf[4]=*(const __attribute__((address_space(3))) bf16x8*)(kp+4096); kf[5]=*(const __attribute__((address_space(3))) bf16x8*)(kp+4608);
  kf[6]=*(const __attribute__((address_space(3))) bf16x8*)(kp+6144); kf[7]=*(const __attribute__((address_space(3))) bf16x8*)(kp+6656);
}
__device__ __forceinline__ void kload2(bf16x8*kf,lds_cptr kp,int j){ kf[2*j]=*(const __attribute__((address_space(3))) bf16x8*)(kp+j*2048); kf[2*j+1]=*(const __attribute__((address_space(3))) bf16x8*)(kp+j*2048+512); }
__device__ __forceinline__ s16x4 vtr(lds_cptr p){ return __builtin_bit_cast(s16x4,__builtin_amdgcn_ds_read_tr16_b64_v4i16((__attribute__((address_space(3))) v4i16_t*)p)); }
__device__ __forceinline__ float rowmax(const f32x16&p0,const f32x16&p1){
  float a=max3f(p0[0],p0[1],p1[0]),b=max3f(p0[2],p0[3],p1[1]);a=max3f(a,p1[2],p1[3]);
  #pragma unroll
  for(int r=4;r<16;r+=4){a=max3f(a,p0[r],p0[r+1]);b=max3f(b,p0[r+2],p0[r+3]);a=max3f(a,p1[r],p1[r+1]);b=max3f(b,p1[r+2],p1[r+3]);}
  const float m=max2f(a,b);
  auto rr=__builtin_amdgcn_permlane32_swap(__float_as_uint(m),__float_as_uint(m),false,false);
  return max2f(__uint_as_float(rr[0]),__uint_as_float(rr[1]));
}
__device__ __forceinline__ void pv(f32x16*o,int vb,bf16x8 pa0,bf16x8 pa1,bf16x8 pa2,bf16x8 pa3){
  #pragma unroll
  for(int d0=0;d0<4;++d0){s16x4 lo[4],hi[4];
    #pragma unroll
    for(int ks=0;ks<4;++ks){
      asm volatile("ds_read_b64_tr_b16 %0,%1 offset:%c2":"=&v"(lo[ks]):"v"(vb),"i"(d0*4096+ks*1024):"memory");
      asm volatile("ds_read_b64_tr_b16 %0,%1 offset:%c2":"=&v"(hi[ks]):"v"(vb),"i"(d0*4096+ks*1024+512):"memory");}
    asm volatile("s_waitcnt lgkmcnt(0)":::"memory");SBAR();
    #define PK(k) (bf16x8){lo[k][0],lo[k][1],lo[k][2],lo[k][3],hi[k][0],hi[k][1],hi[k][2],hi[k][3]}
    o[d0]=__builtin_amdgcn_mfma_f32_32x32x16_bf16(pa0,PK(0),o[d0],0,0,0);
    o[d0]=__builtin_amdgcn_mfma_f32_32x32x16_bf16(pa1,PK(1),o[d0],0,0,0);
    o[d0]=__builtin_amdgcn_mfma_f32_32x32x16_bf16(pa2,PK(2),o[d0],0,0,0);
    o[d0]=__builtin_amdgcn_mfma_f32_32x32x16_bf16(pa3,PK(3),o[d0],0,0,0);
    #undef PK
  }
}

#ifndef ATTN_STORE16
#define ATTN_STORE16(p,v) (*(u32x4*)(p)=(v))
#endif
template<int THRL> __device__ __forceinline__ void attn_unit(int b,int hq,int hv  ,float sl2,int qb,const bf16*Q,const bf16*__restrict__ K,const bf16*__restrict__ V,bf16*O,char*shm,int wave_){
  int lane_; asm volatile("v_mbcnt_lo_u32_b32 %0, -1, 0\n\tv_mbcnt_hi_u32_b32 %0, -1, %0":"=v"(lane_)); const int wid=__builtin_amdgcn_readfirstlane(wave_),lane=lane_,r32=lane&31,hi=lane>>5;
  const long rowbase=(long)b*SEQ; const int q0=qb*QB;
  const bf16*Qw=Q+(rowbase+q0+wid*QBLK)*DM+hq*D;
  const bf16*Kh=K+rowbase*DM+hq*D,*Vh=V+rowbase*DM+hv*(2*D);
  const unsigned lds0=(unsigned)(uintptr_t)shm;
  float*wsf=(float*)(shm+LDS_WS)+wid*64;
  const unsigned koff=(unsigned)(lane*DM+wid*8)*2u;
  const unsigned voff=(unsigned)((16*(wid&3)+(lane>>2))*DM+(wid>>2)*32+(lane&3)*8)*2u;
  const unsigned kdst=lds0+LDS_K+wid*1024, vdst=lds0+LDS_V+wid*1024;
  #define DMA_K(t,slot) glds16s(koff,Kh+(long)(t)*KVBLK*DM,(unsigned)__builtin_amdgcn_readfirstlane(kdst+(slot)))
  #define DMA_V(t,slot) do{ glds16s(voff,Vh+(long)(t)*KVBLK*DM,(unsigned)__builtin_amdgcn_readfirstlane(vdst+2*(slot))); glds16s(voff,Vh+64+(long)(t)*KVBLK*DM,(unsigned)__builtin_amdgcn_readfirstlane(vdst+2*(slot)+8192)); }while(0)
  const char*Kbase=shm+LDS_K; bf16x8 kf[8];
  const lds_cptr shm3=(lds_cptr)shm; const lds_cptr kp0=shm3+LDS_K+hi*1024+r32*16; const lds_cptr vp0=shm3+LDS_V+((lane>>4)&1)*32+(lane&3)*8+(4*hi+((lane&15)>>2))*64;
  const int NT=(q0+QB)/KVBLK;
  DMA_K(0,0);DMA_V(0,0);DMA_K(1,SLOTB);
  bf16x8 qr[4];
  #pragma unroll
  for(int d0=0;d0<4;++d0)qr[d0]=*reinterpret_cast<const bf16x8*>(&Qw[(long)r32*DM+d0*16+hi*8]);
  float l_reg=0.f;f32x16 o[4];o[0]=f32x16{};o[1]=f32x16{};o[2]=f32x16{};o[3]=f32x16{};
  const int qrel=wid*QBLK+r32;
  float nb=sl2*(float)(4*hi-(q0+qrel));
  #define MKC0(C0) do{ _Pragma("unroll") for(int r=0;r<16;++r)C0[r]=__builtin_fmaf(sl2,(float)((r&3)+8*(r>>2)),nb); }while(0)
  #define MKC1(C1) do{ _Pragma("unroll") for(int r=0;r<16;++r)C1[r]=__builtin_fmaf(sl2,(float)((r&3)+8*(r>>2)+32),nb); }while(0)
  #define CMASK(P0,P1,t) do{int jb_=(t)-(NT-4); if(jb_>=0)cmask(P0,P1,jb_,qrel,hi);}while(0)
  bool resc=false;
  #define START(P0,P1) do{ const float rm=rowmax(P0,P1); resc=false; \
    { const float dl=rm; nb=fsub_s(nb,dl); \
      _Pragma("unroll") for(int r=0;r<16;++r){P0[r]=fsub_s(P0[r],dl);P1[r]=fsub_s(P1[r],dl);} } \
    _Pragma("unroll") for(int r=0;r<16;++r)P0[r]=__builtin_amdgcn_exp2f(P0[r]); }while(0)
  #define RESC() do{ if(resc){ asm volatile("s_waitcnt lgkmcnt(0)":::"memory"); \
      _Pragma("unroll") for(int d_=0;d_<4;++d_) _Pragma("unroll") for(int r=0;r<16;++r)o[d_][r]*=wsf[crow(r,hi)]; } }while(0)
  f32x16 pA0,pA1,pB0,pB1;
  int sl_prev=0,sl_cur=0,sl_next=SLOTB;
  #define ROT() do{sl_prev=sl_cur;sl_cur=sl_next;sl_next=(sl_next==(NSLOT-1)*SLOTB)?0:sl_next+SLOTB;}while(0)
  DMA_K(2,2*SLOTB);
  WAIT_BAR(4);
  { f32x16 ci0,ci1; MKC0(ci0); MKC1(ci1); qkt(pA0,pA1,Kbase,qr,ci0,ci1,r32,hi); } asm volatile("s_nop 15\n\ts_nop 7":"+v"(pA0),"+v"(pA1));CMASK(pA0,pA1,0);
  START(pA0,pA1);
  _Pragma("unroll") for(int r=0;r<16;++r)pA1[r]=__builtin_amdgcn_exp2f(pA1[r]);
  WAIT_BAR(0);
  DMA_K(3,0);DMA_V(1,SLOTB);
  ROT();
  kload8(kf,kp0+sl_cur);
  WAIT_BAR(3);
  s16x4 vlo[8],vhi[8]; u32x4 pw0,pw1,pw2,pw3;
  #define PKW(P,B) cvtpk_s(P[B],P[B+1])
  #define PAF(k) __builtin_bit_cast(bf16x8,pw##k)
  #define VFR(i) (bf16x8){vlo[i][0],vlo[i][1],vlo[i][2],vlo[i][3],vhi[i][0],vhi[i][1],vhi[i][2],vhi[i][3]}
  #define PIN(x) asm volatile("":"+v"(x))
  #define MX3(a,b,c) __builtin_fmaxf(__builtin_fmaxf((a),(b)),(c))
  #define GAPA(MF,A0,A1,A2,A3,W0,W1,PW) do{ MF; sacc+=A0; sacc+=A1; sacc+=A2; sacc+=A3; PIN(sacc); W0; W1; PIN(PW); SBAR(); }while(0)
  #define EX(v) __builtin_amdgcn_exp2f(v)
  #define GAPB(MF,X,B) do{ MF; X[B]=EX(X[B]); X[B+1]=EX(X[B+1]); PIN(X); SBAR(); }while(0)
  #define VRD2(i) do{ vlo[i]=vtr(vp_+((((i)>>2)+2)*4096+((i)&3)*1024)); vhi[i]=vtr(vp_+((((i)>>2)+2)*4096+((i)&3)*1024+512)); }while(0)
  #define VRD(i) do{ vlo[i]=vtr(vp_+(((i)>>2)*4096+((i)&3)*1024)); vhi[i]=vtr(vp_+(((i)>>2)*4096+((i)&3)*1024+512)); }while(0)
  #define KRD(G,j) do{ if(G){ kload2(kf,kp0+sl_next,j); SBAR(); } }while(0)
  #define STEP(C0,C1,P0,P1,t,GK,GV,GL) do{ SBAR(); \
    nb=__builtin_fmaf(sl2,64.f,nb); MKC0(C0); PIN(C0); SBAR(); \
    const lds_cptr vp_=vp0+2*sl_prev; \
    VRD(0); SBAR(); float sacc=(P0[0]+P0[1]); \
    GAPA(C0=__builtin_amdgcn_mfma_f32_32x32x16_bf16(kf[0],qr[0],C0,0,0,0), P0[2],P0[3],P0[4],P0[5],     pw0[0]=PKW(P0,0), pw0[1]=PKW(P0,2), pw0); \
    MKC1(C1); PIN(C1); VRD(4); SBAR(); GAPA(C1=__builtin_amdgcn_mfma_f32_32x32x16_bf16(kf[1],qr[0],C1,0,0,0), P0[6],P0[7],P0[8],P0[9],     pw0[2]=PKW(P0,4), pw0[3]=PKW(P0,6), pw0); \
    VRD(1); SBAR(); GAPA(C0=__builtin_amdgcn_mfma_f32_32x32x16_bf16(kf[2],qr[1],C0,0,0,0),   P0[10],P0[11],P0[12],P0[13], pw1[0]=PKW(P0,8), pw1[1]=PKW(P0,10), pw1); \
    VRD(5); SBAR(); GAPA(C1=__builtin_amdgcn_mfma_f32_32x32x16_bf16(kf[3],qr[1],C1,0,0,0),   P0[14],P0[15],P1[0],P1[1],   pw1[2]=PKW(P0,12),pw1[3]=PKW(P0,14), pw1); \
    VRD(2); SBAR(); GAPA(C0=__builtin_amdgcn_mfma_f32_32x32x16_bf16(kf[4],qr[2],C0,0,0,0),   P1[2],P1[3],P1[4],P1[5],     pw2[0]=PKW(P1,0), pw2[1]=PKW(P1,2), pw2); \
    VRD(6); SBAR(); GAPA(C1=__builtin_amdgcn_mfma_f32_32x32x16_bf16(kf[5],qr[2],C1,0,0,0),   P1[6],P1[7],P1[8],P1[9],     pw2[2]=PKW(P1,4), pw2[3]=PKW(P1,6), pw2); \
    VRD(3); SBAR(); GAPA(C0=__builtin_amdgcn_mfma_f32_32x32x16_bf16(kf[6],qr[3],C0,0,0,0),   P1[10],P1[11],P1[12],P1[13], pw3[0]=PKW(P1,8), pw3[1]=PKW(P1,10), pw3); \
    VRD(7); SBAR(); GAPA(C1=__builtin_amdgcn_mfma_f32_32x32x16_bf16(kf[7],qr[3],C1,0,0,0),   P1[14],P1[15],0.f,0.f,       pw3[2]=PKW(P1,12),pw3[3]=PKW(P1,14), pw3); \
    l_reg+=sacc; \
    if(GK){DMA_K((t)+3,sl_cur);} if(GV){DMA_V((t)+1,sl_next);} \
    CMASK(C0,C1,t); \
    { float a=MX3(C0[0],C0[1],C1[0]),b=MX3(C0[2],C0[3],C1[1]); a=MX3(a,C1[2],C1[3]); \
      _Pragma("unroll") for(int r=4;r<16;r+=4){a=MX3(a,C0[r],C0[r+1]);b=MX3(b,C0[r+2],C0[r+3]);a=MX3(a,C1[r],C1[r+1]);b=MX3(b,C1[r+2],C1[r+3]);} \
      float rm=__builtin_fmaxf(a,b); { auto rr=__builtin_amdgcn_permlane32_swap(__float_as_uint(rm),__float_as_uint(rm),false,false); rm=__builtin_fmaxf(__uint_as_float(rr[0]),__uint_as_float(rr[1])); } \
      resc=false; \
      if(__builtin_expect(__any(rm>(float)THRL),0)){ const float dl=__builtin_fmaxf(rm,0.f); nb-=dl; \
        _Pragma("unroll") for(int r=0;r<16;++r){C0[r]-=dl;C1[r]-=dl;} \
        const float f=__builtin_amdgcn_exp2f(-dl); l_reg*=f; { int l_=lane; asm volatile("":"+v"(l_)); if(l_<32)wsf[l_]=f; } resc=true; } } \
    SBAR(); \
    GAPB(o[0]=__builtin_amdgcn_mfma_f32_32x32x16_bf16(PAF(0),VFR(0),o[0],0,0,0); VRD2(0), C0,0); \
    GAPB(o[1]=__builtin_amdgcn_mfma_f32_32x32x16_bf16(PAF(0),VFR(4),o[1],0,0,0); VRD2(4), C0,2); \
    KRD(GL,0); GAPB(o[0]=__builtin_amdgcn_mfma_f32_32x32x16_bf16(PAF(1),VFR(1),o[0],0,0,0); VRD2(1), C0,4); \
    KRD(GL,1); GAPB(o[1]=__builtin_amdgcn_mfma_f32_32x32x16_bf16(PAF(1),VFR(5),o[1],0,0,0); VRD2(5), C0,6); \
    KRD(GL,2); GAPB(o[0]=__builtin_amdgcn_mfma_f32_32x32x16_bf16(PAF(2),VFR(2),o[0],0,0,0); VRD2(2), C0,8); \
    KRD(GL,3); GAPB(o[1]=__builtin_amdgcn_mfma_f32_32x32x16_bf16(PAF(2),VFR(6),o[1],0,0,0); VRD2(6), C0,10); \
    GAPB(o[0]=__builtin_amdgcn_mfma_f32_32x32x16_bf16(PAF(3),VFR(3),o[0],0,0,0); VRD2(3), C0,12); \
    GAPB(o[1]=__builtin_amdgcn_mfma_f32_32x32x16_bf16(PAF(3),VFR(7),o[1],0,0,0); VRD2(7), C0,14); \
    GAPB(o[2]=__builtin_amdgcn_mfma_f32_32x32x16_bf16(PAF(0),VFR(0),o[2],0,0,0), C1,0); \
    GAPB(o[3]=__builtin_amdgcn_mfma_f32_32x32x16_bf16(PAF(0),VFR(4),o[3],0,0,0), C1,2); \
    GAPB(o[2]=__builtin_amdgcn_mfma_f32_32x32x16_bf16(PAF(1),VFR(1),o[2],0,0,0), C1,4); \
    GAPB(o[3]=__builtin_amdgcn_mfma_f32_32x32x16_bf16(PAF(1),VFR(5),o[3],0,0,0), C1,6); \
    GAPB(o[2]=__builtin_amdgcn_mfma_f32_32x32x16_bf16(PAF(2),VFR(2),o[2],0,0,0), C1,8); \
    GAPB(o[3]=__builtin_amdgcn_mfma_f32_32x32x16_bf16(PAF(2),VFR(6),o[3],0,0,0), C1,10); \
    GAPB(o[2]=__builtin_amdgcn_mfma_f32_32x32x16_bf16(PAF(3),VFR(3),o[2],0,0,0), C1,12); \
    GAPB(o[3]=__builtin_amdgcn_mfma_f32_32x32x16_bf16(PAF(3),VFR(7),o[3],0,0,0), C1,14); \
    }while(0)
  int t=1;
  #undef CMASK
  #define CMASK(P0,P1,t) do{}while(0)
  for(;t+5<NT;t+=2){
    STEP(pB0,pB1,pA0,pA1,t,true,true,true);     WAIT_BAR(3); RESC(); ROT();
    STEP(pA0,pA1,pB0,pB1,t+1,true,true,true);   WAIT_BAR(3); RESC(); ROT();
  }
  #undef CMASK
  #define CMASK(P0,P1,t) do{int jb_=(t)-(NT-4); if(jb_>=0)cmask(P0,P1,jb_,qrel,hi);}while(0)
  #define ENDW(tt) do{ if((tt)+3<NT){WAIT_BAR(3);} else if((tt)+2<NT){WAIT_BAR(2);} else {WAIT_BAR(0);} }while(0)
  for(;t+1<NT;t+=2){
    STEP(pB0,pB1,pA0,pA1,t,(t+3<NT),(t+1<NT),(t+1<NT));       ENDW(t);   RESC(); ROT();
    STEP(pA0,pA1,pB0,pB1,t+1,(t+4<NT),(t+2<NT),(t+2<NT));     ENDW(t+1); RESC(); ROT();
  }
  STEP(pB0,pB1,pA0,pA1,NT-1,false,false,false); RESC();
  { float sacc=pB0[0]+pB0[1]; _Pragma("unroll") for(int r=2;r<16;++r)sacc+=pB0[r]; _Pragma("unroll") for(int r=0;r<16;++r)sacc+=pB1[r]; l_reg+=sacc;
    pw0=(u32x4){PKW(pB0,0),PKW(pB0,2),PKW(pB0,4),PKW(pB0,6)};pw1=(u32x4){PKW(pB0,8),PKW(pB0,10),PKW(pB0,12),PKW(pB0,14)};pw2=(u32x4){PKW(pB1,0),PKW(pB1,2),PKW(pB1,4),PKW(pB1,6)};pw3=(u32x4){PKW(pB1,8),PKW(pB1,10),PKW(pB1,12),PKW(pB1,14)};
    SBAR(); { int l_=lane; asm volatile("":"+v"(l_)); const int vb_=(int)(lds0+LDS_V)+((l_>>4)&1)*32+(l_&3)*8+(4*(l_>>5)+((l_&15)>>2))*64; pv(o,vb_+2*sl_cur,PAF(0),PAF(1),PAF(2),PAF(3)); } }
  #undef PKW
  #undef PAF
  #undef VFR
  #undef PIN
  #undef MX3
  #undef GAPA
  #undef GAPB
  #undef EX
  #undef VRD
  #undef VRD2
  #undef KRD
  #undef STEP
  #undef ENDW
  {auto rr=__builtin_amdgcn_permlane32_swap(__float_as_uint(l_reg),__float_as_uint(l_reg),false,false);l_reg=__uint_as_float(rr[0])+__uint_as_float(rr[1]);}
  if(hi==0)wsf[32+r32]=l_reg;asm volatile("s_waitcnt lgkmcnt(0)":::"memory");
  float rli[16];
  #pragma unroll
  for(int r=0;r<16;++r)rli[r]=__builtin_amdgcn_rcpf(wsf[32+crow(r,hi)]);
  bf16*Ow=O+(rowbase+q0+wid*QBLK)*DM+hv*(2*D);
  { bf16*stg=(bf16*)(shm+LDS_OST)+wid*4096;
    #pragma unroll
    for(int r=0;r<16;++r){const int orow=crow(r,hi);
      #pragma unroll
      for(int d0=0;d0<4;++d0)stg[orow*128+d0*32+r32]=__float2bfloat16(o[d0][r]*rli[r]);}
    asm volatile("s_waitcnt lgkmcnt(0)":::"memory");
    #pragma unroll
    for(int i=0;i<8;++i){const int row=i*4+(lane>>4),ch=lane&15; const u32x4 v=*(const u32x4*)(stg+row*128+ch*8); ATTN_STORE16(Ow+(long)row*DM+ch*8,v);} }
  asm volatile("s_waitcnt lgkmcnt(0)\n\ts_barrier":::"memory");
  #undef DMA_K
  #undef DMA_V
  #undef CMASK
  #undef START
  #undef RESC
  #undef ROT
  #undef MKC0
  #undef MKC1
}
constexpr int ATTN_LDS_BYTES=LDS_BYTES;
template<int THRL=8> __device__ __forceinline__ void attn_phase(char*lds,const bf16*Q,const bf16*K,const bf16*V,bf16*O1,bf16*O2,int vcu,int G,int wave_){
  for(int v=vcu;v<256;v+=G){
    const int j=v>>1,s=v&1,b=j>>3,h=(j&7)>>1,c=j&1;
    const float sl2=__builtin_amdgcn_exp2f(-2.0f*(float)(h+1))*1.4426950408889634f;
    for(int i=NQB/2-1;i>=0;--i){ const int qb=2*i+((i^s)&1); attn_unit<THRL>(b,h*2+c,h,sl2,qb,Q,K,V,c?O2:O1,lds,wave_); }
  }
}
#undef SBAR
#undef WAIT_BAR
}
constexpr int NWAVES = 8;
constexpr int BATCH = 16, SEQ = 4096, DM = 1024, M = BATCH * SEQ;
constexpr int EVEN_IN = 2560, ODD_IN = 6144, DFF = 3584, NEXP = 8;
constexpr float LN_EPS = 1e-5f;
constexpr float DN_ALPHA = 1.6817928305074290f;
constexpr int TSLOTS = 133120;
constexpr float W8_SCALE = 64.f;

constexpr size_t MiB = 1u << 20;
constexpr size_t WS_CTL = 0, CTL_ZERO_BYTES = 64 * 1024;
constexpr size_t WS_TOKE = 1 * MiB;
constexpr size_t WS_TOKG = WS_TOKE + (size_t)M * 2 * 4;
constexpr size_t WS_SLOT = WS_TOKG + (size_t)M * 2 * 4;
constexpr size_t WS_TOKS = WS_SLOT + (size_t)M * 2 * 4;
constexpr size_t WS_GATS = WS_TOKS + (size_t)TSLOTS * 4;
constexpr size_t WS_WCNT = WS_GATS + (size_t)TSLOTS * 4;
constexpr size_t WS_TILE = WS_WCNT + (size_t)2048 * 8 * 4;
constexpr size_t WS_WSB = 8 * MiB;
constexpr size_t WS_SA = 9 * MiB;
constexpr size_t WS_SAS = 9 * MiB + 512 * 1024;
constexpr size_t WS_SW = 10 * MiB;
constexpr int SW_EIN = 0, SW_E13 = 4096, SW_OIN = 12288, SW_M13 = 20480, SW_OWO = 77824, SW_EWO = 78848;
constexpr size_t A_PMAX = 768 * MiB;
constexpr int PM_WIN = 0, PM_A = 6144 * 16, PM_B = PM_A + 8 * 3584 * 16, PM_WO = PM_B + 8 * 3584 * 16, PMAX_FLOATS = PM_WO + 1024 * 32;
static_assert((size_t)2 * PMAX_FLOATS * 4 <= 8 * MiB, "PMAX");
constexpr size_t WS_WB = 16 * MiB;
constexpr size_t WB_E_IN = 0, WB_E_O = 5 * MiB, WB_E_13 = 7 * MiB, WB_E_2 = 21 * MiB;
constexpr size_t WB_O_IN = 0, WB_O_O = 12 * MiB, WB_O_13 = 16 * MiB, WB_O_2 = 72 * MiB, WB_XQ = 104 * MiB;
constexpr size_t WS_XB = 200 * MiB;
constexpr size_t WS_ACT = 328 * MiB;
constexpr size_t A_U = 0, A_V = 64 * MiB, A_Q = 128 * MiB, A_K = 192 * MiB, A_VA = 256 * MiB, A_O1 = 320 * MiB, A_O2 = 384 * MiB, A_MIX = 448 * MiB, A_MIX8 = 640 * MiB, A_H = 0;
constexpr size_t AO_Q = 0, AO_K = 128 * MiB, AO_V = 256 * MiB, AO_G = 512 * MiB;
constexpr size_t AM_H = 0, AM_OUT = 462 * MiB;
constexpr size_t WS_END = 1104 * MiB;
static_assert(WS_TILE + 2 * 320 * 4 <= WS_WSB, "ws map");
static_assert((size_t)TSLOTS * DFF <= 462 * MiB && AM_OUT + (size_t)TSLOTS * 1024 * 2 <= 776 * MiB && WB_XQ + (size_t)M * DM <= 184 * MiB, "ws map");
constexpr int CW_BAR = 4096;

constexpr int RING_OFF = 0, RING_BYTES = 143360;
constexpr int LDSCTL_OFF = RING_BYTES;
constexpr int LDS_BYTES = 147456;

#define GAS __attribute__((address_space(1)))
#define LAS __attribute__((address_space(3)))
typedef unsigned short bf16;
typedef unsigned v4u __attribute__((ext_vector_type(4)));
typedef unsigned v2u __attribute__((ext_vector_type(2)));
typedef float f32x4 __attribute__((ext_vector_type(4)));
typedef short bf16x8 __attribute__((ext_vector_type(8)));
typedef short s16x4 __attribute__((ext_vector_type(4)));
#define LDS_WAIT() asm volatile("s_waitcnt lgkmcnt(0)" ::: "memory")
#define VM_WAIT() asm volatile("s_waitcnt vmcnt(0)" ::: "memory")
typedef float f32x2_t __attribute__((ext_vector_type(2))); typedef __bf16 bf16x2_t __attribute__((ext_vector_type(2)));
__device__ __forceinline__ unsigned pk2(float lo, float hi) { f32x2_t v = {lo, hi}; bf16x2_t b = __builtin_convertvector(v, bf16x2_t); return __builtin_bit_cast(unsigned, b); }
__device__ __forceinline__ unsigned f2bf(float f) { return pk2(f, f) & 0xffffu; }
__device__ __forceinline__ float bflo(unsigned w) { return __uint_as_float(w << 16); }
__device__ __forceinline__ float bfhi(unsigned w) { return __uint_as_float(w & 0xffff0000u); }
__device__ __forceinline__ float bf2f(bf16 b) { return __uint_as_float(((unsigned)b) << 16); }
__device__ __forceinline__ int lane_id_opaque() { int l; asm volatile("v_mbcnt_lo_u32_b32 %0, -1, 0\n\tv_mbcnt_hi_u32_b32 %0, -1, %0" : "=v"(l)); return l; }
__device__ __forceinline__ size_t tiled_off(int row, int col, int NT) { return ((size_t)((row >> 8) * NT + (col >> 8)) * 8 + ((col >> 5) & 7)) * 8192 + (size_t)(row & 255) * 32 + (col & 31); }
__device__ __forceinline__ float wave_sum(float v) {
#pragma unroll
    for (int o = 1; o < 64; o <<= 1) v += __shfl_xor(v, o);
    return v;
}

#define XB_TMO      128
#define XB_XCNT(j)  (256  + 64 * (j))
#define XB_XSUB(j)  (1280 + 64 * (j))
#define XB_XGEN(j)  (2304 + 64 * (j))
#define XB_TOP      3328
#define XB_TOPGEN   3392
#define XCD_BAR_WORDS 3456
#define XB_SPIN_CAP (1u << 18)

__device__ __forceinline__ unsigned xb_ld(unsigned* p)              { return __hip_atomic_load(p, __ATOMIC_RELAXED, __HIP_MEMORY_SCOPE_AGENT); }
__device__ __forceinline__ unsigned xb_add(unsigned* p, unsigned v) { return __hip_atomic_fetch_add(p, v, __ATOMIC_RELAXED, __HIP_MEMORY_SCOPE_AGENT); }
__device__ __forceinline__ unsigned xb_xcc_id() { return (unsigned)__builtin_amdgcn_s_getreg((3 << 11) | 20) & 0xFu; }
#define XB_SPIN(cond, bar) do { unsigned _sp = 0; while (cond) { __builtin_amdgcn_s_sleep(1); \
    if ((++_sp & 255u) == 0u) { if (xb_ld(&(bar)[XB_TMO])) break; if (_sp > XB_SPIN_CAP) { atomicAdd(&(bar)[XB_TMO], 1u); break; } } } } while (0)

struct XcdBarrier {
    unsigned* bar; unsigned x;
    volatile LAS unsigned* st;
};

__device__ __forceinline__ XcdBarrier xcd_barrier_post(unsigned* bar, volatile LAS unsigned* st) {
    XcdBarrier b; b.bar = bar; b.x = xb_xcc_id(); b.st = st;
    if (threadIdx.x == 0) (void)xb_add(&bar[XB_XCNT(b.x)], 1u);
    return b;
}
__device__ __forceinline__ void xcd_barrier_complete(unsigned* bar, unsigned x, unsigned& nloc, unsigned& nx) {
    const unsigned G = gridDim.x * gridDim.y * gridDim.z;
    unsigned sum, cnt, mine, sp = 0u;
    for (;;) {
        sum = 0u; cnt = 0u; mine = 0u;
#pragma unroll
        for (unsigned j = 0; j < 16; ++j) { const unsigned c = xb_ld(&bar[XB_XCNT(j)]); sum += c; cnt += (c > 0u) ? 1u : 0u; mine = (j == x) ? c : mine; }
        if (sum == G) break;
        __builtin_amdgcn_s_sleep(1);
        if ((++sp & 255u) == 0u) { if (xb_ld(&bar[XB_TMO])) break; if (sp > XB_SPIN_CAP) { atomicAdd(&bar[XB_TMO], 1u); break; } }
    }
    nloc = mine > 0u ? mine : 1u; nx = cnt > 0u ? cnt : 1u;
}

__device__ __forceinline__ void xcd_barrier(const XcdBarrier& b) {
    asm volatile("s_waitcnt vmcnt(0)" ::: "memory");
    __syncthreads();
    if (threadIdx.x == 0) {
        unsigned* bar = b.bar;
        __builtin_amdgcn_s_waitcnt(0);
        unsigned nloc = b.st[0], nx = b.st[1];
        if (nloc == 0u) { xcd_barrier_complete(bar, b.x, nloc, nx); b.st[0] = nloc; b.st[1] = nx; }
        const unsigned old = xb_add(&bar[XB_XSUB(b.x)], 1u);
        const unsigned gen = old / nloc;
        if (old + 1u == (gen + 1u) * nloc) {
            __builtin_amdgcn_fence(__ATOMIC_RELEASE, "agent");
            asm volatile("s_waitcnt vmcnt(0)" ::: "memory");
            const unsigned og = xb_add(&bar[XB_TOP], 1u);
            const unsigned tg = og / nx;
            if (og + 1u == (tg + 1u) * nx) xb_add(&bar[XB_TOPGEN], 1u);
            else XB_SPIN(xb_ld(&bar[XB_TOPGEN]) == tg, bar);
            __builtin_amdgcn_fence(__ATOMIC_ACQUIRE, "agent");
            xb_add(&bar[XB_XGEN(b.x)], 1u);
            asm volatile("s_waitcnt vmcnt(0)" ::: "memory");
        } else {
            XB_SPIN(xb_ld(&bar[XB_XGEN(b.x)]) == gen, bar);
            __builtin_amdgcn_fence(__ATOMIC_ACQUIRE, "agent");
            asm volatile("s_waitcnt vmcnt(0)" ::: "memory");
        }
    }
    __syncthreads();
}

struct Frame {
    LAS unsigned char* lds;
    int wave;
    int vcu, G;
};

__device__ __forceinline__ void conv_item(const float* W, int K, int N, bf16* WT, int rstride, int roff, LAS float* scr, int item, int lane) {
    const int nblk = N / 32, kb = item / nblk, nb = item % nblk, k0 = 64 * kb, n0 = 32 * nb;
    { float wv[32]; const float* wp = W + (size_t)(k0 + (lane >> 5)) * N + n0 + (lane & 31);
#pragma unroll
      for (int i = 0; i < 32; ++i) wv[i] = wp[(size_t)(2 * i) * N];
#pragma unroll
      for (int i = 0; i < 32; ++i) scr[(2 * i + (lane >> 5)) * 33 + (lane & 31)] = wv[i]; }
    LDS_WAIT(); asm volatile("" ::: "memory");
    const int c = lane & 7;
#pragma unroll
    for (int j = 0; j < 4; ++j) { const int n = (lane >> 3) + 8 * j; const LAS float* s = scr + (8 * c) * 33 + n;
        v4u o; o.x = pk2(s[0 * 33], s[1 * 33]); o.y = pk2(s[2 * 33], s[3 * 33]); o.z = pk2(s[4 * 33], s[5 * 33]); o.w = pk2(s[6 * 33], s[7 * 33]);
        const int ng = n0 + n, drow = (ng >> 7) * rstride + roff + (ng & 127);
        *(GAS v4u*)(WT + (size_t)drow * K + k0 + 8 * c) = o; }
    LDS_WAIT(); asm volatile("" ::: "memory");
}
__device__ __forceinline__ void conv_item8(const float* W, int K, int N, unsigned char* WT, int rstride, int roff, float scale, LAS float* scr, int item, int lane) {
    const int nblk = N / 32, kb = item / nblk, nb = item % nblk, k0 = 64 * kb, n0 = 32 * nb;
    { float wv[32]; const float* wp = W + (size_t)(k0 + (lane >> 5)) * N + n0 + (lane & 31);
#pragma unroll
      for (int i = 0; i < 32; ++i) wv[i] = wp[(size_t)(2 * i) * N];
#pragma unroll
      for (int i = 0; i < 32; ++i) scr[(2 * i + (lane >> 5)) * 33 + (lane & 31)] = wv[i]; }
    LDS_WAIT(); asm volatile("" ::: "memory");
    const int c = lane & 7;
#pragma unroll
    for (int j = 0; j < 4; ++j) { const int n = (lane >> 3) + 8 * j; const LAS float* s = scr + (8 * c) * 33 + n;
        int w0 = 0, w1 = 0;
        w0 = __builtin_amdgcn_cvt_pk_fp8_f32(s[0 * 33] * scale, s[1 * 33] * scale, w0, false); w0 = __builtin_amdgcn_cvt_pk_fp8_f32(s[2 * 33] * scale, s[3 * 33] * scale, w0, true);
        w1 = __builtin_amdgcn_cvt_pk_fp8_f32(s[4 * 33] * scale, s[5 * 33] * scale, w1, false); w1 = __builtin_amdgcn_cvt_pk_fp8_f32(s[6 * 33] * scale, s[7 * 33] * scale, w1, true);
        const int ng = n0 + n, drow = (ng >> 7) * rstride + roff + (ng & 127);
        v2u o; o.x = (unsigned)w0; o.y = (unsigned)w1; *(GAS v2u*)(WT + (size_t)drow * K + k0 + 8 * c) = o; }
    LDS_WAIT(); asm volatile("" ::: "memory");
}
__device__ __forceinline__ int rni8(float x) { return (int)__builtin_rintf(x); }
__device__ __forceinline__ void conv_item_max(const float* W, int K, int N, float* PMAX, int item, int lane) {
    const int nblk = N / 32, kb = item / nblk, nb = item % nblk, k0 = 64 * kb, n0 = 32 * nb;
    const float* wp = W + (size_t)(k0 + (lane >> 5)) * N + n0 + (lane & 31); float wv[32];
#pragma unroll
    for (int i = 0; i < 32; ++i) wv[i] = wp[(size_t)(2 * i) * N];
    float cmax = 0.f;
#pragma unroll
    for (int i = 0; i < 32; ++i) cmax = fmaxf(cmax, fabsf(wv[i]));
    cmax = fmaxf(cmax, __shfl_xor(cmax, 32));
    if (lane < 32) PMAX[(size_t)kb * N + n0 + lane] = cmax;
}
template <int NB = 16> __device__ __forceinline__ void conv_item_q(const float* W, int K, int N, signed char* WT, float* SW, const float* PMAX, int rstride, int roff, LAS float* scr, int item, int lane) {
    const int nblk = N / 32, kb = item / nblk, nb = item % nblk, k0 = 64 * kb, n0 = 32 * nb;
    float wv[32], pm[NB]; const float* wp = W + (size_t)(k0 + (lane >> 5)) * N + n0 + (lane & 31);
#pragma unroll
    for (int i = 0; i < 32; ++i) wv[i] = wp[(size_t)(2 * i) * N];
#pragma unroll
    for (int b = 0; b < NB; ++b) pm[b] = PMAX[(size_t)b * N + n0 + (lane & 31)];
    float cmax = 0.f;
#pragma unroll
    for (int b = 0; b < NB; ++b) cmax = fmaxf(cmax, pm[b]);
    const float inv = cmax > 0.f ? 127.f / cmax : 0.f;
    if (kb == 0 && lane < 32) { const int ng = n0 + lane, drow = (ng >> 7) * rstride + roff + (ng & 127); SW[drow] = cmax > 0.f ? cmax * (1.f / 127.f) : 1.f; }
    {
#pragma unroll
      for (int i = 0; i < 32; ++i) scr[(2 * i + (lane >> 5)) * 33 + (lane & 31)] = wv[i] * inv; }
    LDS_WAIT(); asm volatile("" ::: "memory");
    const int c = lane & 7;
#pragma unroll
    for (int j = 0; j < 4; ++j) { const int n = (lane >> 3) + 8 * j; const LAS float* s = scr + (8 * c) * 33 + n;
        const unsigned w0 = (unsigned)(rni8(s[0 * 33]) & 255) | ((unsigned)(rni8(s[1 * 33]) & 255) << 8) | ((unsigned)(rni8(s[2 * 33]) & 255) << 16) | ((unsigned)rni8(s[3 * 33]) << 24);
        const unsigned w1 = (unsigned)(rni8(s[4 * 33]) & 255) | ((unsigned)(rni8(s[5 * 33]) & 255) << 8) | ((unsigned)(rni8(s[6 * 33]) & 255) << 16) | ((unsigned)rni8(s[7 * 33]) << 24);
        const int ng = n0 + n, drow = (ng >> 7) * rstride + roff + (ng & 127);
        v2u o; o.x = w0; o.y = w1; *(GAS v2u*)(WT + (size_t)drow * K + k0 + 8 * c) = o; }
    LDS_WAIT(); asm volatile("" ::: "memory");
}
struct ConvJob { const float* W; bf16* WT; int K, N, rstride, roff, nitems; float f8scale; float* SW; float* PMAX; int kind; };
template <int NJ> __device__ __forceinline__ void conv_jobs(Frame& F, const ConvJob (&J)[NJ]) {
    const int tid_ = F.wave * 64 + lane_id_opaque(); const int lane = tid_ & 63;
    LAS float* scr = (LAS float*)(F.lds + RING_OFF + F.wave * 16384);
    const int gw = F.vcu * NWAVES + F.wave, NGW = F.G * NWAVES;
    int total = 0;
#pragma unroll
    for (int j = 0; j < NJ; ++j) total += J[j].nitems;
    for (int it = gw; it < total; it += NGW) {
        int r = it;
#pragma unroll
        for (int j = 0; j < NJ; ++j) { if (r >= 0 && r < J[j].nitems) { if (J[j].kind == 1) conv_item8(J[j].W, J[j].K, J[j].N, (unsigned char*)J[j].WT, J[j].rstride, J[j].roff, J[j].f8scale, scr, r, lane); else conv_item(J[j].W, J[j].K, J[j].N, J[j].WT, J[j].rstride, J[j].roff, scr, r, lane); } r -= J[j].nitems; }
    }
}
__device__ __forceinline__ void conv_wo_max(Frame& F, const float* W, float* PMAX) {
    const int lane = lane_id_opaque(); const int gw = F.vcu * NWAVES + F.wave, NGW = F.G * NWAVES;
    for (int it = gw; it < (2 * DM / 64) * (DM / 32); it += NGW) conv_item_max(W, 2 * DM, DM, PMAX, it, lane);
}
__device__ __forceinline__ void conv_wo_q(Frame& F, const float* W, signed char* WT, float* SW, const float* PMAX) {
    const int lane = lane_id_opaque(); const int gw = F.vcu * NWAVES + F.wave, NGW = F.G * NWAVES;
    LAS float* scr = (LAS float*)(F.lds + RING_OFF + F.wave * 16384);
    for (int it = gw; it < (2 * DM / 64) * (DM / 32); it += NGW) conv_item_q<32>(W, 2 * DM, DM, WT, SW, PMAX, 128, 0, scr, it, lane);
}

struct QSet { const float* Win; int Nin; signed char* WinT; float* SWin; const float* W1; const float* W3; int nexp; signed char* W13T; float* SW13; const float* Wo = nullptr; signed char* WoT = nullptr; float* SWo = nullptr; };
__device__ __forceinline__ void conv_q1024(Frame& F, const QSet S) {
    const int tid_ = F.wave * 64 + lane_id_opaque(); const int tid = tid_;
    LAS float* D = (LAS float*)(F.lds + RING_OFF); LAS float* RED = D + 1024 * 32;
    const int nin = S.Nin / 32, nwo = S.Wo != nullptr ? DM / 32 : 0, nff = DFF / 32, total = nin + nwo + S.nexp * 2 * nff;
    f32x4 pre[16];
#define QITEM(it_) const float* W_; int N_, n0_, rs_, ro_; signed char* WT_; float* SW_; \
    if ((it_) < nin) { W_ = S.Win; N_ = S.Nin; n0_ = 32 * (it_); WT_ = S.WinT; SW_ = S.SWin; rs_ = 128; ro_ = 0; } \
    else if ((it_) < nin + nwo) { W_ = S.Wo; N_ = DM; n0_ = 32 * ((it_) - nin); WT_ = S.WoT; SW_ = S.SWo; rs_ = 128; ro_ = 0; } \
    else { const int r_ = (it_) - nin - nwo, e_ = r_ / (2 * nff), q_ = r_ - e_ * 2 * nff, wh_ = q_ >= nff ? 1 : 0; W_ = (wh_ ? S.W3 : S.W1) + (size_t)e_ * DM * DFF; N_ = DFF; n0_ = 32 * (q_ - wh_ * nff); \
           WT_ = S.W13T + (size_t)e_ * 2 * DFF * DM; SW_ = S.SW13 + e_ * 2 * DFF; rs_ = 256; ro_ = 128 * wh_; } \
    (void)W_; (void)N_; (void)n0_; (void)rs_; (void)ro_; (void)WT_; (void)SW_
#define QLOAD(it_) do { QITEM(it_); const float* p_ = W_ + (size_t)(tid >> 3) * N_ + n0_ + (tid & 7) * 4; \
        _Pragma("unroll") for (int j = 0; j < 16; ++j) pre[j] = *(const f32x4*)(p_ + (size_t)(64 * j) * N_); } while (0)
    int it = F.vcu;
    __syncthreads();
    if (it < total) QLOAD(it);
    for (; it < total; it += F.G) {
#pragma unroll
        for (int j = 0; j < 16; ++j) *(LAS f32x4*)(D + (64 * j + (tid >> 3)) * 32 + (tid & 7) * 4) = pre[j];
        __syncthreads();
        if (it + F.G < total) QLOAD(it + F.G);
        const int c = tid & 31, g = tid >> 5;
        float v[64]; float pm = 0.f;
#pragma unroll
        for (int i = 0; i < 64; ++i) { v[i] = D[(64 * g + i) * 32 + c]; pm = fmaxf(pm, fabsf(v[i])); }
        RED[g * 32 + c] = pm;
        __syncthreads();
        float cmax = 0.f;
#pragma unroll
        for (int q = 0; q < 16; ++q) cmax = fmaxf(cmax, RED[q * 32 + c]);
        const float inv = cmax > 0.f ? 127.f / cmax : 0.f;
        QITEM(it);
        const int ng = n0_ + c, drow = (ng >> 7) * rs_ + ro_ + (ng & 127);
        if (g == 0) SW_[drow] = cmax > 0.f ? cmax * (1.f / 127.f) : 1.f;
        v4u* op = (v4u*)(WT_ + (size_t)drow * 1024 + 64 * g);
#pragma unroll
        for (int s4 = 0; s4 < 4; ++s4) { unsigned d[4];
#pragma unroll
            for (int j = 0; j < 4; ++j) { const int b = 16 * s4 + 4 * j;
                d[j] = (unsigned)(rni8(v[b] * inv) & 255) | ((unsigned)(rni8(v[b + 1] * inv) & 255) << 8) | ((unsigned)(rni8(v[b + 2] * inv) & 255) << 16) | ((unsigned)rni8(v[b + 3] * inv) << 24); }
            v4u w; w.x = d[0]; w.y = d[1]; w.z = d[2]; w.w = d[3]; op[s4] = w; }
    }
    __syncthreads();
#undef QLOAD
#undef QITEM
}

template <int SRC, bool ROUTE, bool FINAL>
__device__ __forceinline__ void ln_phase(Frame& F, const float* Y, bf16* XB, float* OUT, const float* gam, const float* bet,
                                         const bf16* OUTB, const int* slot_of_tok,
                                         const float* rw, const float* rb, int* tok_e, float* tok_g, int* wvcnt, signed char* XQ = nullptr, float* SA = nullptr) {
    const int tid_ = F.wave * 64 + lane_id_opaque(); const int lane = tid_ & 63, gw = blockIdx.x * NWAVES + F.wave, NGW = F.G * NWAVES;
    f32x4 g4[4], b4[4];
#pragma unroll
    for (int j = 0; j < 4; ++j) { g4[j] = *(const f32x4*)(gam + 4 * lane + 256 * j); b4[j] = *(const f32x4*)(bet + 4 * lane + 256 * j); }
    float rwv[ROUTE ? 16 : 1][8]; int cnt[8];
    if constexpr (ROUTE) {
#pragma unroll
        for (int j = 0; j < 4; ++j)
#pragma unroll
            for (int c = 0; c < 4; ++c) { const f32x4 a = *(const f32x4*)(rw + (size_t)(4 * lane + 256 * j + c) * 8), b = *(const f32x4*)(rw + (size_t)(4 * lane + 256 * j + c) * 8 + 4);
                rwv[j * 4 + c][0] = a[0]; rwv[j * 4 + c][1] = a[1]; rwv[j * 4 + c][2] = a[2]; rwv[j * 4 + c][3] = a[3]; rwv[j * 4 + c][4] = b[0]; rwv[j * 4 + c][5] = b[1]; rwv[j * 4 + c][6] = b[2]; rwv[j * 4 + c][7] = b[3]; }
#pragma unroll
        for (int e = 0; e < 8; ++e) cnt[e] = 0;
    }
    const int rows_per = M / NGW;
    for (int i = 0; i < rows_per; ++i) {
        const int row = ROUTE ? gw * rows_per + i : gw + i * NGW;
        f32x4 v[4];
        if constexpr (SRC == 0 || SRC == 3) {
            const f32x4* yr = (const f32x4*)(Y + (size_t)row * DM) + lane;
#pragma unroll
            for (int j = 0; j < 4; ++j) v[j] = yr[64 * j];
        } else if constexpr (SRC == 2) {
            const v2u* xr = (const v2u*)(XB + (size_t)row * DM) + lane;
#pragma unroll
            for (int j = 0; j < 4; ++j) { const v2u a = xr[64 * j]; v[j][0] = bflo(a.x); v[j][1] = bfhi(a.x); v[j][2] = bflo(a.y); v[j][3] = bfhi(a.y); }
        } else {
            const int s0 = slot_of_tok[2 * row], s1 = slot_of_tok[2 * row + 1];
            const v2u* xr = (const v2u*)(XB + (size_t)row * DM) + lane; const v2u* o0 = (const v2u*)(OUTB + (size_t)s0 * DM) + lane; const v2u* o1 = (const v2u*)(OUTB + (size_t)s1 * DM) + lane;
#pragma unroll
            for (int j = 0; j < 4; ++j) { const v2u a = xr[64 * j], p = o0[64 * j], q = o1[64 * j];
                v[j][0] = DN_ALPHA * bflo(a.x) + (bflo(p.x) + bflo(q.x)); v[j][1] = DN_ALPHA * bfhi(a.x) + (bfhi(p.x) + bfhi(q.x));
                v[j][2] = DN_ALPHA * bflo(a.y) + (bflo(p.y) + bflo(q.y)); v[j][3] = DN_ALPHA * bfhi(a.y) + (bfhi(p.y) + bfhi(q.y)); }
        }
        float s = 0.f;
#pragma unroll
        for (int j = 0; j < 4; ++j) s += (v[j][0] + v[j][1]) + (v[j][2] + v[j][3]);
        if constexpr (SRC != 3) {
        const float mean = wave_sum(s) * (1.f / DM); float s2 = 0.f;
#pragma unroll
        for (int j = 0; j < 4; ++j) { v[j] = v[j] - mean; s2 += (v[j][0] * v[j][0] + v[j][1] * v[j][1]) + (v[j][2] * v[j][2] + v[j][3] * v[j][3]); }
        const float rstd = 1.f / sqrtf(wave_sum(s2) * (1.f / DM) + LN_EPS);
#pragma unroll
        for (int j = 0; j < 4; ++j) v[j] = v[j] * rstd * g4[j] + b4[j];
        }
        if constexpr (!FINAL) {
            float am = 0.f;
#pragma unroll
            for (int j = 0; j < 4; ++j) am = fmaxf(fmaxf(am, fmaxf(fabsf(v[j][0]), fabsf(v[j][1]))), fmaxf(fabsf(v[j][2]), fabsf(v[j][3])));
#pragma unroll
            for (int o = 1; o < 64; o <<= 1) am = fmaxf(am, __shfl_xor(am, o));
            const float inv = am > 0.f ? 127.f / am : 0.f;
            unsigned* oq = (unsigned*)(XQ + (size_t)row * DM) + lane;
#pragma unroll
            for (int j = 0; j < 4; ++j) oq[64 * j] = (unsigned)(rni8(v[j][0] * inv) & 255) | ((unsigned)(rni8(v[j][1] * inv) & 255) << 8) | ((unsigned)(rni8(v[j][2] * inv) & 255) << 16) | ((unsigned)rni8(v[j][3] * inv) << 24);
            if (lane == 0) SA[row] = am > 0.f ? am * (1.f / 127.f) : 1.f;
        }
        if constexpr (FINAL) {
            f32x4* o = (f32x4*)(OUT + (size_t)row * DM) + lane;
#pragma unroll
            for (int j = 0; j < 4; ++j) o[64 * j] = v[j];
        } else if constexpr (SRC != 3) {
            v2u* o = (v2u*)(XB + (size_t)row * DM) + lane;
#pragma unroll
            for (int j = 0; j < 4; ++j) { v2u w; w.x = pk2(v[j][0], v[j][1]); w.y = pk2(v[j][2], v[j][3]); o[64 * j] = w; }
        }
        if constexpr (ROUTE) {
            float lg[8];
#pragma unroll
            for (int e = 0; e < 8; ++e) { float a = 0.f;
#pragma unroll
                for (int j = 0; j < 4; ++j)
#pragma unroll
                    for (int c = 0; c < 4; ++c) a += v[j][c] * rwv[j * 4 + c][e];
                lg[e] = wave_sum(a) + rb[e]; }
            int e0 = 0; float v0 = lg[0];
#pragma unroll
            for (int e = 1; e < 8; ++e) if (lg[e] > v0) { v0 = lg[e]; e0 = e; }
            int e1 = -1; float v1 = -INFINITY;
#pragma unroll
            for (int e = 0; e < 8; ++e) if (e != e0 && lg[e] > v1) { v1 = lg[e]; e1 = e; }
            const float p1 = 1.f / (1.f + __expf(v0 - v1)), p0 = 1.f - p1;
#pragma unroll
            for (int e = 0; e < 8; ++e) cnt[e] += (e == e0 || e == e1) ? 1 : 0;
            if (lane == 0) { tok_e[2 * row] = e0; tok_e[2 * row + 1] = e1; tok_g[2 * row] = p0; tok_g[2 * row + 1] = p1; }
        }
    }
    if constexpr (ROUTE) { if (lane < 8) { int c = 0;
#pragma unroll
            for (int e = 0; e < 8; ++e) c = (lane == e) ? cnt[e] : c;
            wvcnt[gw * 8 + lane] = c; } }
}

template <bool ROUTE>
__device__ __forceinline__ void panel_ln(Frame& F, bf16* XB, const float* gam, const float* bet,
                                         const float* rw, const float* rb, int* tok_e, float* tok_g, int* wvcnt) {
    const int tid_ = F.wave * 64 + lane_id_opaque(); const int lane = tid_ & 63, wave = F.wave;
    asm volatile("s_waitcnt vmcnt(0)" ::: "memory");
    __syncthreads();
    f32x4 g4[4], b4[4];
#pragma unroll
    for (int j = 0; j < 4; ++j) { g4[j] = *(const f32x4*)(gam + 4 * lane + 256 * j); b4[j] = *(const f32x4*)(bet + 4 * lane + 256 * j); }
    float rwv[ROUTE ? 16 : 1][8]; int cnt[8];
    if constexpr (ROUTE) {
#pragma unroll
        for (int j = 0; j < 4; ++j)
#pragma unroll
            for (int c = 0; c < 4; ++c) { const f32x4 a = *(const f32x4*)(rw + (size_t)(4 * lane + 256 * j + c) * 8), b = *(const f32x4*)(rw + (size_t)(4 * lane + 256 * j + c) * 8 + 4);
                rwv[j * 4 + c][0] = a[0]; rwv[j * 4 + c][1] = a[1]; rwv[j * 4 + c][2] = a[2]; rwv[j * 4 + c][3] = a[3]; rwv[j * 4 + c][4] = b[0]; rwv[j * 4 + c][5] = b[1]; rwv[j * 4 + c][6] = b[2]; rwv[j * 4 + c][7] = b[3]; }
#pragma unroll
        for (int e = 0; e < 8; ++e) cnt[e] = 0;
    }
    const int gw = blockIdx.x * NWAVES + wave;
    for (int i = 0; i < 32; ++i) {
        const int row = blockIdx.x * 256 + wave * 32 + i;
        v2u* xr = (v2u*)(XB + (size_t)row * DM) + lane; f32x4 v[4]; float s = 0.f;
#pragma unroll
        for (int j = 0; j < 4; ++j) { const v2u a = xr[64 * j]; v[j][0] = bflo(a.x); v[j][1] = bfhi(a.x); v[j][2] = bflo(a.y); v[j][3] = bfhi(a.y); s += (v[j][0] + v[j][1]) + (v[j][2] + v[j][3]); }
        const float mean = wave_sum(s) * (1.f / DM); float s2 = 0.f;
#pragma unroll
        for (int j = 0; j < 4; ++j) { v[j] = v[j] - mean; s2 += (v[j][0] * v[j][0] + v[j][1] * v[j][1]) + (v[j][2] * v[j][2] + v[j][3] * v[j][3]); }
        const float rstd = 1.f / sqrtf(wave_sum(s2) * (1.f / DM) + LN_EPS);
#pragma unroll
        for (int j = 0; j < 4; ++j) v[j] = v[j] * rstd * g4[j] + b4[j];
#pragma unroll
        for (int j = 0; j < 4; ++j) { v2u w; w.x = pk2(v[j][0], v[j][1]); w.y = pk2(v[j][2], v[j][3]); xr[64 * j] = w; }
        if constexpr (ROUTE) {
            float lg[8];
#pragma unroll
            for (int e = 0; e < 8; ++e) { float a = 0.f;
#pragma unroll
                for (int j = 0; j < 4; ++j)
#pragma unroll
                    for (int c = 0; c < 4; ++c) a += v[j][c] * rwv[j * 4 + c][e];
                lg[e] = wave_sum(a) + rb[e]; }
            int e0 = 0; float v0 = lg[0];
#pragma unroll
            for (int e = 1; e < 8; ++e) if (lg[e] > v0) { v0 = lg[e]; e0 = e; }
            int e1 = -1; float v1 = -INFINITY;
#pragma unroll
            for (int e = 0; e < 8; ++e) if (e != e0 && lg[e] > v1) { v1 = lg[e]; e1 = e; }
            const float p1 = 1.f / (1.f + __expf(v0 - v1)), p0 = 1.f - p1;
#pragma unroll
            for (int e = 0; e < 8; ++e) cnt[e] += (e == e0 || e == e1) ? 1 : 0;
            if (lane == 0) { tok_e[2 * row] = e0; tok_e[2 * row + 1] = e1; tok_g[2 * row] = p0; tok_g[2 * row + 1] = p1; }
        }
    }
    if constexpr (ROUTE) { if (lane < 8) { int c = 0;
#pragma unroll
            for (int e = 0; e < 8; ++e) c = (lane == e) ? cnt[e] : c;
            wvcnt[gw * 8 + lane] = c; } }
    __syncthreads();
}

__device__ __forceinline__ void assign_phase(Frame& F, const int* wvcnt, const int* tok_e, const float* tok_g, int* slot_of_tok, int* tok_of_slot, float* gate_of_slot, int* tiles, const float* SA, float* SAS) {
    LAS int* sh = (LAS int*)(F.lds + RING_OFF);
    const int tid_ = F.wave * 64 + lane_id_opaque(); const int tid = tid_, lane = tid & 63, wave = F.wave;
    const int gw0 = blockIdx.x * NWAVES;
    int tot[8], pre[8];
#pragma unroll
    for (int e = 0; e < 8; ++e) { tot[e] = 0; pre[e] = 0; }
#pragma unroll
    for (int k = 0; k < 4; ++k) { const int w = 4 * tid + k; const v4u* pp = (const v4u*)(wvcnt + (size_t)w * 8); const v4u a0 = pp[0], a1 = pp[1];
        const int cc[8] = {(int)a0.x, (int)a0.y, (int)a0.z, (int)a0.w, (int)a1.x, (int)a1.y, (int)a1.z, (int)a1.w};
#pragma unroll
        for (int e = 0; e < 8; ++e) { tot[e] += cc[e]; pre[e] += (w < gw0) ? cc[e] : 0; } }
#pragma unroll
    for (int e = 0; e < 8; ++e) {
#pragma unroll
        for (int o = 1; o < 64; o <<= 1) { tot[e] += __shfl_xor(tot[e], o); pre[e] += __shfl_xor(pre[e], o); } }
    if (lane == 0) {
#pragma unroll
        for (int e = 0; e < 8; ++e) { sh[wave * 16 + e] = tot[e]; sh[wave * 16 + 8 + e] = pre[e]; } }
    __syncthreads();
    int T[8], P[8], EB[8];
#pragma unroll
    for (int e = 0; e < 8; ++e) { int a = 0, b = 0;
#pragma unroll
        for (int w = 0; w < 8; ++w) { a += sh[w * 16 + e]; b += sh[w * 16 + 8 + e]; }
        T[e] = a; P[e] = b; }
    { int acc = 0;
#pragma unroll
      for (int e = 0; e < 8; ++e) { EB[e] = acc; acc += (T[e] + 255) & ~255; }
      if (blockIdx.x == 0) {
          const int ntile = acc >> 8;
          if (tid == 0) tiles[0] = ntile;
          for (int t = tid; t < ntile; t += NWAVES * 64) { int ex = 0;
#pragma unroll
              for (int e = 1; e < 8; ++e) if (t * 256 >= EB[e]) ex = e;
              tiles[16 + t] = ex; }
#pragma unroll
          for (int e = 0; e < 8; ++e) { const int lo = EB[e] + T[e], hi = EB[e] + ((T[e] + 255) & ~255);
              for (int s = lo + tid; s < hi; s += NWAVES * 64) { tok_of_slot[s] = 0; gate_of_slot[s] = 0.f; SAS[s] = 1.f; } } } }
    int WP[8];
#pragma unroll
    for (int e = 0; e < 8; ++e) WP[e] = 0;
    for (int w = 0; w < wave; ++w) { const v4u* pp = (const v4u*)(wvcnt + (size_t)(gw0 + w) * 8); const v4u a0 = pp[0], a1 = pp[1];
        WP[0] += (int)a0.x; WP[1] += (int)a0.y; WP[2] += (int)a0.z; WP[3] += (int)a0.w; WP[4] += (int)a1.x; WP[5] += (int)a1.y; WP[6] += (int)a1.z; WP[7] += (int)a1.w; }
    const int t = (gw0 + wave) * 32 + (lane & 31);
    const int e0 = tok_e[2 * t], e1 = tok_e[2 * t + 1]; const float g0 = tok_g[2 * t], g1 = tok_g[2 * t + 1];
    const bool act = lane < 32;
    int s0 = 0, s1 = 0;
#pragma unroll
    for (int e = 0; e < 8; ++e) { const unsigned long long mk = __ballot(act && (e0 == e || e1 == e)); const int rank = __popcll(mk & ((1ull << lane) - 1ull));
        const int sl = EB[e] + P[e] + WP[e] + rank; if (e0 == e) s0 = sl; if (e1 == e) s1 = sl; }
    if (act) { slot_of_tok[2 * t] = s0; slot_of_tok[2 * t + 1] = s1; tok_of_slot[s0] = t; tok_of_slot[s1] = t; gate_of_slot[s0] = g0; gate_of_slot[s1] = g1; const float sat = SA[t]; SAS[s0] = sat; SAS[s1] = sat; }
    __syncthreads();
}

__device__ __forceinline__ f32x4 mfma16(bf16x8 a, bf16x8 b, f32x4 c) { return __builtin_amdgcn_mfma_f32_16x16x32_bf16(a, b, c, 0, 0, 0); }
__device__ __forceinline__ bf16x8 lds_tr8(const LAS bf16* p, int rowstep4  ) {
    const s16x4 lo = __builtin_bit_cast(s16x4, __builtin_amdgcn_ds_read_tr16_b64_v4i16((LAS s16x4*)p));
    const s16x4 hi = __builtin_bit_cast(s16x4, __builtin_amdgcn_ds_read_tr16_b64_v4i16((LAS s16x4*)(p + rowstep4)));
    return (bf16x8){lo[0], lo[1], lo[2], lo[3], hi[0], hi[1], hi[2], hi[3]};
}

constexpr int SG_P = 136;
__device__ __forceinline__ void sgu_phase(Frame& F, const bf16* Wsb, const float* b_s, const float* ln_g, const float* ln_b, const bf16* U, const bf16* V, bf16* MIX) {
    LAS bf16* WS = (LAS bf16*)(F.lds + RING_OFF);
    LAS bf16* VN = WS + 128 * SG_P;
    const int tid_ = F.wave * 64 + lane_id_opaque(); const int tid = tid_, lane = tid & 63, wave = F.wave, fr = lane & 15, fq = lane >> 4;
    int gprev = -1;
    for (int u = F.vcu; u < BATCH * 32 * 4; u += F.G) {
        const int g = u & 3, c = (u >> 2) & 31, b = u >> 7; const size_t row0 = (size_t)b * SEQ + c * 128;
        if (g != gprev) {
            __syncthreads();
#pragma unroll
            for (int i = 0; i < 4; ++i) { const int id = tid + 512 * i, r = id >> 4, ch = id & 15;
                *(LAS v4u*)(WS + r * SG_P + ch * 8) = *(const v4u*)(Wsb + (size_t)g * 16384 + r * 128 + ch * 8); }
            gprev = g;
        }
        { const int s = tid >> 2, qd = tid & 3; const v4u* vp = (const v4u*)(V + (row0 + s) * 512 + g * 128 + qd * 32);
          float x[32];
#pragma unroll
          for (int i = 0; i < 4; ++i) { const v4u w = vp[i]; x[8 * i] = bflo(w.x); x[8 * i + 1] = bfhi(w.x); x[8 * i + 2] = bflo(w.y); x[8 * i + 3] = bfhi(w.y); x[8 * i + 4] = bflo(w.z); x[8 * i + 5] = bfhi(w.z); x[8 * i + 6] = bflo(w.w); x[8 * i + 7] = bfhi(w.w); }
          float sm = 0.f;
#pragma unroll
          for (int i = 0; i < 32; ++i) sm += x[i];
          sm += __shfl_xor(sm, 1); sm += __shfl_xor(sm, 2); const float mean = sm * (1.f / 128.f); float sq = 0.f;
#pragma unroll
          for (int i = 0; i < 32; ++i) { x[i] -= mean; sq += x[i] * x[i]; }
          sq += __shfl_xor(sq, 1); sq += __shfl_xor(sq, 2); const float rstd = 1.f / sqrtf(sq * (1.f / 128.f) + LN_EPS);
          const f32x4* gp = (const f32x4*)(ln_g + g * 128 + qd * 32); const f32x4* bp = (const f32x4*)(ln_b + g * 128 + qd * 32);
#pragma unroll
          for (int i = 0; i < 4; ++i) { const f32x4 g0 = gp[2 * i], g1 = gp[2 * i + 1], b0 = bp[2 * i], b1 = bp[2 * i + 1]; v4u w;
              w.x = pk2(x[8 * i] * rstd * g0[0] + b0[0], x[8 * i + 1] * rstd * g0[1] + b0[1]); w.y = pk2(x[8 * i + 2] * rstd * g0[2] + b0[2], x[8 * i + 3] * rstd * g0[3] + b0[3]);
              w.z = pk2(x[8 * i + 4] * rstd * g1[0] + b1[0], x[8 * i + 5] * rstd * g1[1] + b1[1]); w.w = pk2(x[8 * i + 6] * rstd * g1[2] + b1[2], x[8 * i + 7] * rstd * g1[3] + b1[3]);
              *(LAS v4u*)(VN + s * SG_P + qd * 32 + 8 * i) = w; } }
        __syncthreads();
        f32x4 acc[8];
#pragma unroll
        for (int j = 0; j < 8; ++j) acc[j] = (f32x4){0.f, 0.f, 0.f, 0.f};
        const int ks_end = (16 * wave + 15) >> 5;
        for (int ks = 0; ks <= ks_end; ++ks) {
            const bf16x8 wf = *(const LAS bf16x8*)(WS + (16 * wave + fr) * SG_P + ks * 32 + fq * 8);
#pragma unroll
            for (int j = 0; j < 8; ++j) { const bf16x8 vf = lds_tr8(VN + (32 * ks + 8 * fq + (fr >> 2)) * SG_P + 16 * j + 4 * (fr & 3), 4 * SG_P); acc[j] = mfma16(vf, wf, acc[j]); }
        }
        { const int t = 16 * wave + fr; const float bs = b_s[g * 128 + t];
          const bf16* up = U + (row0 + t) * 512 + g * 128 + 4 * fq; bf16* op = MIX + (row0 + t) * 1024 + g * 128 + 4 * fq;
#pragma unroll
          for (int j = 0; j < 8; ++j) { const v2u uw = *(const v2u*)(up + 16 * j); v2u w;
              w.x = pk2(bflo(uw.x) * (acc[j][0] + bs), bfhi(uw.x) * (acc[j][1] + bs)); w.y = pk2(bflo(uw.y) * (acc[j][2] + bs), bfhi(uw.y) * (acc[j][3] + bs));
              *(v2u*)(op + 16 * j) = w; } }
        __syncthreads();
    }
}

__device__ __forceinline__ void combine_phase(Frame& F, const bf16* O1, const bf16* O2, const float* lq1, const float* lk1, const float* lq2, const float* lk2, const float* subg, float lam_init, const bf16* MIX, signed char* MIX8, float* SA) {
    const int tid_ = F.wave * 64 + lane_id_opaque(); const int lane = tid_ & 63, gw = F.vcu * NWAVES + F.wave, NGW = F.G * NWAVES;
    const float lam = __expf(wave_sum(lq1[lane] * lk1[lane])) - __expf(wave_sum(lq2[lane] * lk2[lane])) + lam_init;
    const int h = lane >> 4, e0 = (lane & 15) * 8; const float post = 1.f - lam_init;
    float sg[8];
#pragma unroll
    for (int i = 0; i < 8; ++i) sg[i] = subg[e0 + i] * post;
    for (int row = gw; row < M; row += NGW) {
        const v4u a = *(const v4u*)(O1 + (size_t)row * 512 + h * 128 + e0), b = *(const v4u*)(O2 + (size_t)row * 512 + h * 128 + e0), ml = *(const v4u*)(MIX + (size_t)row * 1024 + lane * 8);
        float o[8], xl[8];
        o[0] = bflo(a.x) - lam * bflo(b.x); o[1] = bfhi(a.x) - lam * bfhi(b.x); o[2] = bflo(a.y) - lam * bflo(b.y); o[3] = bfhi(a.y) - lam * bfhi(b.y);
        o[4] = bflo(a.z) - lam * bflo(b.z); o[5] = bfhi(a.z) - lam * bfhi(b.z); o[6] = bflo(a.w) - lam * bflo(b.w); o[7] = bfhi(a.w) - lam * bfhi(b.w);
        xl[0] = bflo(ml.x); xl[1] = bfhi(ml.x); xl[2] = bflo(ml.y); xl[3] = bfhi(ml.y); xl[4] = bflo(ml.z); xl[5] = bfhi(ml.z); xl[6] = bflo(ml.w); xl[7] = bfhi(ml.w);
        float ss = 0.f;
#pragma unroll
        for (int i = 0; i < 8; ++i) ss += o[i] * o[i];
        ss += __shfl_xor(ss, 1); ss += __shfl_xor(ss, 2); ss += __shfl_xor(ss, 4); ss += __shfl_xor(ss, 8);
        const float r = 1.f / sqrtf(ss * (1.f / 128.f) + LN_EPS);
        float am = 0.f;
#pragma unroll
        for (int i = 0; i < 8; ++i) { o[i] = o[i] * r * sg[i]; am = fmaxf(am, fmaxf(fabsf(o[i]), fabsf(xl[i]))); }
#pragma unroll
        for (int of = 1; of < 64; of <<= 1) am = fmaxf(am, __shfl_xor(am, of));
        const float inv = am > 0.f ? 127.f / am : 0.f;
        v2u wl, wr;
        wl.x = (unsigned)(rni8(xl[0] * inv) & 255) | ((unsigned)(rni8(xl[1] * inv) & 255) << 8) | ((unsigned)(rni8(xl[2] * inv) & 255) << 16) | ((unsigned)rni8(xl[3] * inv) << 24);
        wl.y = (unsigned)(rni8(xl[4] * inv) & 255) | ((unsigned)(rni8(xl[5] * inv) & 255) << 8) | ((unsigned)(rni8(xl[6] * inv) & 255) << 16) | ((unsigned)rni8(xl[7] * inv) << 24);
        wr.x = (unsigned)(rni8(o[0] * inv) & 255) | ((unsigned)(rni8(o[1] * inv) & 255) << 8) | ((unsigned)(rni8(o[2] * inv) & 255) << 16) | ((unsigned)rni8(o[3] * inv) << 24);
        wr.y = (unsigned)(rni8(o[4] * inv) & 255) | ((unsigned)(rni8(o[5] * inv) & 255) << 8) | ((unsigned)(rni8(o[6] * inv) & 255) << 16) | ((unsigned)rni8(o[7] * inv) << 24);
        *(v2u*)(MIX8 + (size_t)row * 1024 + lane * 8) = wl; *(v2u*)(MIX8 + (size_t)row * 1024 + 512 + h * 128 + e0) = wr;
        if (lane == 0) SA[row] = am > 0.f ? am * (1.f / 127.f) : 1.f;
    }
}

constexpr int RC = 64, RQ_P = 272, RK_P = 272, RV_P = 136, RP_P = 80;
constexpr int R_QS = 0, R_KS = R_QS + RC * RQ_P * 2, R_VS = R_KS + RC * RK_P * 2, R_PS = R_VS + RC * RV_P * 2, R_END = R_PS + RC * RP_P * 2;
static_assert(R_END <= RING_BYTES, "retention LDS");
#define RKSW(r_) (8 * ((((r_) >> 2) ^ ((r_) >> 3)) & 1))
template <int VAR> __device__ __forceinline__ void retention_phase(Frame& F, const bf16* Q, const bf16* K, const bf16* V, bf16* O) {
    LAS bf16* QS = (LAS bf16*)(F.lds + RING_OFF + R_QS); LAS bf16* KS = (LAS bf16*)(F.lds + RING_OFF + R_KS);
    LAS bf16* VS = (LAS bf16*)(F.lds + RING_OFF + R_VS); LAS bf16* PS = (LAS bf16*)(F.lds + RING_OFF + R_PS);
    const int wave = F.wave;
    for (int u = F.vcu; u < BATCH * 4 * 4; u += F.G) {
        const int sl = u & 3, h = (u >> 2) & 3, b = u >> 4;
        const float lg = __log2f(1.0f - __builtin_amdgcn_exp2f(-5.0f - (float)h));
        const float cdec = __builtin_amdgcn_exp2f(lg * (float)RC);
        const bf16* Qg = Q + (size_t)b * SEQ * 1024 + h * 256; const bf16* Kg = K + (size_t)b * SEQ * 1024 + h * 256;
        const bf16* Vg = V + (size_t)b * SEQ * 2048 + h * 512 + sl * 128; bf16* Og = O + (size_t)b * SEQ * 2048 + h * 512 + sl * 128;
        f32x4 st[16];
#pragma unroll
        for (int t = 0; t < 16; ++t) st[t] = (f32x4){0.f, 0.f, 0.f, 0.f};
        float qd[4], kdv[2][8];
        { const int l0 = lane_id_opaque(), fr0 = l0 & 15, fq0 = l0 >> 4;
#pragma unroll
          for (int mi = 0; mi < 4; ++mi) qd[mi] = __builtin_amdgcn_exp2f(lg * (float)(16 * mi + fr0 + 1));
#pragma unroll
          for (int ks = 0; ks < 2; ++ks)
#pragma unroll
              for (int j = 0; j < 8; ++j) kdv[ks][j] = __builtin_amdgcn_exp2f(lg * (float)(RC - 1 - (32 * ks + 8 * fq0 + j))); }
        v4u rq[4], rk[4], rv[2];
#define RET_TID() const int tid_ = F.wave * 64 + lane_id_opaque(); const int tid = tid_, lane = tid & 63, fr = lane & 15, fq = lane >> 4; (void)fr; (void)fq
#define RET_LOAD(c0) do { RET_TID(); const size_t t0_ = (size_t)(c0) * RC; \
            _Pragma("unroll") for (int i = 0; i < 4; ++i) { const int id = tid + 512 * i; const size_t o_ = tiled_off(b * SEQ + (int)t0_ + (id >> 5), h * 256 + (id & 31) * 8, 4); rq[i] = *(const v4u*)(Q + o_); rk[i] = *(const v4u*)(K + o_); } \
            _Pragma("unroll") for (int i = 0; i < 2; ++i) { const int id = tid + 512 * i; rv[i] = *(const v4u*)(V + tiled_off(b * SEQ + (int)t0_ + (id >> 4), h * 512 + sl * 128 + (id & 15) * 8, 8)); } } while (0)
        RET_LOAD(0);
        if (VAR == 2) { asm volatile("" : "+v"(rq[0]), "+v"(rq[1]), "+v"(rq[2]), "+v"(rq[3]), "+v"(rk[0]), "+v"(rk[1]), "+v"(rk[2]), "+v"(rk[3]), "+v"(rv[0]), "+v"(rv[1])); }
        for (int c = 0; c < SEQ / RC; ++c) {
            { RET_TID();
#pragma unroll
              for (int i = 0; i < 4; ++i) { const int id = tid + 512 * i; *(LAS v4u*)(QS + (id >> 5) * RQ_P + (id & 31) * 8) = rq[i]; *(LAS v4u*)(KS + (id >> 5) * RK_P + (((id & 31) ^ RKSW(id >> 5)) * 8)) = rk[i]; }
#pragma unroll
              for (int i = 0; i < 2; ++i) { const int id = tid + 512 * i; *(LAS v4u*)(VS + (id >> 4) * RV_P + (id & 15) * 8) = rv[i]; } }
            if (VAR != 2 && c + 1 < SEQ / RC) RET_LOAD(c + 1);
            __syncthreads();
            if (VAR != 1) {
            { RET_TID(); const int ti = wave >> 1, tj0 = 2 * (wave & 1);
              f32x4 sc[2] = {(f32x4){0.f, 0.f, 0.f, 0.f}, (f32x4){0.f, 0.f, 0.f, 0.f}};
#define LOADS(dst, g_) do { _Pragma("unroll") for (int k2 = 0; k2 < 2; ++k2) { dst[3 * k2] = *(const LAS bf16x8*)(QS + (16 * ti + fr) * RQ_P + (2 * (g_) + k2) * 32 + fq * 8); \
                  dst[3 * k2 + 1] = *(const LAS bf16x8*)(KS + (16 * tj0 + fr) * RK_P + ((((2 * (g_) + k2) * 4 + fq) ^ RKSW(fr)) * 8)); dst[3 * k2 + 2] = *(const LAS bf16x8*)(KS + (16 * (tj0 + 1) + fr) * RK_P + ((((2 * (g_) + k2) * 4 + fq) ^ RKSW(fr)) * 8)); } } while (0)
#define SCORE(f) do { sc[0] = mfma16(f[1], f[0], sc[0]); sc[1] = mfma16(f[2], f[0], sc[1]); sc[0] = mfma16(f[4], f[3], sc[0]); sc[1] = mfma16(f[5], f[3], sc[1]); } while (0)
              bf16x8 fa[6], fb[6];
              LOADS(fa, 0); __builtin_amdgcn_sched_barrier(0);
              LOADS(fb, 1); __builtin_amdgcn_sched_barrier(0); SCORE(fa); __builtin_amdgcn_sched_barrier(0);
              LOADS(fa, 2); __builtin_amdgcn_sched_barrier(0); SCORE(fb); __builtin_amdgcn_sched_barrier(0);
              LOADS(fb, 3); __builtin_amdgcn_sched_barrier(0); SCORE(fa); __builtin_amdgcn_sched_barrier(0);
              SCORE(fb); __builtin_amdgcn_sched_barrier(0);
#undef LOADS
#undef SCORE
              const int q = 16 * ti + fr;
#pragma unroll
              for (int j = 0; j < 2; ++j) { const int key0 = 16 * (tj0 + j) + 4 * fq; float p[4];
#pragma unroll
                  for (int r = 0; r < 4; ++r) p[r] = (q >= key0 + r) ? sc[j][r] * __builtin_amdgcn_exp2f(lg * (float)(q - key0 - r)) : 0.f;
                  v2u w; w.x = pk2(p[0], p[1]); w.y = pk2(p[2], p[3]); *(LAS v2u*)(PS + q * RP_P + key0) = w; } }
            }
            __syncthreads();
            if (VAR != 1) {
            RET_TID();
#define SB() __builtin_amdgcn_sched_barrier(0)
#define LOADQ(dst, ks_) do { _Pragma("unroll") for (int mi = 0; mi < 4; ++mi) dst[mi] = *(const LAS v4u*)(QS + (16 * mi + fr) * RQ_P + (ks_) * 32 + 8 * fq); } while (0)
#define LOADP(dst, ks_) do { _Pragma("unroll") for (int mi = 0; mi < 4; ++mi) dst[mi] = *(const LAS v4u*)(PS + (16 * mi + fr) * RP_P + (ks_) * 32 + fq * 8); } while (0)
#define LOADKT(dst, t_) do { _Pragma("unroll") for (int k2 = 0; k2 < 2; ++k2) { const int cl_ = (4 * ((t_) >> 1) + (fr & 3)) ^ (8 * (fq & 1));     \
                const LAS bf16* pl_ = KS + (32 * k2 + 8 * fq + (fr >> 2)) * RK_P + cl_ * 8 + 4 * ((t_) & 1); const LAS bf16* ph_ = KS + (32 * k2 + 8 * fq + (fr >> 2) + 4) * RK_P + (cl_ ^ 8) * 8 + 4 * ((t_) & 1); \
                const s16x4 lo_ = __builtin_bit_cast(s16x4, __builtin_amdgcn_ds_read_tr16_b64_v4i16((LAS s16x4*)pl_)); const s16x4 hi_ = __builtin_bit_cast(s16x4, __builtin_amdgcn_ds_read_tr16_b64_v4i16((LAS s16x4*)ph_)); \
                dst[k2] = (bf16x8){lo_[0], lo_[1], lo_[2], lo_[3], hi_[0], hi_[1], hi_[2], hi_[3]}; } } while (0)
#define CROSS(ks_, qf) do { const v4u pw_ = {pk2(st[2 * (ks_)][0], st[2 * (ks_)][1]), pk2(st[2 * (ks_)][2], st[2 * (ks_)][3]), pk2(st[2 * (ks_) + 1][0], st[2 * (ks_) + 1][1]), pk2(st[2 * (ks_) + 1][2], st[2 * (ks_) + 1][3])}; \
                const bf16x8 sb_ = __builtin_bit_cast(bf16x8, pw_); _Pragma("unroll") for (int mi = 0; mi < 4; ++mi) acc[mi] = mfma16(sb_, __builtin_bit_cast(bf16x8, qf[mi]), acc[mi]); } while (0)
            f32x4 acc[4];
#pragma unroll
            for (int mi = 0; mi < 4; ++mi) acc[mi] = (f32x4){0.f, 0.f, 0.f, 0.f};
            v4u qa[4], qb[4]; bf16x8 vb[2], vd[2], ka[2], kb[2];
            LOADQ(qa, 0); SB();
            LOADQ(qb, 1); SB(); CROSS(0, qa); SB();
            LOADQ(qa, 2); SB(); CROSS(1, qb); SB();
            LOADQ(qb, 3); SB(); CROSS(2, qa); SB();
            LOADQ(qa, 4); SB(); CROSS(3, qb); SB();
            LOADQ(qb, 5); SB(); CROSS(4, qa); SB();
            LOADQ(qa, 6); SB(); CROSS(5, qb); SB();
            LOADQ(qb, 7); SB(); CROSS(6, qa); SB();
#pragma unroll
            for (int ks = 0; ks < 2; ++ks) vb[ks] = lds_tr8(VS + (32 * ks + 8 * fq + (fr >> 2)) * RV_P + 16 * wave + 4 * (fr & 3), 4 * RV_P);
            LOADP(qa, 0); SB(); CROSS(7, qb); SB();
#pragma unroll
            for (int mi = 0; mi < 4; ++mi) acc[mi] = acc[mi] * qd[mi];
            LOADP(qb, 1); SB();
#pragma unroll
            for (int mi = 0; mi < 4; ++mi) acc[mi] = mfma16(vb[0], __builtin_bit_cast(bf16x8, qa[mi]), acc[mi]);
            SB(); LOADKT(ka, 0); SB();
#pragma unroll
            for (int mi = 0; mi < 4; ++mi) acc[mi] = mfma16(vb[1], __builtin_bit_cast(bf16x8, qb[mi]), acc[mi]);
            SB();
#pragma unroll
            for (int ks = 0; ks < 2; ++ks) { const v4u vw = __builtin_bit_cast(v4u, vb[ks]); v4u dw;
                dw.x = pk2(bflo(vw.x) * kdv[ks][0], bfhi(vw.x) * kdv[ks][1]); dw.y = pk2(bflo(vw.y) * kdv[ks][2], bfhi(vw.y) * kdv[ks][3]);
                dw.z = pk2(bflo(vw.z) * kdv[ks][4], bfhi(vw.z) * kdv[ks][5]); dw.w = pk2(bflo(vw.w) * kdv[ks][6], bfhi(vw.w) * kdv[ks][7]);
                vd[ks] = __builtin_bit_cast(bf16x8, dw); }
            if (VAR != 3) { bf16* op = Og + ((size_t)c * RC + fr) * 2048 + 16 * wave + 4 * fq;
#pragma unroll
              for (int mi = 0; mi < 4; ++mi) { v2u w; w.x = pk2(acc[mi][0], acc[mi][1]); w.y = pk2(acc[mi][2], acc[mi][3]); *(v2u*)(op + (size_t)(16 * mi) * 2048) = w; } }
            SB();
#define STATE(t_, kf) do { st[t_] = st[t_] * cdec; st[t_] = mfma16(kf[0], vd[0], st[t_]); st[t_] = mfma16(kf[1], vd[1], st[t_]); } while (0)
#pragma unroll
            for (int t = 0; t < 16; t += 2) {
                LOADKT(kb, t + 1); SB(); STATE(t, ka); SB();
                if (t + 2 < 16) { LOADKT(ka, t + 2); } SB(); STATE(t + 1, kb); SB(); }
#undef SB
#undef LOADQ
#undef LOADP
#undef LOADKT
#undef CROSS
#undef STATE
            }
            __syncthreads();
        }
#undef RET_LOAD
#undef RET_TID
    }
}

__device__ __forceinline__ void gate_phase(Frame& F, const bf16* O, const bf16* G, const float* gn_g, signed char* G8, float* SA) {
    const int tid_ = F.wave * 64 + lane_id_opaque(); const int lane = tid_ & 63, gw = F.vcu * NWAVES + F.wave, NGW = F.G * NWAVES;
    float gg[32];
#pragma unroll
    for (int i = 0; i < 32; ++i) gg[i] = gn_g[lane * 32 + i];
    for (int row = gw; row < M; row += NGW) {
        const v4u* op = (const v4u*)(O + (size_t)row * 2048 + lane * 32); const v4u* gp = (const v4u*)(G + tiled_off(row, lane * 32, 8));
        float x[32], gt[32];
#pragma unroll
        for (int i = 0; i < 4; ++i) { const v4u w = op[i], z = gp[i];
            x[8 * i] = bflo(w.x); x[8 * i + 1] = bfhi(w.x); x[8 * i + 2] = bflo(w.y); x[8 * i + 3] = bfhi(w.y); x[8 * i + 4] = bflo(w.z); x[8 * i + 5] = bfhi(w.z); x[8 * i + 6] = bflo(w.w); x[8 * i + 7] = bfhi(w.w);
            gt[8 * i] = bflo(z.x); gt[8 * i + 1] = bfhi(z.x); gt[8 * i + 2] = bflo(z.y); gt[8 * i + 3] = bfhi(z.y); gt[8 * i + 4] = bflo(z.z); gt[8 * i + 5] = bfhi(z.z); gt[8 * i + 6] = bflo(z.w); gt[8 * i + 7] = bfhi(z.w); }
        float sm = 0.f;
#pragma unroll
        for (int i = 0; i < 32; ++i) sm += x[i];
        sm += __shfl_xor(sm, 1); sm += __shfl_xor(sm, 2); sm += __shfl_xor(sm, 4); sm += __shfl_xor(sm, 8);
        const float mean = sm * (1.f / 512.f); float sq = 0.f;
#pragma unroll
        for (int i = 0; i < 32; ++i) { x[i] -= mean; sq += x[i] * x[i]; }
        sq += __shfl_xor(sq, 1); sq += __shfl_xor(sq, 2); sq += __shfl_xor(sq, 4); sq += __shfl_xor(sq, 8);
        const float rstd = 1.f / sqrtf(sq * (1.f / 512.f) + LN_EPS);
        float am = 0.f;
#pragma unroll
        for (int i = 0; i < 32; ++i) { x[i] = x[i] * rstd * gg[i] * gt[i]; am = fmaxf(am, fabsf(x[i])); }
#pragma unroll
        for (int o = 1; o < 64; o <<= 1) am = fmaxf(am, __shfl_xor(am, o));
        const float inv = am > 0.f ? 127.f / am : 0.f;
        v4u* qp = (v4u*)(G8 + (size_t)row * 2048 + lane * 32);
#pragma unroll
        for (int i = 0; i < 2; ++i) { v4u w; unsigned d[4];
#pragma unroll
            for (int j = 0; j < 4; ++j) { const float* y = x + 16 * i + 4 * j;
                d[j] = (unsigned)(rni8(y[0] * inv) & 255) | ((unsigned)(rni8(y[1] * inv) & 255) << 8) | ((unsigned)(rni8(y[2] * inv) & 255) << 16) | ((unsigned)rni8(y[3] * inv) << 24); }
            w.x = d[0]; w.y = d[1]; w.z = d[2]; w.w = d[3]; qp[i] = w; }
        if (lane == 0) SA[row] = am > 0.f ? am * (1.f / 127.f) : 1.f;
    }
}

struct Args {
    const float* in[31]; float* out; unsigned char* ws; int ph_lo, ph_hi; int pad0, pad1;
};
enum { I_X = 0, I_EWIN, I_EWS, I_EBS, I_EVLG, I_EVLB, I_LQ1, I_LK1, I_LQ2, I_LK2, I_SUBG, I_EWO, I_ELN1G, I_ELN1B, I_FW1, I_FW3, I_FW2, I_ELN2G, I_ELN2B,
       I_OWIN, I_OGN, I_OWO, I_OLN1G, I_OLN1B, I_RW, I_RB, I_MW1, I_MW3, I_MW2, I_OLN2G, I_OLN2B };
constexpr int PH_EVEN = 8, PH_ODD = 9, PH_TOTAL = 1 + 2 * (PH_EVEN + PH_ODD);

__global__ void __launch_bounds__(NWAVES * 64, 2) mk_fwd(Args args) {
    extern __shared__ __attribute__((aligned(16))) unsigned char lds[];
    Frame F;
    F.lds = (LAS unsigned char*)lds;
    F.wave = __builtin_amdgcn_readfirstlane((int)threadIdx.x >> 6);
    F.G = gridDim.x; { const int bx = blockIdx.x; F.vcu = (F.G % 8 == 0) ? (bx % 8) * (F.G / 8) + bx / 8 : bx; }
    unsigned* ctl = (unsigned*)(args.ws + WS_CTL);
    for (int u = threadIdx.x; u < (LDS_BYTES - LDSCTL_OFF) / 4; u += NWAVES * 64) ((LAS unsigned*)(F.lds + LDSCTL_OFF))[u] = 0u;
    __syncthreads();
    const int lo = args.ph_lo, hi = args.ph_hi;
    XcdBarrier bar; bar.bar = ctl + CW_BAR; bar.x = 0; bar.st = nullptr;
    if (hi - lo > 1) bar = xcd_barrier_post(ctl + CW_BAR, (volatile LAS unsigned*)(F.lds + LDSCTL_OFF + 32));
#define IN(k) (lo <= (k) && (k) < hi)
#ifndef ONLY_PH
#define ONLY_PH -1
#endif
#define KEEP(n) (ONLY_PH < 0 || ONLY_PH == (n))
#ifndef DUP_MASK
#define DUP_MASK 0
#endif
#define NREP(n) ((((n) == 1 || (n) == 4 || (n) == 6 || (n) == 7 || (n) == 10 || (n) == 13) && (DUP_MASK & 1)) || (((n) == 16 || (n) == 17) && (DUP_MASK & 2)) || ((n) == 2 && (DUP_MASK & 4)) || ((n) == 11 && (DUP_MASK & 8)) || \
    (((n) == 0 || (n) == 3 || (n) == 5 || (n) == 8 || (n) == 9 || (n) == 14 || (n) == 15) && (DUP_MASK & 16)) ? 2 : 1)
#define SEAM(k) do { if (IN(k) && IN((k) + 1)) xcd_barrier(bar); } while (0)

#define PH_LOCALS int z_ = 0; asm volatile("" : "+s"(z_)); unsigned char* const ws = args.ws + z_; (void)ws; \
    bf16* const XB = (bf16*)(ws + WS_XB); (void)XB; signed char* const XQ = (signed char*)(ws + WS_WB + WB_XQ); (void)XQ; float* const SA = (float*)(ws + WS_SA); (void)SA; float* const SW = (float*)(ws + WS_SW); (void)SW; float* const SAS = (float*)(ws + WS_SAS); (void)SAS; float* const Y = args.out + z_; (void)Y; unsigned char* const act = ws + WS_ACT; (void)act; unsigned char* const wb = ws + WS_WB; (void)wb
#define INP(i) (args.in[(i) + z_])
#define MOE_PTRS int* const tok_e = (int*)(ws + WS_TOKE); float* const tok_g = (float*)(ws + WS_TOKG); int* const slot_of_tok = (int*)(ws + WS_SLOT); \
    int* const tok_of_slot = (int*)(ws + WS_TOKS); float* const gate_of_slot = (float*)(ws + WS_GATS); int* const wvcnt = (int*)(ws + WS_WCNT); int* const tiles = (int*)(ws + WS_TILE); \
    (void)tok_e; (void)tok_g; (void)slot_of_tok; (void)tok_of_slot; (void)gate_of_slot; (void)wvcnt; (void)tiles
#define EVEN_PTRS bf16* const WinT = (bf16*)(wb + WB_E_IN); bf16* const WoT = (bf16*)(wb + WB_E_O); bf16* const W13T = (bf16*)(wb + WB_E_13); bf16* const W2T = (bf16*)(wb + WB_E_2); \
    bf16* const Wsb = (bf16*)(ws + WS_WSB); \
    bf16* const U = (bf16*)(act + A_U); bf16* const Vg = (bf16*)(act + A_V); bf16* const Qa = (bf16*)(act + A_Q); bf16* const Ka = (bf16*)(act + A_K); bf16* const Va = (bf16*)(act + A_VA); \
    bf16* const O1 = (bf16*)(act + A_O1); bf16* const O2 = (bf16*)(act + A_O2); bf16* const MIX = (bf16*)(act + A_MIX); bf16* const Hh = (bf16*)(act + A_H); \
    (void)WinT; (void)WoT; (void)W13T; (void)W2T; (void)Wsb; (void)U; (void)Vg; (void)Qa; (void)Ka; (void)Va; (void)O1; (void)O2; (void)MIX; (void)Hh
#define ODD_PTRS bf16* const WinT = (bf16*)(wb + WB_O_IN); bf16* const WoT = (bf16*)(wb + WB_O_O); unsigned char* const MW13 = wb + WB_O_13; unsigned char* const MW2 = wb + WB_O_2; \
    bf16* const Qr = (bf16*)(act + AO_Q); bf16* const Kr = (bf16*)(act + AO_K); bf16* const Vr = (bf16*)(act + AO_V); bf16* const Gr = (bf16*)(act + AO_G); \
    bf16* const Or = (bf16*)Y; unsigned char* const HM = act + AM_H; bf16* const OUTB = (bf16*)(act + AM_OUT); \
    (void)WinT; (void)WoT; (void)MW13; (void)MW2; (void)Qr; (void)Kr; (void)Vr; (void)Gr; (void)Or; (void)HM; (void)OUTB

    int ph = 0;
    for (int l = 0; l < 4; ++l) {
        const int li = l >> 1;
        if ((l & 1) == 0) {
            if (l == 0) {
            if (KEEP(0) && IN(ph)) for (int rep_ = 0; rep_ < NREP(0); ++rep_) { PH_LOCALS; EVEN_PTRS;
                conv_q1024(F, QSet{INP(I_EWIN) + (size_t)li * DM * EVEN_IN, EVEN_IN, (signed char*)WinT, SW + SW_EIN, INP(I_FW1) + (size_t)li * DM * DFF, INP(I_FW3) + (size_t)li * DM * DFF, 1, (signed char*)W13T, SW + SW_E13,
                                   INP(I_EWO) + (size_t)li * DM * DM, (signed char*)WoT, SW + SW_EWO});
                const ConvJob J[1] = {
                    {INP(I_FW2) + (size_t)li * DFF * DM, W2T, DFF, DM, 128, 0, (DFF / 64) * (DM / 32), W8_SCALE, nullptr, nullptr, 1}};
                conv_jobs<1>(F, J);
                { float* const PN = (float*)(act + A_PMAX) + (size_t)((l + 1) & 1) * PMAX_FLOATS;
                  conv_wo_max(F, INP(I_OWO) + (size_t)li * 2 * DM * DM, PN + PM_WO); }
                const int tq = F.wave * 64 + lane_id_opaque();
                { const float* wsrc = INP(I_EWS) + (size_t)li * 4 * 128 * 128;
                  for (int i = blockIdx.x * 512 + tq; i < 4 * 128 * 128; i += F.G * 512) { const int s = i & 127, t = (i >> 7) & 127; Wsb[i] = (bf16)f2bf(s <= t ? wsrc[i] : 0.f); } }
                if (l == 0) ln_phase<3, false, false>(F, INP(I_X), XB, nullptr, INP(I_ELN1G), INP(I_ELN1B), nullptr, nullptr, nullptr, nullptr, nullptr, nullptr, nullptr, XQ, SA);
            }
            SEAM(ph); ++ph;
            }
            if (KEEP(1) && IN(ph)) for (int rep_ = 0; rep_ < NREP(1); ++rep_) { PH_LOCALS; EVEN_PTRS;
                pg8::Gemm g{(const bf16*)XQ, WinT, M, EVEN_IN, DM}; pg8::StaticOrder S; S.init(M, EVEN_IN, F.G, (int)blockIdx.x);
                pg8::EpiRouteQ E{{U, Vg, Qa, Ka, Va}, {512, 512, 512, 512, 512}, {0, 2, 4, 6, 8}, {1, 1, 0, 0, 0}, {1.f, 1.f, attn_body::C2, 1.f, 1.f}, 5, SA, SW + SW_EIN, nullptr};
                pg8::gemm_phase<pg8::EpiRouteQ, pg8::StaticOrder, true, true, 2>(F.lds + RING_OFF, g, S, E, F.wave);
            }
            SEAM(ph); ++ph;
            if (KEEP(2) && IN(ph)) for (int rep_ = 0; rep_ < NREP(2); ++rep_) { PH_LOCALS; EVEN_PTRS;
                attn_body::attn_phase<40>((char*)lds + RING_OFF, (const attn_body::bf16*)Qa, (const attn_body::bf16*)Ka, (const attn_body::bf16*)Va, (attn_body::bf16*)O1, (attn_body::bf16*)O2, F.vcu, F.G, F.wave);
                sgu_phase(F, Wsb, INP(I_EBS) + li * 512, INP(I_EVLG) + li * 512, INP(I_EVLB) + li * 512, U, Vg, MIX);
            }
            SEAM(ph); ++ph;
            if (KEEP(3) && IN(ph)) for (int rep_ = 0; rep_ < NREP(3); ++rep_) { PH_LOCALS; EVEN_PTRS;
                const float lam_init = 0.8f - 0.6f * __expf(-0.3f * (float)l);
                combine_phase(F, O1, O2, INP(I_LQ1) + li * 64, INP(I_LK1) + li * 64, INP(I_LQ2) + li * 64, INP(I_LK2) + li * 64, INP(I_SUBG) + li * 128, lam_init, MIX, (signed char*)(act + A_MIX8), SA);
            }
            SEAM(ph); ++ph;
            if (KEEP(4) && IN(ph)) for (int rep_ = 0; rep_ < NREP(4); ++rep_) { PH_LOCALS; EVEN_PTRS;
                pg8::Gemm g{(const bf16*)(act + A_MIX8), WoT, M, DM, DM}; pg8::StaticOrder S; S.init(M, DM, F.G, (int)blockIdx.x);
                if (l == 0) { pg8::EpiResFromF32Q E{INP(I_X), XB, DM, DN_ALPHA, SA, SW + SW_EWO, nullptr};
                    pg8::gemm_phase<pg8::EpiResFromF32Q, pg8::StaticOrder, true, true, 2>(F.lds + RING_OFF, g, S, E, F.wave); }
                else { pg8::EpiResInplaceQ E{XB, DM, DN_ALPHA, SA, SW + SW_EWO, nullptr};
                    pg8::gemm_phase<pg8::EpiResInplaceQ, pg8::StaticOrder, true, true, 2>(F.lds + RING_OFF, g, S, E, F.wave); }
            }
            SEAM(ph); ++ph;
            if (KEEP(5) && IN(ph)) for (int rep_ = 0; rep_ < NREP(5); ++rep_) { PH_LOCALS; EVEN_PTRS; ln_phase<2, false, false>(F, nullptr, XB, nullptr, INP(I_ELN1G) + li * DM, INP(I_ELN1B) + li * DM, nullptr, nullptr, nullptr, nullptr, nullptr, nullptr, nullptr, XQ, SA); }
            SEAM(ph); ++ph;
            if (KEEP(6) && IN(ph)) for (int rep_ = 0; rep_ < NREP(6); ++rep_) { PH_LOCALS; EVEN_PTRS;
                pg8::Gemm g{(const bf16*)XQ, W13T, M, 2 * DFF, DM}; pg8::StaticOrder S; S.init(M, 2 * DFF, F.G, (int)blockIdx.x);
                pg8::EpiSwigluQ<true> E{Hh, DFF, SA, SW + SW_E13, nullptr};
                pg8::gemm_phase<pg8::EpiSwigluQ<true>, pg8::StaticOrder, true, true, 2>(F.lds + RING_OFF, g, S, E, F.wave);
            }
            SEAM(ph); ++ph;
            if (KEEP(7) && IN(ph)) for (int rep_ = 0; rep_ < NREP(7); ++rep_) { PH_LOCALS; EVEN_PTRS;
                pg8::Gemm g{Hh, W2T, M, DM, DFF}; pg8::StaticOrder S; S.init(M, DM, F.G, (int)blockIdx.x);
                pg8::EpiResInplace E{XB, DM, DN_ALPHA, 1.f / W8_SCALE};
                pg8::gemm_phase<pg8::EpiResInplace, pg8::StaticOrder, true, true, 1, true>(F.lds + RING_OFF, g, S, E, F.wave);
            }
            SEAM(ph); ++ph;
            if (KEEP(8) && IN(ph)) for (int rep_ = 0; rep_ < NREP(8); ++rep_) { PH_LOCALS; EVEN_PTRS; ln_phase<2, false, false>(F, nullptr, XB, nullptr, INP(I_ELN2G) + li * DM, INP(I_ELN2B) + li * DM, nullptr, nullptr, nullptr, nullptr, nullptr, nullptr, nullptr, XQ, SA);
                { ODD_PTRS; MOE_PTRS;
                float* const PM = (float*)(act + A_PMAX) + (size_t)((l + 1) & 1) * PMAX_FLOATS;
                conv_q1024(F, QSet{INP(I_OWIN) + (size_t)li * DM * ODD_IN, ODD_IN, (signed char*)WinT, SW + SW_OIN, INP(I_MW1) + (size_t)li * NEXP * DM * DFF, INP(I_MW3) + (size_t)li * NEXP * DM * DFF, NEXP, (signed char*)MW13, SW + SW_M13});
                conv_wo_q(F, INP(I_OWO) + (size_t)li * 2 * DM * DM, (signed char*)WoT, SW + SW_OWO, PM + PM_WO);
                for (int e = 0; e < NEXP; ++e) { const ConvJob J[1] = {
                    {INP(I_MW2) + ((size_t)li * NEXP + e) * DFF * DM, (bf16*)(MW2 + (size_t)e * DM * DFF), DFF, DM, 128, 0, (DFF / 64) * (DM / 32), W8_SCALE, nullptr, nullptr, 1}};
                    conv_jobs<1>(F, J); }
                } }
            SEAM(ph); ++ph;
        } else {
            if (KEEP(10) && IN(ph)) for (int rep_ = 0; rep_ < NREP(10); ++rep_) { PH_LOCALS; ODD_PTRS; MOE_PTRS;
                pg8::Gemm g{(const bf16*)XQ, WinT, M, ODD_IN, DM}; pg8::StaticOrder S; S.init(M, ODD_IN, F.G, (int)blockIdx.x);
                pg8::EpiRouteQ E{{Qr, Kr, Vr, Gr, Gr}, {1024, 1024, 2048, 2048, 2048}, {0, 4, 8, 16, 1 << 30}, {0, 0, 0, 2, 0}, {1.f, 0.0625f, 1.f, 1.f, 1.f}, 4, SA, SW + SW_OIN, nullptr, 1};
                pg8::gemm_phase<pg8::EpiRouteQ, pg8::StaticOrder, true, true, 2>(F.lds + RING_OFF, g, S, E, F.wave);
            }
            SEAM(ph); ++ph;
            if (KEEP(11) && IN(ph)) for (int rep_ = 0; rep_ < NREP(11); ++rep_) { PH_LOCALS; ODD_PTRS; MOE_PTRS;
#ifdef DUP_VARIANT
                if (args.pad0 == 1) retention_phase<1>(F, Qr, Kr, Vr, Or); else if (args.pad0 == 2) retention_phase<2>(F, Qr, Kr, Vr, Or); else if (args.pad0 == 3) retention_phase<3>(F, Qr, Kr, Vr, Or); else
#endif
                retention_phase<0>(F, Qr, Kr, Vr, Or); }
            SEAM(ph); ++ph;
            if (KEEP(12) && IN(ph)) for (int rep_ = 0; rep_ < NREP(12); ++rep_) { PH_LOCALS; ODD_PTRS; MOE_PTRS; gate_phase(F, Or, Gr, INP(I_OGN) + li * 2048, (signed char*)Qr, SA); }
            SEAM(ph); ++ph;
            if (KEEP(13) && IN(ph)) for (int rep_ = 0; rep_ < NREP(13); ++rep_) { PH_LOCALS; ODD_PTRS; MOE_PTRS;
                pg8::Gemm g{Qr, WoT, M, DM, 2 * DM}; pg8::StaticOrder S; S.init(M, DM, F.G, (int)blockIdx.x);
                pg8::EpiResInplaceQ E{XB, DM, DN_ALPHA, SA, SW + SW_OWO, nullptr};
                pg8::gemm_phase<pg8::EpiResInplaceQ, pg8::StaticOrder, true, true, 2>(F.lds + RING_OFF, g, S, E, F.wave);
            }
            SEAM(ph); ++ph;
            if (KEEP(14) && IN(ph)) for (int rep_ = 0; rep_ < NREP(14); ++rep_) { PH_LOCALS; ODD_PTRS; MOE_PTRS; ln_phase<2, true, false>(F, nullptr, XB, nullptr, INP(I_OLN1G) + li * DM, INP(I_OLN1B) + li * DM, nullptr, nullptr,
                                                 INP(I_RW) + (size_t)li * DM * NEXP, INP(I_RB) + li * NEXP, tok_e, tok_g, wvcnt, XQ, SA); }
            SEAM(ph); ++ph;
            if (KEEP(15) && IN(ph)) for (int rep_ = 0; rep_ < NREP(15); ++rep_) { PH_LOCALS; ODD_PTRS; MOE_PTRS; assign_phase(F, wvcnt, tok_e, tok_g, slot_of_tok, tok_of_slot, gate_of_slot, tiles, SA, SAS); }
            SEAM(ph); ++ph;
            if (KEEP(16) && IN(ph)) for (int rep_ = 0; rep_ < NREP(16); ++rep_) { PH_LOCALS; ODD_PTRS; MOE_PTRS;
                const int nt = tiles[0];
                pg8::Gemm g{(const bf16*)XQ, (const bf16*)MW13, 0, 0, DM}; pg8::MoeOrder<true> S; S.init(nt, 2 * DFF / 256, F.G, (int)blockIdx.x, tiles + 16, tok_of_slot);
                pg8::EpiSwigluQ<true> E{HM, DFF, SAS, SW + SW_M13, nullptr};
                pg8::gemm_phase<pg8::EpiSwigluQ<true>, pg8::MoeOrder<true>, true, true, 2>(F.lds + RING_OFF, g, S, E, F.wave);
            }
            SEAM(ph); ++ph;
            if (KEEP(17) && IN(ph)) for (int rep_ = 0; rep_ < NREP(17); ++rep_) { PH_LOCALS; ODD_PTRS; MOE_PTRS;
                const int nt = tiles[0];
                pg8::Gemm g{(const bf16*)HM, (const bf16*)MW2, 0, 0, DFF}; pg8::MoeOrder<false> S; S.init(nt, DM / 256, F.G, (int)blockIdx.x, tiles + 16, nullptr);
                pg8::EpiMoeDown E{OUTB, DM, gate_of_slot, 1.f / W8_SCALE, nullptr};
                pg8::gemm_phase<pg8::EpiMoeDown, pg8::MoeOrder<false>, true, true, 1, true>(F.lds + RING_OFF, g, S, E, F.wave);
            }
            SEAM(ph); ++ph;
            if (KEEP(18) && IN(ph)) for (int rep_ = 0; rep_ < NREP(18); ++rep_) { PH_LOCALS; ODD_PTRS; MOE_PTRS;
                if (l == 3) ln_phase<1, false, true>(F, nullptr, XB, Y, INP(I_OLN2G) + li * DM, INP(I_OLN2B) + li * DM, OUTB, slot_of_tok, nullptr, nullptr, nullptr, nullptr, nullptr);
                else        ln_phase<1, false, false>(F, nullptr, XB, nullptr, INP(I_OLN2G) + li * DM, INP(I_OLN2B) + li * DM, OUTB, slot_of_tok, nullptr, nullptr, nullptr, nullptr, nullptr, XQ, SA);
                if (l + 1 < 4) { EVEN_PTRS;
                conv_q1024(F, QSet{INP(I_EWIN) + (size_t)(li + 1) * DM * EVEN_IN, EVEN_IN, (signed char*)WinT, SW + SW_EIN, INP(I_FW1) + (size_t)(li + 1) * DM * DFF, INP(I_FW3) + (size_t)(li + 1) * DM * DFF, 1, (signed char*)W13T, SW + SW_E13,
                                   INP(I_EWO) + (size_t)(li + 1) * DM * DM, (signed char*)WoT, SW + SW_EWO});
                const ConvJob J[1] = {
                    {INP(I_FW2) + (size_t)(li + 1) * DFF * DM, W2T, DFF, DM, 128, 0, (DFF / 64) * (DM / 32), W8_SCALE, nullptr, nullptr, 1}};
                conv_jobs<1>(F, J);
                { float* const PN = (float*)(act + A_PMAX) + (size_t)((l + 2) & 1) * PMAX_FLOATS;
                  conv_wo_max(F, INP(I_OWO) + (size_t)(li + 1) * 2 * DM * DM, PN + PM_WO); }
                const int tq = F.wave * 64 + lane_id_opaque();
                { const float* wsrc = INP(I_EWS) + (size_t)(li + 1) * 4 * 128 * 128;
                  for (int i = blockIdx.x * 512 + tq; i < 4 * 128 * 128; i += F.G * 512) { const int s = i & 127, t = (i >> 7) & 127; Wsb[i] = (bf16)f2bf(s <= t ? wsrc[i] : 0.f); } }
                }
            }
            SEAM(ph); ++ph;
        }
    }
#undef IN
#undef SEAM
#undef PH_LOCALS
#undef INP
#undef MOE_PTRS
#undef EVEN_PTRS
#undef ODD_PTRS
}

extern "C" void kernel_launch(void* const* d_in, const int* in_sizes, int n_in, void* d_out, int out_size, void* d_ws, size_t ws_size, hipStream_t stream) {
    static int grid = 0;
    if (grid == 0) {
        if (n_in != 31 || in_sizes[0] != M * DM || out_size != M * DM || ws_size < WS_END) { fprintf(stderr, "kernel_launch: unexpected shapes (n_in %d, in0 %d, out %d, ws %zu < %zu); nothing launched\n", n_in, n_in > 0 ? in_sizes[0] : -1, out_size, ws_size, (size_t)WS_END); grid = -1; return; }
        int dev = 0, cus = 0, per_cu = 0;
        if (hipGetDevice(&dev) != hipSuccess || hipDeviceGetAttribute(&cus, hipDeviceAttributeMultiprocessorCount, dev) != hipSuccess) { grid = -1; return; }
        if (hipFuncSetAttribute((const void*)mk_fwd, hipFuncAttributeMaxDynamicSharedMemorySize, LDS_BYTES) != hipSuccess) { fprintf(stderr, "kernel_launch: hipFuncSetAttribute failed\n"); grid = -1; return; }
        if (hipOccupancyMaxActiveBlocksPerMultiprocessor(&per_cu, (const void*)mk_fwd, NWAVES * 64, LDS_BYTES) != hipSuccess || per_cu < 1) { fprintf(stderr, "kernel_launch: occupancy query says %d workgroups per CU\n", per_cu); }
        (void)hipGetLastError();
        grid = cus;
        if (grid != 256) { fprintf(stderr, "kernel_launch: built for a 256-CU device, found %d CUs; nothing launched\n", cus); grid = -1; return; }
    }
    if (grid < 0) return;
    if (hipMemsetAsync((char*)d_ws + WS_CTL, 0, CTL_ZERO_BYTES, stream) != hipSuccess) return;
    Args a{};
    for (int i = 0; i < 31; ++i) a.in[i] = (const float*)d_in[i];
    a.out = (float*)d_out; a.ws = (unsigned char*)d_ws;
#if MK_ONE_LAUNCH
    a.ph_lo = 0; a.ph_hi = PH_TOTAL;
    hipLaunchKernelGGL(mk_fwd, dim3(grid), dim3(NWAVES * 64), LDS_BYTES, stream, a);
#else
#ifndef DUP_N_MASK
#define DUP_N_MASK 0
#endif
    for (int p = 0; p < PH_TOTAL; ++p) { const int q = p == 0 ? 0 : (p - 1) % (PH_EVEN + PH_ODD); const int n = p == 0 ? 0 : (q < PH_EVEN ? q + 1 : 10 + (q - PH_EVEN));
        const int reps = ((DUP_N_MASK >> n) & 1) ? 2 : 1;
        for (int r = 0; r < reps; ++r) { a.ph_lo = p; a.ph_hi = p + 1;
#ifdef DUP_VARIANT
            a.pad0 = (reps == 2 && r == 0) ? DUP_VARIANT : 0;
#endif
            hipLaunchKernelGGL(mk_fwd, dim3(grid), dim3(NWAVES * 64), LDS_BYTES, stream, a); } }
#endif
}
```

```cpp
#include <hip/hip_runtime.h>
#include <hip/hip_bf16.h>
#include <cstdio>
#include <cstdint>
#include <cmath>

#ifndef MK_ONE_LAUNCH
#define MK_ONE_LAUNCH 1
#endif

namespace pg8 {
#define PG8_LAS __attribute__((address_space(3)))
typedef unsigned short bf16_t;
typedef short bf16x8 __attribute__((ext_vector_type(8)));
typedef float f32x4 __attribute__((ext_vector_type(4)));
typedef float f32x2 __attribute__((ext_vector_type(2)));
typedef unsigned u32x4 __attribute__((ext_vector_type(4)));
typedef unsigned u32x2 __attribute__((ext_vector_type(2)));
typedef int v8i_t __attribute__((ext_vector_type(8)));
typedef int v4i_t __attribute__((ext_vector_type(4)));
constexpr int BM = 256, BK = 64, HALF = 128, HTB = HALF * BK * 2  , STAGE_BYTES = 8 * HTB, NXCD = 8, WGM = 8;

__host__ __device__ __forceinline__ int lds_byte(int r, int c) { const int st = (r >> 4) * 2 + (c >> 5), rr = r & 15, cc = c & 31, ob = rr * 64 + cc * 2; return st * 1024 + (ob ^ (((ob >> 9) & 1) << 5)); }
__host__ __device__ __forceinline__ void stage_rc(int b, int& R, int& C) { const int st = b / 1024, sb = b % 1024, swz = sb ^ (((sb >> 9) & 1) << 5); R = (st >> 1) * 16 + swz / 64; C = (st & 1) * 32 + (swz % 64) / 2; }
__host__ __device__ __forceinline__ int perm32(int rho) { const int n = rho >> 4, i = rho & 15; return 8 * (i >> 2) + 4 * n + (i & 3); }

struct Unit { int pm, pn, pb; };
struct Gemm { const bf16_t* A; const bf16_t* Bt; int M, N, K; };

struct StaticOrder {
    static constexpr bool GATHER = false;
    int nM, nN, nwg, G, c;
    __host__ __device__ void init(int M, int N, int G_, int c_) { nM = M / BM; nN = N / BM; nwg = nM * nN; G = G_; c = c_; }
    __host__ __device__ bool next(int i, Unit& u) const {
        const long L = (long)i * G + c; if (L >= nwg) return false;
        int wgid = (int)L; { const int q = nwg / NXCD, r = nwg % NXCD, xcd = wgid % NXCD, off = wgid / NXCD; wgid = (xcd < r ? xcd * (q + 1) : r * (q + 1) + (xcd - r) * q) + off; }
        const int nig = WGM * nN, gid = wgid / nig, fm = gid * WGM, gsz = (nM - fm) < WGM ? (nM - fm) : WGM;
        u.pm = fm + ((wgid % nig) % gsz); u.pn = (wgid % nig) / gsz; u.pb = u.pn; return true;
    }
    __device__ __forceinline__ unsigned a_row(const Unit& u, int r) const { return (unsigned)(u.pm * BM + r); }
};
struct PanelOrder {
    static constexpr bool GATHER = false;
    int nN, c;
    __device__ bool next(int i, Unit& u) const { if (i >= nN) return false; u.pm = c; u.pn = i; u.pb = i; return true; }
    __device__ __forceinline__ unsigned a_row(const Unit& u, int r) const { return (unsigned)(u.pm * BM + r); }
};
template <bool GATHER_> struct MoeOrder {
    static constexpr bool GATHER = GATHER_;
    int nM, nN, nwg, G, c; const int* tile_expert; const int* rowidx;
    __device__ void init(int nM_, int nN_, int G_, int c_, const int* te, const int* ri) { nM = nM_; nN = nN_; nwg = nM * nN; G = G_; c = c_; tile_expert = te; rowidx = ri; }
    __device__ bool next(int i, Unit& u) const {
        const long L = (long)i * G + c; if (L >= nwg) return false;
        int wgid = (int)L; { const int q = nwg / NXCD, r = nwg % NXCD, xcd = wgid % NXCD, off = wgid / NXCD; wgid = (xcd < r ? xcd * (q + 1) : r * (q + 1) + (xcd - r) * q) + off; }
        const int nig = WGM * nN, gid = wgid / nig, fm = gid * WGM, gsz = (nM - fm) < WGM ? (nM - fm) : WGM;
        u.pm = fm + ((wgid % nig) % gsz); u.pn = (wgid % nig) / gsz; u.pb = tile_expert[u.pm] * nN + u.pn; return true;
    }
    __device__ __forceinline__ unsigned a_row(const Unit& u, int r) const { return GATHER_ ? (unsigned)rowidx[u.pm * BM + r] : (unsigned)(u.pm * BM + r); }
};

__device__ __forceinline__ unsigned cvt_pk_bf16(float lo, float hi) { unsigned r; asm volatile("v_cvt_pk_bf16_f32 %0, %1, %2" : "=v"(r) : "v"(lo), "v"(hi)); return r; }
__device__ __forceinline__ f32x2 gelu_pk(f32x2 v) {
    const f32x2 av = __builtin_elementwise_abs(v), d = av * 0.2316418882f + 1.0f;
    f32x2 t; t.x = __builtin_amdgcn_rcpf(d.x); t.y = __builtin_amdgcn_rcpf(d.y);
    f32x2 q = t * 0.5307027145f + (-0.7265760135f); q = q * t + 0.7107068705f; q = q * t + (-0.142248368f); q = q * t + 0.127414796f; q = q * t;
    const f32x2 s = (v * v) * (-0.72134752044f);
    f32x2 e; e.x = __builtin_amdgcn_exp2f(s.x); e.y = __builtin_amdgcn_exp2f(s.y);
    const f32x2 m = v * (q * e), r = v - m;
    f32x2 o; o.x = v.x < 0.f ? m.x : r.x; o.y = v.y < 0.f ? m.y : r.y; return o;
}
__device__ __forceinline__ float silu_f(float v) { return v * __builtin_amdgcn_rcpf(1.0f + __builtin_amdgcn_exp2f(-1.4426950408889634f * v)); }


struct EpiRoute {
    static constexpr bool PERM = true, AFTER_DRAIN = false, LDS_SCALES = false;
    bf16_t* base[5]; int ldc[5]; int t0[5];
    int act[5];
    float scale[5]; int nseg;
    __device__ __forceinline__ void operator()(const f32x4 (&acc)[2][2][4][2], const Unit& u, int wr, int wc, int fr, int fq) const {
        bf16_t* O = base[0]; int ld = ldc[0], a = act[0], tt = t0[0]; float sc = scale[0];
#pragma unroll
        for (int k = 1; k < 5; ++k) if (k < nseg && u.pn >= t0[k]) { O = base[k]; ld = ldc[k]; a = act[k]; tt = t0[k]; sc = scale[k]; }
        const int row0 = u.pm * BM + wr * 64 + fr, col0 = (u.pn - tt) * BM + wc * 32 + 8 * fq;
#pragma unroll
        for (int ai = 0; ai < 2; ++ai)
#pragma unroll
            for (int m = 0; m < 4; ++m) { bf16_t* rowp = O + (size_t)(row0 + ai * HALF + m * 16) * ld + col0;
#pragma unroll
                for (int bj = 0; bj < 2; ++bj) { f32x4 v0 = acc[ai][bj][m][0], v1 = acc[ai][bj][m][1];
                    if (a == 1) { f32x2 p = gelu_pk((f32x2){v0[0], v0[1]}), q = gelu_pk((f32x2){v0[2], v0[3]}), r = gelu_pk((f32x2){v1[0], v1[1]}), t = gelu_pk((f32x2){v1[2], v1[3]});
                        v0 = (f32x4){p.x, p.y, q.x, q.y}; v1 = (f32x4){r.x, r.y, t.x, t.y}; }
                    else if (a == 2) {
#pragma unroll
                        for (int j = 0; j < 4; ++j) { v0[j] = silu_f(v0[j]); v1[j] = silu_f(v1[j]); } }
                    v0 = v0 * sc; v1 = v1 * sc; u32x4 w; w.x = cvt_pk_bf16(v0[0], v0[1]); w.y = cvt_pk_bf16(v0[2], v0[3]); w.z = cvt_pk_bf16(v1[0], v1[1]); w.w = cvt_pk_bf16(v1[2], v1[3]);
                    *(u32x4*)(rowp + bj * HALF) = w; } }
    }
};
struct EpiResF32 {
    static constexpr bool PERM = false, AFTER_DRAIN = false, LDS_SCALES = false;
    float* Y; const bf16_t* XB; int ldc; float alpha;
    __device__ __forceinline__ void operator()(const f32x4 (&acc)[2][2][4][2], const Unit& u, int wr, int wc, int fr, int fq) const {
        const int row0 = u.pm * BM + wr * 64 + fr, col0 = u.pn * BM + wc * 32 + 4 * fq;
#pragma unroll
        for (int ai = 0; ai < 2; ++ai)
#pragma unroll
            for (int m = 0; m < 4; ++m) { const size_t off = (size_t)(row0 + ai * HALF + m * 16) * ldc + col0;
#pragma unroll
                for (int bj = 0; bj < 2; ++bj)
#pragma unroll
                    for (int n = 0; n < 2; ++n) { const u32x2 xb = *(const u32x2*)(XB + off + bj * HALF + n * 16);
                        f32x4 r; r[0] = __uint_as_float(xb.x << 16); r[1] = __uint_as_float(xb.x & 0xffff0000u); r[2] = __uint_as_float(xb.y << 16); r[3] = __uint_as_float(xb.y & 0xffff0000u);
                        *(f32x4*)(Y + off + bj * HALF + n * 16) = r * alpha + acc[ai][bj][m][n]; } }
    }
};
struct EpiResFromF32 {
    static constexpr bool PERM = false, AFTER_DRAIN = false, LDS_SCALES = false;
    const float* XF; bf16_t* XB; int ldc; float alpha;
    __device__ __forceinline__ void operator()(const f32x4 (&acc)[2][2][4][2], const Unit& u, int wr, int wc, int fr, int fq) const {
        const int row0 = u.pm * BM + wr * 64 + fr, col0 = u.pn * BM + wc * 32 + 4 * fq;
#pragma unroll
        for (int ai = 0; ai < 2; ++ai)
#pragma unroll
            for (int m = 0; m < 4; ++m) { const size_t off = (size_t)(row0 + ai * HALF + m * 16) * ldc + col0;
#pragma unroll
                for (int bj = 0; bj < 2; ++bj)
#pragma unroll
                    for (int n = 0; n < 2; ++n) { f32x4 r = *(const f32x4*)(XF + off + bj * HALF + n * 16);
                        r = r * alpha + acc[ai][bj][m][n];
                        u32x2 w; w.x = cvt_pk_bf16(r[0], r[1]); w.y = cvt_pk_bf16(r[2], r[3]); *(u32x2*)(XB + off + bj * HALF + n * 16) = w; } }
    }
};
struct EpiResInplace {
    static constexpr bool PERM = true, AFTER_DRAIN = false, LDS_SCALES = false;
    bf16_t* XB; int ldc; float alpha; float inv;
    __device__ __forceinline__ void operator()(const f32x4 (&acc)[2][2][4][2], const Unit& u, int wr, int wc, int fr, int fq) const {
        const int row0 = u.pm * BM + wr * 64 + fr, col0 = u.pn * BM + wc * 32 + 8 * fq;
#pragma unroll
        for (int ai = 0; ai < 2; ++ai)
#pragma unroll
            for (int m = 0; m < 4; ++m) { const size_t off = (size_t)(row0 + ai * HALF + m * 16) * ldc + col0;
#pragma unroll
                for (int bj = 0; bj < 2; ++bj) { u32x4* p = (u32x4*)(XB + off + bj * HALF); const u32x4 xb = *p;
                    f32x4 r0, r1; r0[0] = __uint_as_float(xb.x << 16); r0[1] = __uint_as_float(xb.x & 0xffff0000u); r0[2] = __uint_as_float(xb.y << 16); r0[3] = __uint_as_float(xb.y & 0xffff0000u);
                    r1[0] = __uint_as_float(xb.z << 16); r1[1] = __uint_as_float(xb.z & 0xffff0000u); r1[2] = __uint_as_float(xb.w << 16); r1[3] = __uint_as_float(xb.w & 0xffff0000u);
                    r0 = r0 * alpha + acc[ai][bj][m][0] * inv; r1 = r1 * alpha + acc[ai][bj][m][1] * inv;
                    u32x4 w; w.x = cvt_pk_bf16(r0[0], r0[1]); w.y = cvt_pk_bf16(r0[2], r0[3]); w.z = cvt_pk_bf16(r1[0], r1[1]); w.w = cvt_pk_bf16(r1[2], r1[3]); *p = w; } }
    }
};
struct EpiSwiglu {
    static constexpr bool PERM = true, AFTER_DRAIN = false, LDS_SCALES = false;
    bf16_t* H; int ldc;
    __device__ __forceinline__ void operator()(const f32x4 (&acc)[2][2][4][2], const Unit& u, int wr, int wc, int fr, int fq) const {
        const int row0 = u.pm * BM + wr * 64 + fr, col0 = u.pn * HALF + wc * 32 + 8 * fq;
#pragma unroll
        for (int ai = 0; ai < 2; ++ai)
#pragma unroll
            for (int m = 0; m < 4; ++m) { bf16_t* rowp = H + (size_t)(row0 + ai * HALF + m * 16) * ldc + col0;
                f32x4 v0, v1;
#pragma unroll
                for (int j = 0; j < 4; ++j) { v0[j] = silu_f(acc[ai][0][m][0][j]) * acc[ai][1][m][0][j]; v1[j] = silu_f(acc[ai][0][m][1][j]) * acc[ai][1][m][1][j]; }
                u32x4 w; w.x = cvt_pk_bf16(v0[0], v0[1]); w.y = cvt_pk_bf16(v0[2], v0[3]); w.z = cvt_pk_bf16(v1[0], v1[1]); w.w = cvt_pk_bf16(v1[2], v1[3]);
                *(u32x4*)rowp = w; }
    }
};
struct EpiSwiglu8 {
    static constexpr bool PERM = true, AFTER_DRAIN = false, LDS_SCALES = false;
    unsigned char* H; int ldc; float inv;
    __device__ __forceinline__ void operator()(const f32x4 (&acc)[2][2][4][2], const Unit& u, int wr, int wc, int fr, int fq) const {
        const int row0 = u.pm * BM + wr * 64 + fr, col0 = u.pn * HALF + wc * 32 + 8 * fq;
#pragma unroll
        for (int ai = 0; ai < 2; ++ai)
#pragma unroll
            for (int m = 0; m < 4; ++m) { unsigned char* rowp = H + (size_t)(row0 + ai * HALF + m * 16) * ldc + col0;
                float v[8];
#pragma unroll
                for (int j = 0; j < 4; ++j) { v[j] = silu_f(acc[ai][0][m][0][j] * inv) * (acc[ai][1][m][0][j] * inv); v[4 + j] = silu_f(acc[ai][0][m][1][j] * inv) * (acc[ai][1][m][1][j] * inv); }
                int w0 = 0, w1 = 0;
                w0 = __builtin_amdgcn_cvt_pk_fp8_f32(v[0], v[1], w0, false); w0 = __builtin_amdgcn_cvt_pk_fp8_f32(v[2], v[3], w0, true);
                w1 = __builtin_amdgcn_cvt_pk_fp8_f32(v[4], v[5], w1, false); w1 = __builtin_amdgcn_cvt_pk_fp8_f32(v[6], v[7], w1, true);
                u32x2 w; w.x = (unsigned)w0; w.y = (unsigned)w1; *(u32x2*)rowp = w; }
    }
};
__device__ __forceinline__ f32x4 i2f4(const f32x4& a) { const v4i_t i = __builtin_bit_cast(v4i_t, a); return (f32x4){(float)i[0], (float)i[1], (float)i[2], (float)i[3]}; }
struct EpiResInplaceQ {
    static constexpr bool PERM = true, AFTER_DRAIN = false, LDS_SCALES = true;
    bf16_t* XB; int ldc; float alpha; const float* sa; const float* sw; PG8_LAS unsigned char* sbuf;
    __device__ __forceinline__ const float* row_src(const Unit& u) const { return sa + u.pm * BM; }
    __device__ __forceinline__ const float* col_src(const Unit& u) const { return sw + u.pb * BM; }
    __device__ __forceinline__ void operator()(const f32x4 (&acc)[2][2][4][2], const Unit& u, int wr, int wc, int fr, int fq) const {
        const int row0 = u.pm * BM + wr * 64 + fr, col0 = u.pn * BM + wc * 32 + 8 * fq;
        const PG8_LAS float* LR = (const PG8_LAS float*)sbuf + wr * 64 + fr; const PG8_LAS float* LC = (const PG8_LAS float*)(sbuf + 1024) + wc * 32 + 8 * fq;
        f32x4 cw[2][2];
#pragma unroll
        for (int bj = 0; bj < 2; ++bj)
#pragma unroll
            for (int n = 0; n < 2; ++n) cw[bj][n] = *(const PG8_LAS f32x4*)(LC + bj * HALF + 4 * n);
#pragma unroll
        for (int ai = 0; ai < 2; ++ai)
#pragma unroll
            for (int m = 0; m < 4; ++m) { const size_t off = (size_t)(row0 + ai * HALF + m * 16) * ldc + col0; const float rs = LR[ai * HALF + m * 16];
#pragma unroll
                for (int bj = 0; bj < 2; ++bj) { u32x4* p = (u32x4*)(XB + off + bj * HALF); const u32x4 xb = *p;
                    f32x4 r0, r1; r0[0] = __uint_as_float(xb.x << 16); r0[1] = __uint_as_float(xb.x & 0xffff0000u); r0[2] = __uint_as_float(xb.y << 16); r0[3] = __uint_as_float(xb.y & 0xffff0000u);
                    r1[0] = __uint_as_float(xb.z << 16); r1[1] = __uint_as_float(xb.z & 0xffff0000u); r1[2] = __uint_as_float(xb.w << 16); r1[3] = __uint_as_float(xb.w & 0xffff0000u);
                    r0 = r0 * alpha + i2f4(acc[ai][bj][m][0]) * rs * cw[bj][0]; r1 = r1 * alpha + i2f4(acc[ai][bj][m][1]) * rs * cw[bj][1];
                    u32x4 w; w.x = cvt_pk_bf16(r0[0], r0[1]); w.y = cvt_pk_bf16(r0[2], r0[3]); w.z = cvt_pk_bf16(r1[0], r1[1]); w.w = cvt_pk_bf16(r1[2], r1[3]); *p = w; } }
    }
};
struct EpiResFromF32Q {
    static constexpr bool PERM = true, AFTER_DRAIN = false, LDS_SCALES = true;
    const float* XF; bf16_t* XB; int ldc; float alpha; const float* sa; const float* sw; PG8_LAS unsigned char* sbuf;
    __device__ __forceinline__ const float* row_src(const Unit& u) const { return sa + u.pm * BM; }
    __device__ __forceinline__ const float* col_src(const Unit& u) const { return sw + u.pb * BM; }
    __device__ __forceinline__ void operator()(const f32x4 (&acc)[2][2][4][2], const Unit& u, int wr, int wc, int fr, int fq) const {
        const int row0 = u.pm * BM + wr * 64 + fr, col0 = u.pn * BM + wc * 32 + 8 * fq;
        const PG8_LAS float* LR = (const PG8_LAS float*)sbuf + wr * 64 + fr; const PG8_LAS float* LC = (const PG8_LAS float*)(sbuf + 1024) + wc * 32 + 8 * fq;
        f32x4 cw[2][2];
#pragma unroll
        for (int bj = 0; bj < 2; ++bj)
#pragma unroll
            for (int n = 0; n < 2; ++n) cw[bj][n] = *(const PG8_LAS f32x4*)(LC + bj * HALF + 4 * n);
#pragma unroll
        for (int ai = 0; ai < 2; ++ai)
#pragma unroll
            for (int m = 0; m < 4; ++m) { const size_t off = (size_t)(row0 + ai * HALF + m * 16) * ldc + col0; const float rs = LR[ai * HALF + m * 16];
#pragma unroll
                for (int bj = 0; bj < 2; ++bj) { f32x4 r0 = *(const f32x4*)(XF + off + bj * HALF), r1 = *(const f32x4*)(XF + off + bj * HALF + 4);
                    r0 = r0 * alpha + i2f4(acc[ai][bj][m][0]) * rs * cw[bj][0]; r1 = r1 * alpha + i2f4(acc[ai][bj][m][1]) * rs * cw[bj][1];
                    u32x4 w; w.x = cvt_pk_bf16(r0[0], r0[1]); w.y = cvt_pk_bf16(r0[2], r0[3]); w.z = cvt_pk_bf16(r1[0], r1[1]); w.w = cvt_pk_bf16(r1[2], r1[3]); *(u32x4*)(XB + off + bj * HALF) = w; } }
    }
};
struct EpiRouteQ {
    static constexpr bool PERM = true, AFTER_DRAIN = false, LDS_SCALES = true;
    bf16_t* base[5]; int ldc[5]; int t0[5]; int act[5]; float scale[5]; int nseg; const float* sa; const float* sw; PG8_LAS unsigned char* sbuf;
    __device__ __forceinline__ const float* row_src(const Unit& u) const { return sa + u.pm * BM; }
    __device__ __forceinline__ const float* col_src(const Unit& u) const { return sw + u.pb * BM; }
    __device__ __forceinline__ void operator()(const f32x4 (&acc)[2][2][4][2], const Unit& u, int wr, int wc, int fr, int fq) const {
        bf16_t* O = base[0]; int ld = ldc[0], a = act[0], tt = t0[0]; float sc = scale[0];
#pragma unroll
        for (int k = 1; k < 5; ++k) if (k < nseg && u.pn >= t0[k]) { O = base[k]; ld = ldc[k]; a = act[k]; tt = t0[k]; sc = scale[k]; }
        const int row0 = u.pm * BM + wr * 64 + fr, col0 = (u.pn - tt) * BM + wc * 32 + 8 * fq;
        const PG8_LAS float* LR = (const PG8_LAS float*)sbuf + wr * 64 + fr; const PG8_LAS float* LC = (const PG8_LAS float*)(sbuf + 1024) + wc * 32 + 8 * fq;
        f32x4 cw[2][2];
        const float csc = (a == 0) ? sc : 1.f;
#pragma unroll
        for (int bj = 0; bj < 2; ++bj)
#pragma unroll
            for (int n = 0; n < 2; ++n) cw[bj][n] = *(const PG8_LAS f32x4*)(LC + bj * HALF + 4 * n) * csc;
#pragma unroll
        for (int ai = 0; ai < 2; ++ai)
#pragma unroll
            for (int m = 0; m < 4; ++m) { const int row = row0 + ai * HALF + m * 16; const float rs = LR[ai * HALF + m * 16]; bf16_t* rowp = O + (size_t)row * ld + col0;
#pragma unroll
                for (int bj = 0; bj < 2; ++bj) { f32x4 v0 = i2f4(acc[ai][bj][m][0]) * rs * cw[bj][0], v1 = i2f4(acc[ai][bj][m][1]) * rs * cw[bj][1];
                    if (a == 1) { f32x2 p = gelu_pk((f32x2){v0[0], v0[1]}), q = gelu_pk((f32x2){v0[2], v0[3]}), r = gelu_pk((f32x2){v1[0], v1[1]}), t = gelu_pk((f32x2){v1[2], v1[3]});
                        v0 = (f32x4){p.x, p.y, q.x, q.y}; v1 = (f32x4){r.x, r.y, t.x, t.y}; }
                    else if (a == 2) {
#pragma unroll
                        for (int j = 0; j < 4; ++j) { v0[j] = silu_f(v0[j]); v1[j] = silu_f(v1[j]); } }
                    if (a != 0 && sc != 1.f) { v0 = v0 * sc; v1 = v1 * sc; } u32x4 w; w.x = cvt_pk_bf16(v0[0], v0[1]); w.y = cvt_pk_bf16(v0[2], v0[3]); w.z = cvt_pk_bf16(v1[0], v1[1]); w.w = cvt_pk_bf16(v1[2], v1[3]);
                    *(u32x4*)(rowp + bj * HALF) = w; } }
    }
};
template <bool OUT8> struct EpiSwigluQ {
    static constexpr bool PERM = true, AFTER_DRAIN = false, LDS_SCALES = true;
    void* H; int ldc; const float* sa; const float* sw; PG8_LAS unsigned char* sbuf;
    __device__ __forceinline__ const float* row_src(const Unit& u) const { return sa + u.pm * BM; }
    __device__ __forceinline__ const float* col_src(const Unit& u) const { return sw + u.pb * BM; }
    __device__ __forceinline__ void operator()(const f32x4 (&acc)[2][2][4][2], const Unit& u, int wr, int wc, int fr, int fq) const {
        const int row0 = u.pm * BM + wr * 64 + fr, col0 = u.pn * HALF + wc * 32 + 8 * fq;
        const PG8_LAS float* LR = (const PG8_LAS float*)sbuf + wr * 64 + fr; const PG8_LAS float* LC = (const PG8_LAS float*)(sbuf + 1024) + wc * 32 + 8 * fq;
        f32x4 cw[2][2], cwl[2];
#pragma unroll
        for (int bj = 0; bj < 2; ++bj)
#pragma unroll
            for (int n = 0; n < 2; ++n) cw[bj][n] = *(const PG8_LAS f32x4*)(LC + bj * HALF + 4 * n);
        cwl[0] = cw[0][0] * -1.4426950408889634f; cwl[1] = cw[0][1] * -1.4426950408889634f;
        const f32x4 cab[2] = {cw[0][0] * cw[1][0], cw[0][1] * cw[1][1]};
        unsigned char* const hb = (unsigned char*)H + ((size_t)(u.pm * (ldc / HALF) + u.pn) * 4 + wc) * 8192 + (wr * 64 + fr) * 32 + 8 * fq;
        (void)hb;
#pragma unroll
        for (int ai = 0; ai < 2; ++ai)
#pragma unroll
            for (int m = 0; m < 4; ++m) { const int row = row0 + ai * HALF + m * 16; const float rs = LR[ai * HALF + m * 16], rs2 = rs * rs;
                float v[8];
#pragma unroll
                for (int n = 0; n < 2; ++n) { const f32x4 fa = i2f4(acc[ai][0][m][n]), fb = i2f4(acc[ai][1][m][n]); const f32x4 t = (fa * cwl[n]) * rs, mm = ((fa * fb) * cab[n]) * rs2;
                    f32x4 e; e[0] = __builtin_amdgcn_exp2f(t[0]); e[1] = __builtin_amdgcn_exp2f(t[1]); e[2] = __builtin_amdgcn_exp2f(t[2]); e[3] = __builtin_amdgcn_exp2f(t[3]);
                    e = e + 1.0f; f32x4 r; r[0] = __builtin_amdgcn_rcpf(e[0]); r[1] = __builtin_amdgcn_rcpf(e[1]); r[2] = __builtin_amdgcn_rcpf(e[2]); r[3] = __builtin_amdgcn_rcpf(e[3]);
                    const f32x4 o = mm * r; v[4 * n] = o[0]; v[4 * n + 1] = o[1]; v[4 * n + 2] = o[2]; v[4 * n + 3] = o[3]; }
                if constexpr (OUT8) { int w0 = 0, w1 = 0;
                    w0 = __builtin_amdgcn_cvt_pk_fp8_f32(v[0], v[1], w0, false); w0 = __builtin_amdgcn_cvt_pk_fp8_f32(v[2], v[3], w0, true);
                    w1 = __builtin_amdgcn_cvt_pk_fp8_f32(v[4], v[5], w1, false); w1 = __builtin_amdgcn_cvt_pk_fp8_f32(v[6], v[7], w1, true);
                    u32x2 w; w.x = (unsigned)w0; w.y = (unsigned)w1;
                    *(u32x2*)(hb + ai * 4096 + m * 512) = w; }
                else { u32x4 w; w.x = cvt_pk_bf16(v[0], v[1]); w.y = cvt_pk_bf16(v[2], v[3]); w.z = cvt_pk_bf16(v[4], v[5]); w.w = cvt_pk_bf16(v[6], v[7]);
                    *(u32x4*)((bf16_t*)H + (size_t)row * ldc + col0) = w; } }
    }
};
struct EpiMoeDown {
    static constexpr bool PERM = true, AFTER_DRAIN = false, LDS_SCALES = true;
    bf16_t* O; int ldc; const float* gate; float inv; PG8_LAS unsigned char* sbuf;
    __device__ __forceinline__ const float* row_src(const Unit& u) const { return gate + u.pm * BM; }
    __device__ __forceinline__ const float* col_src(const Unit& u) const { return gate + u.pm * BM; }
    __device__ __forceinline__ void operator()(const f32x4 (&acc)[2][2][4][2], const Unit& u, int wr, int wc, int fr, int fq) const {
        const int row0 = u.pm * BM + wr * 64 + fr, col0 = u.pn * BM + wc * 32 + 8 * fq;
        const PG8_LAS float* LR = (const PG8_LAS float*)sbuf + wr * 64 + fr;
#pragma unroll
        for (int ai = 0; ai < 2; ++ai)
#pragma unroll
            for (int m = 0; m < 4; ++m) { const int row = row0 + ai * HALF + m * 16; const float gt = LR[ai * HALF + m * 16] * inv; bf16_t* rowp = O + (size_t)row * ldc + col0;
#pragma unroll
                for (int bj = 0; bj < 2; ++bj) { const f32x4 v0 = acc[ai][bj][m][0] * gt, v1 = acc[ai][bj][m][1] * gt;
                    u32x4 w; w.x = cvt_pk_bf16(v0[0], v0[1]); w.y = cvt_pk_bf16(v0[2], v0[3]); w.z = cvt_pk_bf16(v1[0], v1[1]); w.w = cvt_pk_bf16(v1[2], v1[3]);
                    *(u32x4*)(rowp + bj * HALF) = w; } }
    }
};

template <class Epi, class Sched, bool ALIGN_EPI = false, bool SP2 = false, int MODE = 0, bool AT = false>
__device__ __forceinline__ void gemm_phase(PG8_LAS unsigned char* lds, const Gemm g, const Sched& S, Epi& E, int wave_) {
    int tid_; { int l_; asm volatile("v_mbcnt_lo_u32_b32 %0, -1, 0\n\tv_mbcnt_hi_u32_b32 %0, -1, %0" : "=v"(l_)); tid_ = wave_ * 64 + l_; }
    constexpr bool GATHER = Sched::GATHER;
    const int tid = tid_, wid = __builtin_amdgcn_readfirstlane(wave_), lane = tid & 63, wr = wid >> 2, wc = wid & 3, fr = lane & 15, fq = lane >> 4;
    constexpr bool FP8 = (MODE == 1), I8 = (MODE == 2); constexpr int ES = MODE ? 1 : 2;
    const int K = g.K, nt = K * ES / (BK * 2);
    unsigned voffA[2], voffB[2]; int RA[2], CA[2];
#pragma unroll
    for (int i = 0; i < 2; ++i) { int R, C; stage_rc(tid * 16 + i * 8192, R, C); const int Rb = Epi::PERM ? ((R & ~31) + perm32(R & 31)) : R;
        RA[i] = R; CA[i] = C * 2; voffA[i] = AT ? (unsigned)(((C * 2) >> 5) * 8192 + R * 32 + ((C * 2) & 16)) : (unsigned)(R * K * ES + C * 2); voffB[i] = (unsigned)(Rb * K * ES + C * 2); }
    const unsigned K2 = (unsigned)(K * ES);
#define PG8_MKVA(dst, u) do { if constexpr (GATHER) { _Pragma("unroll") for (int _h = 0; _h < 2; ++_h) _Pragma("unroll") for (int _i = 0; _i < 2; ++_i) dst[_h][_i] = S.a_row(u, _h * HALF + RA[_i]) * K2 + (unsigned)CA[_i]; } } while (0)
#define PG8_ABASE(u) (GATHER ? (const char*)g.A : (const char*)g.A + (size_t)(u).pm * tstep)
    const size_t kstep = (size_t)(BK * 2);
    const size_t hstep = (size_t)HALF * K * ES;
    const size_t kstepA = AT ? (size_t)32768 : kstep, hstepA = AT ? (size_t)HALF * 32 : hstep;
    const size_t tstep = 2 * hstep;
    const unsigned ldsw = (unsigned)wid * 1024u;
    const int aoff = lds_byte(wr * 64 + fr, fq * 8), boff = lds_byte(wc * 32 + fr, fq * 8);
#define PG8_SA(b, h) (((b) * 2 + (h)) * HTB)
#define PG8_SB(b, h) ((4 + (b) * 2 + (h)) * HTB)
#define PG8_STAGE(bufoff, gbase, voff) do { _Pragma("unroll") for (int _i = 0; _i < 2; ++_i) \
        __builtin_amdgcn_global_load_lds((const unsigned*)((const char*)(gbase) + (voff)[_i]), (PG8_LAS unsigned*)(lds + (bufoff) + ldsw + _i * 8192), 16, 0, 0); } while (0)
#define PG8_STAGE_A(bufoff, gbase, VA, h) do { if constexpr (GATHER) { _Pragma("unroll") for (int _i = 0; _i < 2; ++_i) \
        __builtin_amdgcn_global_load_lds((const unsigned*)((const char*)(gbase) + (VA)[h][_i]), (PG8_LAS unsigned*)(lds + (bufoff) + ldsw + _i * 8192), 16, 0, 0); } \
        else { _Pragma("unroll") for (int _i = 0; _i < 2; ++_i) \
        __builtin_amdgcn_global_load_lds((const unsigned*)((const char*)(gbase) + (h) * hstepA + voffA[_i]), (PG8_LAS unsigned*)(lds + (bufoff) + ldsw + _i * 8192), 16, 0, 0); } } while (0)
#define PG8_LDA(dst, b, h) do { _Pragma("unroll") for (int m = 0; m < 4; ++m) _Pragma("unroll") for (int k = 0; k < 2; ++k) dst[m][k] = *(const PG8_LAS bf16x8*)(lds + PG8_SA(b, h) + aoff + m * 2048 + k * 1024); } while (0)
#define PG8_LDB(dst, b, h) do { _Pragma("unroll") for (int n = 0; n < 2; ++n) _Pragma("unroll") for (int k = 0; k < 2; ++k) dst[n][k] = *(const PG8_LAS bf16x8*)(lds + PG8_SB(b, h) + boff + n * 2048 + k * 1024); } while (0)
#define PG8_CAT(x) __builtin_bit_cast(v8i_t, __builtin_shufflevector(x[0], x[1], 0, 1, 2, 3, 4, 5, 6, 7, 8, 9, 10, 11, 12, 13, 14, 15))
#define PG8_MMA(ai, bj, At, Bt) do { __builtin_amdgcn_s_setprio(1); if constexpr (FP8) { _Pragma("unroll") for (int m = 0; m < 4; ++m) _Pragma("unroll") for (int n = 0; n < 2; ++n) \
        { const v8i_t a8_ = PG8_CAT(Bt[n]), b8_ = PG8_CAT(At[m]); asm volatile("v_mfma_f32_16x16x128_f8f6f4 %0, %1, %2, %0" : "+v"(acc[ai][bj][m][n]) : "v"(a8_), "v"(b8_)); } } \
        else if constexpr (I8) { _Pragma("unroll") for (int m = 0; m < 4; ++m) _Pragma("unroll") for (int n = 0; n < 2; ++n) _Pragma("unroll") for (int k = 0; k < 2; ++k) \
        acc[ai][bj][m][n] = __builtin_bit_cast(f32x4, __builtin_amdgcn_mfma_i32_16x16x64_i8(__builtin_bit_cast(v4i_t, Bt[n][k]), __builtin_bit_cast(v4i_t, At[m][k]), __builtin_bit_cast(v4i_t, acc[ai][bj][m][n]), 0, 0, 0)); } \
        else { _Pragma("unroll") for (int m = 0; m < 4; ++m) _Pragma("unroll") for (int n = 0; n < 2; ++n) _Pragma("unroll") for (int k = 0; k < 2; ++k) \
        acc[ai][bj][m][n] = __builtin_amdgcn_mfma_f32_16x16x32_bf16(Bt[n][k], At[m][k], acc[ai][bj][m][n], 0, 0, 0); } __builtin_amdgcn_s_setprio(0); } while (0)
#define PG8_WAIT_V(n) asm volatile("s_waitcnt vmcnt(" #n ")" ::: "memory")
#define PG8_WAIT_L(n) asm volatile("s_waitcnt lgkmcnt(" #n ")" ::: "memory")
#define PG8_BAR __builtin_amdgcn_s_barrier()
#define PG8_SCHED __builtin_amdgcn_sched_barrier(0)
    Unit cur, nxt; int ui = 0;
    if (!S.next(0, cur)) return;
    f32x4 acc[2][2][4][2];
#pragma unroll
    for (int a = 0; a < 2; ++a)
#pragma unroll
        for (int b = 0; b < 2; ++b)
#pragma unroll
            for (int m = 0; m < 4; ++m)
#pragma unroll
                for (int n = 0; n < 2; ++n) acc[a][b][m][n] = (f32x4){0.f, 0.f, 0.f, 0.f};
    bf16x8 At[4][2], B0[2][2], B1[2][2];
    const char* cA = PG8_ABASE(cur); const char* cB = (const char*)g.Bt + (size_t)cur.pb * tstep;
    unsigned va[2][2] = {{0u, 0u}, {0u, 0u}}, nva[2][2] = {{0u, 0u}, {0u, 0u}}; PG8_MKVA(va, cur);
#define PG8_SCALES(u, b) do { if constexpr (Epi::LDS_SCALES) { if (wid < 2) { const float* s_ = (wid == 0) ? E.row_src(u) : E.col_src(u); \
        __builtin_amdgcn_global_load_lds((const unsigned*)(s_ + lane * 4), (PG8_LAS unsigned*)(lds + STAGE_BYTES + (b) * 2048 + wid * 1024), 16, 0, 0); } } } while (0)
    PG8_SCALES(cur, 0);
    if constexpr (SP2) {
        PG8_STAGE(PG8_SB(0, 0), cB, voffB); PG8_STAGE(PG8_SB(0, 1), cB + hstep, voffB); PG8_STAGE_A(PG8_SA(0, 0), cA, va, 0); PG8_STAGE_A(PG8_SA(0, 1), cA, va, 1);
        if (wr == 1) PG8_BAR;
        PG8_WAIT_V(2); PG8_BAR;
        PG8_STAGE(PG8_SB(1, 0), cB + kstep, voffB); PG8_STAGE_A(PG8_SA(1, 0), cA + kstepA, va, 0); PG8_STAGE(PG8_SB(1, 1), cB + hstep + kstep, voffB);
        PG8_WAIT_V(6); PG8_BAR;
    } else {
        PG8_STAGE(PG8_SB(0, 0), cB, voffB); PG8_STAGE_A(PG8_SA(0, 0), cA, va, 0); PG8_STAGE(PG8_SB(0, 1), cB + hstep, voffB); PG8_STAGE_A(PG8_SA(0, 1), cA, va, 1);
        if (wr == 1) PG8_BAR;
        PG8_WAIT_V(4); PG8_BAR;
        PG8_STAGE(PG8_SB(1, 0), cB + kstep, voffB); PG8_STAGE_A(PG8_SA(1, 0), cA + kstepA, va, 0); PG8_STAGE(PG8_SB(1, 1), cB + hstep + kstep, voffB);
        PG8_WAIT_V(6); PG8_BAR;
    }
    for (;;) {
        const bool has_next = S.next(ui + 1, nxt);
        const char* nA = has_next ? PG8_ABASE(nxt) : cA; const char* nB = has_next ? (const char*)g.Bt + (size_t)nxt.pb * tstep : cB;
        if (has_next) PG8_SCALES(nxt, (ui + 1) % 3);
        if constexpr (GATHER) { if (has_next) PG8_MKVA(nva, nxt); else { _Pragma("unroll") for (int _h = 0; _h < 2; ++_h) _Pragma("unroll") for (int _i = 0; _i < 2; ++_i) nva[_h][_i] = va[_h][_i]; } }
#pragma unroll 1
        for (int t = 0; t < nt; t += 2) {
            const bool last = (t == nt - 2);
            const char* a1 = cA + (size_t)(t + 1) * kstepA;
            const char* a2 = last ? nA : cA + (size_t)(t + 2) * kstepA; const char* b2 = last ? nB : cB + (size_t)(t + 2) * kstep;
            const char* a3 = a2 + kstepA; const char* b3 = b2 + kstep;
            unsigned o2[2][2] = {{0u, 0u}, {0u, 0u}};
            if constexpr (GATHER) {
#pragma unroll
                for (int _h = 0; _h < 2; ++_h)
#pragma unroll
                    for (int _i = 0; _i < 2; ++_i) o2[_h][_i] = last ? nva[_h][_i] : va[_h][_i]; }
            if constexpr (SP2) {
            PG8_LDB(B0, 0, 0); PG8_LDB(B1, 0, 1); PG8_SCHED; PG8_LDA(At, 0, 0); PG8_STAGE_A(PG8_SA(1, 1), a1, va, 1);
            PG8_WAIT_V(8); PG8_WAIT_L(0); PG8_BAR; PG8_MMA(0, 0, At, B0); PG8_MMA(0, 1, At, B1); PG8_BAR; PG8_SCHED;
            PG8_LDA(At, 0, 1); PG8_STAGE(PG8_SB(0, 0), b2, voffB); PG8_STAGE(PG8_SB(0, 1), b2 + hstep, voffB); PG8_STAGE_A(PG8_SA(0, 0), a2, o2, 0);
            PG8_WAIT_V(8); PG8_WAIT_L(0); PG8_BAR; PG8_MMA(1, 0, At, B0); PG8_MMA(1, 1, At, B1); PG8_BAR; PG8_SCHED;
            PG8_LDB(B0, 1, 0); PG8_LDB(B1, 1, 1); PG8_SCHED; PG8_LDA(At, 1, 0); PG8_STAGE_A(PG8_SA(0, 1), a2, o2, 1);
            PG8_WAIT_V(8); PG8_WAIT_L(0); PG8_BAR; PG8_MMA(0, 0, At, B0); PG8_MMA(0, 1, At, B1); PG8_BAR; PG8_SCHED;
            PG8_LDA(At, 1, 1); PG8_STAGE(PG8_SB(1, 0), b3, voffB); PG8_STAGE(PG8_SB(1, 1), b3 + hstep, voffB); PG8_STAGE_A(PG8_SA(1, 0), a3, o2, 0);
            PG8_WAIT_V(8); PG8_WAIT_L(0); PG8_BAR; PG8_MMA(1, 0, At, B0); PG8_MMA(1, 1, At, B1); PG8_BAR; PG8_SCHED;
            } else {
            PG8_LDB(B0, 0, 0); PG8_SCHED; PG8_LDA(At, 0, 0); PG8_STAGE_A(PG8_SA(1, 1), a1, va, 1);
            PG8_WAIT_L(8); PG8_BAR; PG8_WAIT_L(0); PG8_MMA(0, 0, At, B0); PG8_BAR; PG8_SCHED;
            PG8_LDB(B1, 0, 1); PG8_STAGE(PG8_SB(0, 0), b2, voffB);
            PG8_BAR; PG8_WAIT_L(0); PG8_MMA(0, 1, At, B1); PG8_BAR;
            PG8_LDA(At, 0, 1); PG8_STAGE_A(PG8_SA(0, 0), a2, o2, 0);
            PG8_BAR; PG8_WAIT_L(0); PG8_MMA(1, 0, At, B0); PG8_BAR; PG8_SCHED;
            PG8_STAGE(PG8_SB(0, 1), b2 + hstep, voffB);
            PG8_WAIT_V(6); PG8_BAR; PG8_MMA(1, 1, At, B1); PG8_BAR;
            PG8_LDB(B0, 1, 0); PG8_SCHED; PG8_LDA(At, 1, 0); PG8_STAGE_A(PG8_SA(0, 1), a2, o2, 1);
            PG8_WAIT_L(8); PG8_BAR; PG8_WAIT_L(0); PG8_MMA(0, 0, At, B0); PG8_BAR; PG8_SCHED;
            PG8_LDB(B1, 1, 1); PG8_STAGE(PG8_SB(1, 0), b3, voffB);
            PG8_BAR; PG8_WAIT_L(0); PG8_MMA(0, 1, At, B1); PG8_BAR;
            PG8_LDA(At, 1, 1); PG8_STAGE_A(PG8_SA(1, 0), a3, o2, 0);
            PG8_BAR; PG8_WAIT_L(0); PG8_MMA(1, 0, At, B0); PG8_BAR; PG8_SCHED;
            PG8_STAGE(PG8_SB(1, 1), b3 + hstep, voffB);
            PG8_WAIT_V(6); PG8_BAR; PG8_MMA(1, 1, At, B1); PG8_BAR;
            }
        }
        if constexpr (ALIGN_EPI) { if (wr == 0) PG8_BAR; }
        if constexpr (FP8) asm volatile("s_nop 15\n\ts_nop 7" ::: "memory");
        if constexpr (Epi::LDS_SCALES) E.sbuf = lds + STAGE_BYTES + (ui % 3) * 2048;
        E(acc, cur, wr, wc, fr, fq);
        if (!has_next) break;
#pragma unroll
        for (int a = 0; a < 2; ++a)
#pragma unroll
            for (int b = 0; b < 2; ++b)
#pragma unroll
                for (int m = 0; m < 4; ++m)
#pragma unroll
                    for (int n = 0; n < 2; ++n) acc[a][b][m][n] = (f32x4){0.f, 0.f, 0.f, 0.f};
        cur = nxt; cA = nA; cB = nB; ++ui;
        if constexpr (GATHER) {
#pragma unroll
            for (int _h = 0; _h < 2; ++_h)
#pragma unroll
                for (int _i = 0; _i < 2; ++_i) va[_h][_i] = nva[_h][_i]; }
        if constexpr (ALIGN_EPI) { if (wr == 1) PG8_BAR; }
    }
    PG8_WAIT_V(0);
    if constexpr (!ALIGN_EPI) { if (wr == 0) PG8_BAR; }
    PG8_BAR;
#undef PG8_SA
#undef PG8_SB
#undef PG8_STAGE
#undef PG8_STAGE_A
#undef PG8_MKVA
#undef PG8_ABASE
#undef PG8_LDA
#undef PG8_LDB
#undef PG8_MMA
#undef PG8_SCALES
#undef PG8_CAT
#undef PG8_WAIT_V
#undef PG8_WAIT_L
#undef PG8_BAR
#undef PG8_SCHED
}
}

#include <hip/hip_bf16.h>
#include <cmath>
namespace attn_body {
using bf16=__hip_bfloat16;
using bf16x8=__attribute__((ext_vector_type(8)))short;
using s16x4=__attribute__((ext_vector_type(4)))short;
using f32x16=__attribute__((ext_vector_type(16)))float;
using u32x4=__attribute__((ext_vector_type(4)))unsigned;
constexpr int SEQ=4096,D=64,DM=512;
constexpr int NW=8,QBLK=32,QB=QBLK*NW,KVBLK=64,NQB=SEQ/QB;
constexpr int ATTN_PITCH=DM, ATTN_UNIT_ROWS=QB;
__device__ __forceinline__ int crow(int r,int hi){return (r&3)+8*(r>>2)+4*hi;}
#define SBAR() __builtin_amdgcn_sched_barrier(0)
__device__ __forceinline__ void cmask(f32x16&p0,f32x16&p1,int jb,int qrel,int hi){
  const float NEG=-INFINITY; int kb=64*jb+4*hi;
  #pragma unroll
  for(int r=0;r<16;++r){int kv=kb+(r&3)+8*(r>>2); if(kv>qrel)p0[r]=NEG; if(kv+32>qrel)p1[r]=NEG;}
}

constexpr int NSLOT=3, SLOTB=8192;
constexpr int LDS_K=0, LDS_V=NSLOT*SLOTB, LDS_WS=3*NSLOT*SLOTB, LDS_OST=LDS_WS+NW*64*4, LDS_BYTES=LDS_OST+NW*8192;
constexpr float C2=0.125f*1.4426950408889634f;
__device__ __forceinline__ void glds16(const void*gsrc,unsigned lds_dst){unsigned keep;
  asm volatile("s_mov_b32 %0, m0\n\ts_mov_b32 m0, %2\n\ts_nop 0\n\tglobal_load_lds_dwordx4 %1, off\n\ts_mov_b32 m0, %0":"=&s"(keep):"v"(gsrc),"s"(lds_dst):"memory");}
__device__ __forceinline__ void glds16s(unsigned voff,const void*sbase,unsigned lds_dst){unsigned keep;
  const unsigned long long b=(unsigned long long)sbase; const unsigned blo=__builtin_amdgcn_readfirstlane((unsigned)b),bhi=__builtin_amdgcn_readfirstlane((unsigned)(b>>32));
  const unsigned long long sb=((unsigned long long)bhi<<32)|blo;
  asm volatile("s_mov_b32 %0, m0\n\ts_mov_b32 m0, %2\n\ts_nop 4\n\tglobal_load_lds_dwordx4 %1, %3\n\ts_mov_b32 m0, %0":"=&s"(keep):"v"(voff),"s"(lds_dst),"s"(sb):"memory");}
__device__ __forceinline__ float max3f(float a,float b,float c){float r;asm("v_max3_f32 %0, %1, %2, %3":"=v"(r):"v"(a),"v"(b),"v"(c));return r;}
__device__ __forceinline__ float max2f(float a,float b){float r;asm("v_max_f32_e32 %0, %1, %2":"=v"(r):"v"(a),"v"(b));return r;}
__device__ __forceinline__ float fadd_s(float a,float b){float r;asm("v_add_f32_e32 %0, %1, %2":"=v"(r):"v"(a),"v"(b));return r;}
__device__ __forceinline__ float fsub_s(float a,float b){float r;asm("v_sub_f32_e32 %0, %1, %2":"=v"(r):"v"(a),"v"(b));return r;}
typedef float f32x2_t __attribute__((ext_vector_type(2))); typedef __bf16 bf16x2_t __attribute__((ext_vector_type(2)));
__device__ __forceinline__ unsigned cvtpk_s(float lo,float hi){f32x2_t v={lo,hi};bf16x2_t b=__builtin_convertvector(v,bf16x2_t);return __builtin_bit_cast(unsigned,b);}
#define WAIT_BAR(N) asm volatile("s_waitcnt vmcnt(" #N ") lgkmcnt(0)\n\ts_barrier":::"memory")

__device__ __forceinline__ void qkt(f32x16&p0,f32x16&p1,const char*Kslot,const bf16x8*qr,const f32x16&c0,const f32x16&c1,int r32,int hi){
  const char*kb=Kslot+hi*1024+r32*16;
  #pragma unroll
  for(int d0=0;d0<4;++d0){
    const bf16x8 b0=*reinterpret_cast<const bf16x8*>(kb+d0*2048);
    const bf16x8 b1=*reinterpret_cast<const bf16x8*>(kb+d0*2048+512);
    if(d0==0){p0=__builtin_amdgcn_mfma_f32_32x32x16_bf16(b0,qr[0],c0,0,0,0);p1=__builtin_amdgcn_mfma_f32_32x32x16_bf16(b1,qr[0],c1,0,0,0);}
    else{p0=__builtin_amdgcn_mfma_f32_32x32x16_bf16(b0,qr[d0],p0,0,0,0);p1=__builtin_amdgcn_mfma_f32_32x32x16_bf16(b1,qr[d0],p1,0,0,0);}}
}
typedef __attribute__((address_space(3))) const char* lds_cptr;
typedef short v4i16_t __attribute__((ext_vector_type(4)));
__device__ __forceinline__ void kload8(bf16x8*kf,lds_cptr kp){
  kf[0]=*(const __attribute__((address_space(3))) bf16x8*)(kp);      kf[1]=*(const __attribute__((address_space(3))) bf16x8*)(kp+512);
  kf[2]=*(const __attribute__((address_space(3))) bf16x8*)(kp+2048); kf[3]=*(const __attribute__((address_space(3))) bf16x8*)(kp+2560);
  kf[4]=*(const __attribute__((address_space(3))) bf16x8*)(kp+4096); kf[5]=*(const __attribute__((address_space(3))) bf16x8*)(kp+4608);
  kf[6]=*(const __attribute__((address_space(3))) bf16x8*)(kp+6144); kf[7]=*(const __attribute__((address_space(3))) bf16x8*)(kp+6656);
}
__device__ __forceinline__ void kload2(bf16x8*kf,lds_cptr kp,int j){ kf[2*j]=*(const __attribute__((address_space(3))) bf16x8*)(kp+j*2048); kf[2*j+1]=*(const __attribute__((address_space(3))) bf16x8*)(kp+j*2048+512); }
__device__ __forceinline__ s16x4 vtr(lds_cptr p){ return __builtin_bit_cast(s16x4,__builtin_amdgcn_ds_read_tr16_b64_v4i16((__attribute__((address_space(3))) v4i16_t*)p)); }
__device__ __forceinline__ float rowmax(const f32x16&p0,const f32x16&p1){
  float a=max3f(p0[0],p0[1],p1[0]),b=max3f(p0[2],p0[3],p1[1]);a=max3f(a,p1[2],p1[3]);
  #pragma unroll
  for(int r=4;r<16;r+=4){a=max3f(a,p0[r],p0[r+1]);b=max3f(b,p0[r+2],p0[r+3]);a=max3f(a,p1[r],p1[r+1]);b=max3f(b,p1[r+2],p1[r+3]);}
  const float m=max2f(a,b);
  auto rr=__builtin_amdgcn_permlane32_swap(__float_as_uint(m),__float_as_uint(m),false,false);
  return max2f(__uint_as_float(rr[0]),__uint_as_float(rr[1]));
}
__device__ __forceinline__ void pv(f32x16*o,int vb,bf16x8 pa0,bf16x8 pa1,bf16x8 pa2,bf16x8 pa3){
  #pragma unroll
  for(int d0=0;d0<4;++d0){s16x4 lo[4],hi[4];
    #pragma unroll
    for(int ks=0;ks<4;++ks){
      asm volatile("ds_read_b64_tr_b16 %0,%1 offset:%c2":"=&v"(lo[ks]):"v"(vb),"i"(d0*4096+ks*1024):"memory");
      asm volatile("ds_read_b64_tr_b16 %0,%1 offset:%c2":"=&v"(hi[ks]):"v"(vb),"i"(d0*4096+ks*1024+512):"memory");}
    asm volatile("s_waitcnt lgkmcnt(0)":::"memory");SBAR();
    #define PK(k) (bf16x8){lo[k][0],lo[k][1],lo[k][2],lo[k][3],hi[k][0],hi[k][1],hi[k][2],hi[k][3]}
    o[d0]=__builtin_amdgcn_mfma_f32_32x32x16_bf16(pa0,PK(0),o[d0],0,0,0);
    o[d0]=__builtin_amdgcn_mfma_f32_32x32x16_bf16(pa1,PK(1),o[d0],0,0,0);
    o[d0]=__builtin_amdgcn_mfma_f32_32x32x16_bf16(pa2,PK(2),o[d0],0,0,0);
    o[d0]=__builtin_amdgcn_mfma_f32_32x32x16_bf16(pa3,PK(3),o[d0],0,0,0);
    #undef PK
  }
}

#ifndef ATTN_STORE16
#define ATTN_STORE16(p,v) (*(u32x4*)(p)=(v))
#endif
template<int THRL> __device__ __forceinline__ void attn_unit(int b,int hq,int hv  ,float sl2,int qb,const bf16*Q,const bf16*__restrict__ K,const bf16*__restrict__ V,bf16*O,char*shm,int wave_){
  int lane_; asm volatile("v_mbcnt_lo_u32_b32 %0, -1, 0\n\tv_mbcnt_hi_u32_b32 %0, -1, %0":"=v"(lane_)); const int wid=__builtin_amdgcn_readfirstlane(wave_),lane=lane_,r32=lane&31,hi=lane>>5;
  const long rowbase=(long)b*SEQ; const int q0=qb*QB;
  const bf16*Qw=Q+(rowbase+q0+wid*QBLK)*DM+hq*D;
  const bf16*Kh=K+rowbase*DM+hq*D,*Vh=V+rowbase*DM+hv*(2*D);
  const unsigned lds0=(unsigned)(uintptr_t)shm;
  float*wsf=(float*)(shm+LDS_WS)+wid*64;
  const unsigned koff=(unsigned)(lane*DM+wid*8)*2u;
  const unsigned voff=(unsigned)((16*(wid&3)+(lane>>2))*DM+(wid>>2)*32+(lane&3)*8)*2u;
  const unsigned kdst=lds0+LDS_K+wid*1024, vdst=lds0+LDS_V+wid*1024;
  #define DMA_K(t,slot) glds16s(koff,Kh+(long)(t)*KVBLK*DM,(unsigned)__builtin_amdgcn_readfirstlane(kdst+(slot)))
  #define DMA_V(t,slot) do{ glds16s(voff,Vh+(long)(t)*KVBLK*DM,(unsigned)__builtin_amdgcn_readfirstlane(vdst+2*(slot))); glds16s(voff,Vh+64+(long)(t)*KVBLK*DM,(unsigned)__builtin_amdgcn_readfirstlane(vdst+2*(slot)+8192)); }while(0)
  const char*Kbase=shm+LDS_K; bf16x8 kf[8];
  const lds_cptr shm3=(lds_cptr)shm; const lds_cptr kp0=shm3+LDS_K+hi*1024+r32*16; const lds_cptr vp0=shm3+LDS_V+((lane>>4)&1)*32+(lane&3)*8+(4*hi+((lane&15)>>2))*64;
  const int NT=(q0+QB)/KVBLK;
  DMA_K(0,0);DMA_V(0,0);DMA_K(1,SLOTB);
  bf16x8 qr[4];
  #pragma unroll
  for(int d0=0;d0<4;++d0)qr[d0]=*reinterpret_cast<const bf16x8*>(&Qw[(long)r32*DM+d0*16+hi*8]);
  float l_reg=0.f;f32x16 o[4];o[0]=f32x16{};o[1]=f32x16{};o[2]=f32x16{};o[3]=f32x16{};
  const int qrel=wid*QBLK+r32;
  float nb=sl2*(float)(4*hi-(q0+qrel));
  #define MKC0(C0) do{ _Pragma("unroll") for(int r=0;r<16;++r)C0[r]=__builtin_fmaf(sl2,(float)((r&3)+8*(r>>2)),nb); }while(0)
  #define MKC1(C1) do{ _Pragma("unroll") for(int r=0;r<16;++r)C1[r]=__builtin_fmaf(sl2,(float)((r&3)+8*(r>>2)+32),nb); }while(0)
  #define CMASK(P0,P1,t) do{int jb_=(t)-(NT-4); if(jb_>=0)cmask(P0,P1,jb_,qrel,hi);}while(0)
  bool resc=false;
  #define START(P0,P1) do{ const float rm=rowmax(P0,P1); resc=false; \
    { const float dl=rm; nb=fsub_s(nb,dl); \
      _Pragma("unroll") for(int r=0;r<16;++r){P0[r]=fsub_s(P0[r],dl);P1[r]=fsub_s(P1[r],dl);} } \
    _Pragma("unroll") for(int r=0;r<16;++r)P0[r]=__builtin_amdgcn_exp2f(P0[r]); }while(0)
  #define RESC() do{ if(resc){ asm volatile("s_waitcnt lgkmcnt(0)":::"memory"); \
      _Pragma("unroll") for(int d_=0;d_<4;++d_) _Pragma("unroll") for(int r=0;r<16;++r)o[d_][r]*=wsf[crow(r,hi)]; } }while(0)
  f32x16 pA0,pA1,pB0,pB1;
  int sl_prev=0,sl_cur=0,sl_next=SLOTB;
  #define ROT() do{sl_prev=sl_cur;sl_cur=sl_next;sl_next=(sl_next==(NSLOT-1)*SLOTB)?0:sl_next+SLOTB;}while(0)
  DMA_K(2,2*SLOTB);
  WAIT_BAR(4);
  { f32x16 ci0,ci1; MKC0(ci0); MKC1(ci1); qkt(pA0,pA1,Kbase,qr,ci0,ci1,r32,hi); } asm volatile("s_nop 15\n\ts_nop 7":"+v"(pA0),"+v"(pA1));CMASK(pA0,pA1,0);
  START(pA0,pA1);
  _Pragma("unroll") for(int r=0;r<16;++r)pA1[r]=__builtin_amdgcn_exp2f(pA1[r]);
  WAIT_BAR(0);
  DMA_K(3,0);DMA_V(1,SLOTB);
  ROT();
  kload8(kf,kp0+sl_cur);
  WAIT_BAR(3);
  s16x4 vlo[8],vhi[8]; u32x4 pw0,pw1,pw2,pw3;
  #define PKW(P,B) cvtpk_s(P[B],P[B+1])
  #define PAF(k) __builtin_bit_cast(bf16x8,pw##k)
  #define VFR(i) (bf16x8){vlo[i][0],vlo[i][1],vlo[i][2],vlo[i][3],vhi[i][0],vhi[i][1],vhi[i][2],vhi[i][3]}
  #define PIN(x) asm volatile("":"+v"(x))
  #define MX3(a,b,c) __builtin_fmaxf(__builtin_fmaxf((a),(b)),(c))
  #define GAPA(MF,A0,A1,A2,A3,W0,W1,PW) do{ MF; sacc+=A0; sacc+=A1; sacc+=A2; sacc+=A3; PIN(sacc); W0; W1; PIN(PW); SBAR(); }while(0)
  #define EX(v) __builtin_amdgcn_exp2f(v)
  #define GAPB(MF,X,B) do{ MF; X[B]=EX(X[B]); X[B+1]=EX(X[B+1]); PIN(X); SBAR(); }while(0)
  #define VRD2(i) do{ vlo[i]=vtr(vp_+((((i)>>2)+2)*4096+((i)&3)*1024)); vhi[i]=vtr(vp_+((((i)>>2)+2)*4096+((i)&3)*1024+512)); }while(0)
  #define VRD(i) do{ vlo[i]=vtr(vp_+(((i)>>2)*4096+((i)&3)*1024)); vhi[i]=vtr(vp_+(((i)>>2)*4096+((i)&3)*1024+512)); }while(0)
  #define KRD(G,j) do{ if(G){ kload2(kf,kp0+sl_next,j); SBAR(); } }while(0)
  #define STEP(C0,C1,P0,P1,t,GK,GV,GL) do{ SBAR(); \
    nb=__builtin_fmaf(sl2,64.f,nb); MKC0(C0); PIN(C0); SBAR(); \
    const lds_cptr vp_=vp0+2*sl_prev; \
    VRD(0); SBAR(); float sacc=(P0[0]+P0[1]); \
    GAPA(C0=__builtin_amdgcn_mfma_f32_32x32x16_bf16(kf[0],qr[0],C0,0,0,0), P0[2],P0[3],P0[4],P0[5],     pw0[0]=PKW(P0,0), pw0[1]=PKW(P0,2), pw0); \
    MKC1(C1); PIN(C1); VRD(4); SBAR(); GAPA(C1=__builtin_amdgcn_mfma_f32_32x32x16_bf16(kf[1],qr[0],C1,0,0,0), P0[6],P0[7],P0[8],P0[9],     pw0[2]=PKW(P0,4), pw0[3]=PKW(P0,6), pw0); \
    VRD(1); SBAR(); GAPA(C0=__builtin_amdgcn_mfma_f32_32x32x16_bf16(kf[2],qr[1],C0,0,0,0),   P0[10],P0[11],P0[12],P0[13], pw1[0]=PKW(P0,8), pw1[1]=PKW(P0,10), pw1); \
    VRD(5); SBAR(); GAPA(C1=__builtin_amdgcn_mfma_f32_32x32x16_bf16(kf[3],qr[1],C1,0,0,0),   P0[14],P0[15],P1[0],P1[1],   pw1[2]=PKW(P0,12),pw1[3]=PKW(P0,14), pw1); \
    VRD(2); SBAR(); GAPA(C0=__builtin_amdgcn_mfma_f32_32x32x16_bf16(kf[4],qr[2],C0,0,0,0),   P1[2],P1[3],P1[4],P1[5],     pw2[0]=PKW(P1,0), pw2[1]=PKW(P1,2), pw2); \
    VRD(6); SBAR(); GAPA(C1=__builtin_amdgcn_mfma_f32_32x32x16_bf16(kf[5],qr[2],C1,0,0,0),   P1[6],P1[7],P1[8],P1[9],     pw2[2]=PKW(P1,4), pw2[3]=PKW(P1,6), pw2); \
    VRD(3); SBAR(); GAPA(C0=__builtin_amdgcn_mfma_f32_32x32x16_bf16(kf[6],qr[3],C0,0,0,0),   P1[10],P1[11],P1[12],P1[13], pw3[0]=PKW(P1,8), pw3[1]=PKW(P1,10), pw3); \
    VRD(7); SBAR(); GAPA(C1=__builtin_amdgcn_mfma_f32_32x32x16_bf16(kf[7],qr[3],C1,0,0,0),   P1[14],P1[15],0.f,0.f,       pw3[2]=PKW(P1,12),pw3[3]=PKW(P1,14), pw3); \
    l_reg+=sacc; \
    if(GK){DMA_K((t)+3,sl_cur);} if(GV){DMA_V((t)+1,sl_next);} \
    CMASK(C0,C1,t); \
    { float a=MX3(C0[0],C0[1],C1[0]),b=MX3(C0[2],C0[3],C1[1]); a=MX3(a,C1[2],C1[3]); \
      _Pragma("unroll") for(int r=4;r<16;r+=4){a=MX3(a,C0[r],C0[r+1]);b=MX3(b,C0[r+2],C0[r+3]);a=MX3(a,C1[r],C1[r+1]);b=MX3(b,C1[r+2],C1[r+3]);} \
      float rm=__builtin_fmaxf(a,b); { auto rr=__builtin_amdgcn_permlane32_swap(__float_as_uint(rm),__float_as_uint(rm),false,false); rm=__builtin_fmaxf(__uint_as_float(rr[0]),__uint_as_float(rr[1])); } \
      resc=false; \
      if(__builtin_expect(__any(rm>(float)THRL),0)){ const float dl=__builtin_fmaxf(rm,0.f); nb-=dl; \
        _Pragma("unroll") for(int r=0;r<16;++r){C0[r]-=dl;C1[r]-=dl;} \
        const float f=__builtin_amdgcn_exp2f(-dl); l_reg*=f; { int l_=lane; asm volatile("":"+v"(l_)); if(l_<32)wsf[l_]=f; } resc=true; } } \
    SBAR(); \
    GAPB(o[0]=__builtin_amdgcn_mfma_f32_32x32x16_bf16(PAF(0),VFR(0),o[0],0,0,0); VRD2(0), C0,0); \
    GAPB(o[1]=__builtin_amdgcn_mfma_f32_32x32x16_bf16(PAF(0),VFR(4),o[1],0,0,0); VRD2(4), C0,2); \
    KRD(GL,0); GAPB(o[0]=__builtin_amdgcn_mfma_f32_32x32x16_bf16(PAF(1),VFR(1),o[0],0,0,0); VRD2(1), C0,4); \
    KRD(GL,1); GAPB(o[1]=__builtin_amdgcn_mfma_f32_32x32x16_bf16(PAF(1),VFR(5),o[1],0,0,0); VRD2(5), C0,6); \
    KRD(GL,2); GAPB(o[0]=__builtin_amdgcn_mfma_f32_32x32x16_bf16(PAF(2),VFR(2),o[0],0,0,0); VRD2(2), C0,8); \
    KRD(GL,3); GAPB(o[1]=__builtin_amdgcn_mfma_f32_32x32x16_bf16(PAF(2),VFR(6),o[1],0,0,0); VRD2(6), C0,10); \
    GAPB(o[0]=__builtin_amdgcn_mfma_f32_32x32x16_bf16(PAF(3),VFR(3),o[0],0,0,0); VRD2(3), C0,12); \
    GAPB(o[1]=__builtin_amdgcn_mfma_f32_32x32x16_bf16(PAF(3),VFR(7),o[1],0,0,0); VRD2(7), C0,14); \
    GAPB(o[2]=__builtin_amdgcn_mfma_f32_32x32x16_bf16(PAF(0),VFR(0),o[2],0,0,0), C1,0); \
    GAPB(o[3]=__builtin_amdgcn_mfma_f32_32x32x16_bf16(PAF(0),VFR(4),o[3],0,0,0), C1,2); \
    GAPB(o[2]=__builtin_amdgcn_mfma_f32_32x32x16_bf16(PAF(1),VFR(1),o[2],0,0,0), C1,4); \
    GAPB(o[3]=__builtin_amdgcn_mfma_f32_32x32x16_bf16(PAF(1),VFR(5),o[3],0,0,0), C1,6); \
    GAPB(o[2]=__builtin_amdgcn_mfma_f32_32x32x16_bf16(PAF(2),VFR(2),o[2],0,0,0), C1,8); \
    GAPB(o[3]=__builtin_amdgcn_mfma_f32_32x32x16_bf16(PAF(2),VFR(6),o[3],0,0,0), C1,10); \
    GAPB(o[2]=__builtin_amdgcn_mfma_f32_32x32x16_bf16(PAF(3),VFR(3),o[2],0,0,0), C1,12); \
    GAPB(o[3]=__builtin_amdgcn_mfma_f32_32x32x16_bf16(PAF(3),VFR(7),o[3],0,0,0), C1,14); \
    }while(0)
  int t=1;
  #undef CMASK
  #define CMASK(P0,P1,t) do{}while(0)
  for(;t+5<NT;t+=2){
    STEP(pB0,pB1,pA0,pA1,t,true,true,true);     WAIT_BAR(3); RESC(); ROT();
    STEP(pA0,pA1,pB0,pB1,t+1,true,true,true);   WAIT_BAR(3); RESC(); ROT();
  }
  #undef CMASK
  #define CMASK(P0,P1,t) do{int jb_=(t)-(NT-4); if(jb_>=0)cmask(P0,P1,jb_,qrel,hi);}while(0)
  #define ENDW(tt) do{ if((tt)+3<NT){WAIT_BAR(3);} else if((tt)+2<NT){WAIT_BAR(2);} else {WAIT_BAR(0);} }while(0)
  for(;t+1<NT;t+=2){
    STEP(pB0,pB1,pA0,pA1,t,(t+3<NT),(t+1<NT),(t+1<NT));       ENDW(t);   RESC(); ROT();
    STEP(pA0,pA1,pB0,pB1,t+1,(t+4<NT),(t+2<NT),(t+2<NT));     ENDW(t+1); RESC(); ROT();
  }
  STEP(pB0,pB1,pA0,pA1,NT-1,false,false,false); RESC();
  { float sacc=pB0[0]+pB0[1]; _Pragma("unroll") for(int r=2;r<16;++r)sacc+=pB0[r]; _Pragma("unroll") for(int r=0;r<16;++r)sacc+=pB1[r]; l_reg+=sacc;
    pw0=(u32x4){PKW(pB0,0),PKW(pB0,2),PKW(pB0,4),PKW(pB0,6)};pw1=(u32x4){PKW(pB0,8),PKW(pB0,10),PKW(pB0,12),PKW(pB0,14)};pw2=(u32x4){PKW(pB1,0),PKW(pB1,2),PKW(pB1,4),PKW(pB1,6)};pw3=(u32x4){PKW(pB1,8),PKW(pB1,10),PKW(pB1,12),PKW(pB1,14)};
    SBAR(); { int l_=lane; asm volatile("":"+v"(l_)); const int vb_=(int)(lds0+LDS_V)+((l_>>4)&1)*32+(l_&3)*8+(4*(l_>>5)+((l_&15)>>2))*64; pv(o,vb_+2*sl_cur,PAF(0),PAF(1),PAF(2),PAF(3)); } }
  #undef PKW
  #undef PAF
  #undef VFR
  #undef PIN
  #undef MX3
  #undef GAPA
  #undef GAPB
  #undef EX
  #undef VRD
  #undef VRD2
  #undef KRD
  #undef STEP
  #undef ENDW
  {auto rr=__builtin_amdgcn_permlane32_swap(__float_as_uint(l_reg),__float_as_uint(l_reg),false,false);l_reg=__uint_as_float(rr[0])+__uint_as_float(rr[1]);}
  if(hi==0)wsf[32+r32]=l_reg;asm volatile("s_waitcnt lgkmcnt(0)":::"memory");
  float rli[16];
  #pragma unroll
  for(int r=0;r<16;++r)rli[r]=__builtin_amdgcn_rcpf(wsf[32+crow(r,hi)]);
  bf16*Ow=O+(rowbase+q0+wid*QBLK)*DM+hv*(2*D);
  { bf16*stg=(bf16*)(shm+LDS_OST)+wid*4096;
    #pragma unroll
    for(int r=0;r<16;++r){const int orow=crow(r,hi);
      #pragma unroll
      for(int d0=0;d0<4;++d0)stg[orow*128+d0*32+r32]=__float2bfloat16(o[d0][r]*rli[r]);}
    asm volatile("s_waitcnt lgkmcnt(0)":::"memory");
    #pragma unroll
    for(int i=0;i<8;++i){const int row=i*4+(lane>>4),ch=lane&15; const u32x4 v=*(const u32x4*)(stg+row*128+ch*8); ATTN_STORE16(Ow+(long)row*DM+ch*8,v);} }
  asm volatile("s_waitcnt lgkmcnt(0)\n\ts_barrier":::"memory");
  #undef DMA_K
  #undef DMA_V
  #undef CMASK
  #undef START
  #undef RESC
  #undef ROT
  #undef MKC0
  #undef MKC1
}
constexpr int ATTN_LDS_BYTES=LDS_BYTES;
template<int THRL=8> __device__ __forceinline__ void attn_phase(char*lds,const bf16*Q,const bf16*K,const bf16*V,bf16*O1,bf16*O2,int vcu,int G,int wave_){
  for(int v=vcu;v<256;v+=G){
    const int j=v>>1,s=v&1,b=j>>3,h=(j&7)>>1,c=j&1;
    const float sl2=__builtin_amdgcn_exp2f(-2.0f*(float)(h+1))*1.4426950408889634f;
    for(int i=NQB/2-1;i>=0;--i){ const int qb=2*i+((i^s)&1); attn_unit<THRL>(b,h*2+c,h,sl2,qb,Q,K,V,c?O2:O1,lds,wave_); }
  }
}
#undef SBAR
#undef WAIT_BAR
}
constexpr int NWAVES = 8;
constexpr int BATCH = 16, SEQ = 4096, DM = 1024, M = BATCH * SEQ;
constexpr int EVEN_IN = 2560, ODD_IN = 6144, DFF = 3584, NEXP = 8;
constexpr float LN_EPS = 1e-5f;
constexpr float DN_ALPHA = 1.6817928305074290f;
constexpr int TSLOTS = 133120;
constexpr float W8_SCALE = 64.f;

constexpr size_t MiB = 1u << 20;
constexpr size_t WS_CTL = 0, CTL_ZERO_BYTES = 64 * 1024;
constexpr size_t WS_TOKE = 1 * MiB;
constexpr size_t WS_TOKG = WS_TOKE + (size_t)M * 2 * 4;
constexpr size_t WS_SLOT = WS_TOKG + (size_t)M * 2 * 4;
constexpr size_t WS_TOKS = WS_SLOT + (size_t)M * 2 * 4;
constexpr size_t WS_GATS = WS_TOKS + (size_t)TSLOTS * 4;
constexpr size_t WS_WCNT = WS_GATS + (size_t)TSLOTS * 4;
constexpr size_t WS_TILE = WS_WCNT + (size_t)2048 * 8 * 4;
constexpr size_t WS_WSB = 8 * MiB;
constexpr size_t WS_SA = 9 * MiB;
constexpr size_t WS_SAS = 9 * MiB + 512 * 1024;
constexpr size_t WS_SW = 10 * MiB;
constexpr int SW_EIN = 0, SW_E13 = 4096, SW_OIN = 12288, SW_M13 = 20480, SW_OWO = 77824, SW_EWO = 78848;
constexpr size_t A_PMAX = 768 * MiB;
constexpr int PM_WIN = 0, PM_A = 6144 * 16, PM_B = PM_A + 8 * 3584 * 16, PM_WO = PM_B + 8 * 3584 * 16, PMAX_FLOATS = PM_WO + 1024 * 32;
static_assert((size_t)2 * PMAX_FLOATS * 4 <= 8 * MiB, "PMAX");
constexpr size_t WS_WB = 16 * MiB;
constexpr size_t WB_E_IN = 0, WB_E_O = 5 * MiB, WB_E_13 = 7 * MiB, WB_E_2 = 21 * MiB;
constexpr size_t WB_O_IN = 0, WB_O_O = 12 * MiB, WB_O_13 = 16 * MiB, WB_O_2 = 72 * MiB, WB_XQ = 104 * MiB;
constexpr size_t WS_XB = 200 * MiB;
constexpr size_t WS_ACT = 328 * MiB;
constexpr size_t A_U = 0, A_V = 64 * MiB, A_Q = 128 * MiB, A_K = 192 * MiB, A_VA = 256 * MiB, A_O1 = 320 * MiB, A_O2 = 384 * MiB, A_MIX = 448 * MiB, A_MIX8 = 640 * MiB, A_H = 0;
constexpr size_t AO_Q = 0, AO_K = 128 * MiB, AO_V = 256 * MiB, AO_G = 512 * MiB;
constexpr size_t AM_H = 0, AM_OUT = 462 * MiB;
constexpr size_t WS_END = 1104 * MiB;
static_assert(WS_TILE + 2 * 320 * 4 <= WS_WSB, "ws map");
static_assert((size_t)TSLOTS * DFF <= 462 * MiB && AM_OUT + (size_t)TSLOTS * 1024 * 2 <= 776 * MiB && WB_XQ + (size_t)M * DM <= 184 * MiB, "ws map");
constexpr int CW_BAR = 4096;

constexpr int RING_OFF = 0, RING_BYTES = 143360;
constexpr int LDSCTL_OFF = RING_BYTES;
constexpr int LDS_BYTES = 147456;

#define GAS __attribute__((address_space(1)))
#define LAS __attribute__((address_space(3)))
typedef unsigned short bf16;
typedef unsigned v4u __attribute__((ext_vector_type(4)));
typedef unsigned v2u __attribute__((ext_vector_type(2)));
typedef float f32x4 __attribute__((ext_vector_type(4)));
typedef short bf16x8 __attribute__((ext_vector_type(8)));
typedef short s16x4 __attribute__((ext_vector_type(4)));
#define LDS_WAIT() asm volatile("s_waitcnt lgkmcnt(0)" ::: "memory")
#define VM_WAIT() asm volatile("s_waitcnt vmcnt(0)" ::: "memory")
typedef float f32x2_t __attribute__((ext_vector_type(2))); typedef __bf16 bf16x2_t __attribute__((ext_vector_type(2)));
__device__ __forceinline__ unsigned pk2(float lo, float hi) { f32x2_t v = {lo, hi}; bf16x2_t b = __builtin_convertvector(v, bf16x2_t); return __builtin_bit_cast(unsigned, b); }
__device__ __forceinline__ unsigned f2bf(float f) { return pk2(f, f) & 0xffffu; }
__device__ __forceinline__ float bflo(unsigned w) { return __uint_as_float(w << 16); }
__device__ __forceinline__ float bfhi(unsigned w) { return __uint_as_float(w & 0xffff0000u); }
__device__ __forceinline__ float bf2f(bf16 b) { return __uint_as_float(((unsigned)b) << 16); }
__device__ __forceinline__ int lane_id_opaque() { int l; asm volatile("v_mbcnt_lo_u32_b32 %0, -1, 0\n\tv_mbcnt_hi_u32_b32 %0, -1, %0" : "=v"(l)); return l; }
__device__ __forceinline__ float wave_sum(float v) {
#pragma unroll
    for (int o = 1; o < 64; o <<= 1) v += __shfl_xor(v, o);
    return v;
}

#define XB_TMO      128
#define XB_XCNT(j)  (256  + 64 * (j))
#define XB_XSUB(j)  (1280 + 64 * (j))
#define XB_XGEN(j)  (2304 + 64 * (j))
#define XB_TOP      3328
#define XB_TOPGEN   3392
#define XCD_BAR_WORDS 3456
#define XB_SPIN_CAP (1u << 18)

__device__ __forceinline__ unsigned xb_ld(unsigned* p)              { return __hip_atomic_load(p, __ATOMIC_RELAXED, __HIP_MEMORY_SCOPE_AGENT); }
__device__ __forceinline__ unsigned xb_add(unsigned* p, unsigned v) { return __hip_atomic_fetch_add(p, v, __ATOMIC_RELAXED, __HIP_MEMORY_SCOPE_AGENT); }
__device__ __forceinline__ unsigned xb_xcc_id() { return (unsigned)__builtin_amdgcn_s_getreg((3 << 11) | 20) & 0xFu; }
#define XB_SPIN(cond, bar) do { unsigned _sp = 0; while (cond) { __builtin_amdgcn_s_sleep(1); \
    if ((++_sp & 255u) == 0u) { if (xb_ld(&(bar)[XB_TMO])) break; if (_sp > XB_SPIN_CAP) { atomicAdd(&(bar)[XB_TMO], 1u); break; } } } } while (0)

struct XcdBarrier {
    unsigned* bar; unsigned x;
    volatile LAS unsigned* st;
};

__device__ __forceinline__ XcdBarrier xcd_barrier_post(unsigned* bar, volatile LAS unsigned* st) {
    XcdBarrier b; b.bar = bar; b.x = xb_xcc_id(); b.st = st;
    if (threadIdx.x == 0) (void)xb_add(&bar[XB_XCNT(b.x)], 1u);
    return b;
}
__device__ __forceinline__ void xcd_barrier_complete(unsigned* bar, unsigned x, unsigned& nloc, unsigned& nx) {
    const unsigned G = gridDim.x * gridDim.y * gridDim.z;
    unsigned sum, cnt, mine, sp = 0u;
    for (;;) {
        sum = 0u; cnt = 0u; mine = 0u;
#pragma unroll
        for (unsigned j = 0; j < 16; ++j) { const unsigned c = xb_ld(&bar[XB_XCNT(j)]); sum += c; cnt += (c > 0u) ? 1u : 0u; mine = (j == x) ? c : mine; }
        if (sum == G) break;
        __builtin_amdgcn_s_sleep(1);
        if ((++sp & 255u) == 0u) { if (xb_ld(&bar[XB_TMO])) break; if (sp > XB_SPIN_CAP) { atomicAdd(&bar[XB_TMO], 1u); break; } }
    }
    nloc = mine > 0u ? mine : 1u; nx = cnt > 0u ? cnt : 1u;
}

__device__ __forceinline__ void xcd_barrier(const XcdBarrier& b) {
    asm volatile("s_waitcnt vmcnt(0)" ::: "memory");
    __syncthreads();
    if (threadIdx.x == 0) {
        unsigned* bar = b.bar;
        __builtin_amdgcn_s_waitcnt(0);
        unsigned nloc = b.st[0], nx = b.st[1];
        if (nloc == 0u) { xcd_barrier_complete(bar, b.x, nloc, nx); b.st[0] = nloc; b.st[1] = nx; }
        const unsigned old = xb_add(&bar[XB_XSUB(b.x)], 1u);
        const unsigned gen = old / nloc;
        if (old + 1u == (gen + 1u) * nloc) {
            __builtin_amdgcn_fence(__ATOMIC_RELEASE, "agent");
            asm volatile("s_waitcnt vmcnt(0)" ::: "memory");
            const unsigned og = xb_add(&bar[XB_TOP], 1u);
            const unsigned tg = og / nx;
            if (og + 1u == (tg + 1u) * nx) xb_add(&bar[XB_TOPGEN], 1u);
            else XB_SPIN(xb_ld(&bar[XB_TOPGEN]) == tg, bar);
            __builtin_amdgcn_fence(__ATOMIC_ACQUIRE, "agent");
            xb_add(&bar[XB_XGEN(b.x)], 1u);
            asm volatile("s_waitcnt vmcnt(0)" ::: "memory");
        } else {
            XB_SPIN(xb_ld(&bar[XB_XGEN(b.x)]) == gen, bar);
            __builtin_amdgcn_fence(__ATOMIC_ACQUIRE, "agent");
            asm volatile("s_waitcnt vmcnt(0)" ::: "memory");
        }
    }
    __syncthreads();
}

struct Frame {
    LAS unsigned char* lds;
    int wave;
    int vcu, G;
};

__device__ __forceinline__ void conv_item(const float* W, int K, int N, bf16* WT, int rstride, int roff, LAS float* scr, int item, int lane) {
    const int nblk = N / 32, kb = item / nblk, nb = item % nblk, k0 = 64 * kb, n0 = 32 * nb;
    { float wv[32]; const float* wp = W + (size_t)(k0 + (lane >> 5)) * N + n0 + (lane & 31);
#pragma unroll
      for (int i = 0; i < 32; ++i) wv[i] = wp[(size_t)(2 * i) * N];
#pragma unroll
      for (int i = 0; i < 32; ++i) scr[(2 * i + (lane >> 5)) * 33 + (lane & 31)] = wv[i]; }
    LDS_WAIT(); asm volatile("" ::: "memory");
    const int c = lane & 7;
#pragma unroll
    for (int j = 0; j < 4; ++j) { const int n = (lane >> 3) + 8 * j; const LAS float* s = scr + (8 * c) * 33 + n;
        v4u o; o.x = pk2(s[0 * 33], s[1 * 33]); o.y = pk2(s[2 * 33], s[3 * 33]); o.z = pk2(s[4 * 33], s[5 * 33]); o.w = pk2(s[6 * 33], s[7 * 33]);
        const int ng = n0 + n, drow = (ng >> 7) * rstride + roff + (ng & 127);
        *(GAS v4u*)(WT + (size_t)drow * K + k0 + 8 * c) = o; }
    LDS_WAIT(); asm volatile("" ::: "memory");
}
__device__ __forceinline__ void conv_item8(const float* W, int K, int N, unsigned char* WT, int rstride, int roff, float scale, LAS float* scr, int item, int lane) {
    const int nblk = N / 32, kb = item / nblk, nb = item % nblk, k0 = 64 * kb, n0 = 32 * nb;
    { float wv[32]; const float* wp = W + (size_t)(k0 + (lane >> 5)) * N + n0 + (lane & 31);
#pragma unroll
      for (int i = 0; i < 32; ++i) wv[i] = wp[(size_t)(2 * i) * N];
#pragma unroll
      for (int i = 0; i < 32; ++i) scr[(2 * i + (lane >> 5)) * 33 + (lane & 31)] = wv[i]; }
    LDS_WAIT(); asm volatile("" ::: "memory");
    const int c = lane & 7;
#pragma unroll
    for (int j = 0; j < 4; ++j) { const int n = (lane >> 3) + 8 * j; const LAS float* s = scr + (8 * c) * 33 + n;
        int w0 = 0, w1 = 0;
        w0 = __builtin_amdgcn_cvt_pk_fp8_f32(s[0 * 33] * scale, s[1 * 33] * scale, w0, false); w0 = __builtin_amdgcn_cvt_pk_fp8_f32(s[2 * 33] * scale, s[3 * 33] * scale, w0, true);
        w1 = __builtin_amdgcn_cvt_pk_fp8_f32(s[4 * 33] * scale, s[5 * 33] * scale, w1, false); w1 = __builtin_amdgcn_cvt_pk_fp8_f32(s[6 * 33] * scale, s[7 * 33] * scale, w1, true);
        const int ng = n0 + n, drow = (ng >> 7) * rstride + roff + (ng & 127);
        v2u o; o.x = (unsigned)w0; o.y = (unsigned)w1; *(GAS v2u*)(WT + (size_t)drow * K + k0 + 8 * c) = o; }
    LDS_WAIT(); asm volatile("" ::: "memory");
}
__device__ __forceinline__ int rni8(float x) { return (int)__builtin_rintf(x); }
__device__ __forceinline__ void conv_item_max(const float* W, int K, int N, float* PMAX, int item, int lane) {
    const int nblk = N / 32, kb = item / nblk, nb = item % nblk, k0 = 64 * kb, n0 = 32 * nb;
    const float* wp = W + (size_t)(k0 + (lane >> 5)) * N + n0 + (lane & 31); float wv[32];
#pragma unroll
    for (int i = 0; i < 32; ++i) wv[i] = wp[(size_t)(2 * i) * N];
    float cmax = 0.f;
#pragma unroll
    for (int i = 0; i < 32; ++i) cmax = fmaxf(cmax, fabsf(wv[i]));
    cmax = fmaxf(cmax, __shfl_xor(cmax, 32));
    if (lane < 32) PMAX[(size_t)kb * N + n0 + lane] = cmax;
}
template <int NB = 16> __device__ __forceinline__ void conv_item_q(const float* W, int K, int N, signed char* WT, float* SW, const float* PMAX, int rstride, int roff, LAS float* scr, int item, int lane) {
    const int nblk = N / 32, kb = item / nblk, nb = item % nblk, k0 = 64 * kb, n0 = 32 * nb;
    float wv[32], pm[NB]; const float* wp = W + (size_t)(k0 + (lane >> 5)) * N + n0 + (lane & 31);
#pragma unroll
    for (int i = 0; i < 32; ++i) wv[i] = wp[(size_t)(2 * i) * N];
#pragma unroll
    for (int b = 0; b < NB; ++b) pm[b] = PMAX[(size_t)b * N + n0 + (lane & 31)];
    float cmax = 0.f;
#pragma unroll
    for (int b = 0; b < NB; ++b) cmax = fmaxf(cmax, pm[b]);
    const float inv = cmax > 0.f ? 127.f / cmax : 0.f;
    if (kb == 0 && lane < 32) { const int ng = n0 + lane, drow = (ng >> 7) * rstride + roff + (ng & 127); SW[drow] = cmax > 0.f ? cmax * (1.f / 127.f) : 1.f; }
    {
#pragma unroll
      for (int i = 0; i < 32; ++i) scr[(2 * i + (lane >> 5)) * 33 + (lane & 31)] = wv[i] * inv; }
    LDS_WAIT(); asm volatile("" ::: "memory");
    const int c = lane & 7;
#pragma unroll
    for (int j = 0; j < 4; ++j) { const int n = (lane >> 3) + 8 * j; const LAS float* s = scr + (8 * c) * 33 + n;
        const unsigned w0 = (unsigned)(rni8(s[0 * 33]) & 255) | ((unsigned)(rni8(s[1 * 33]) & 255) << 8) | ((unsigned)(rni8(s[2 * 33]) & 255) << 16) | ((unsigned)rni8(s[3 * 33]) << 24);
        const unsigned w1 = (unsigned)(rni8(s[4 * 33]) & 255) | ((unsigned)(rni8(s[5 * 33]) & 255) << 8) | ((unsigned)(rni8(s[6 * 33]) & 255) << 16) | ((unsigned)rni8(s[7 * 33]) << 24);
        const int ng = n0 + n, drow = (ng >> 7) * rstride + roff + (ng & 127);
        v2u o; o.x = w0; o.y = w1; *(GAS v2u*)(WT + (size_t)drow * K + k0 + 8 * c) = o; }
    LDS_WAIT(); asm volatile("" ::: "memory");
}
struct ConvJob { const float* W; bf16* WT; int K, N, rstride, roff, nitems; float f8scale; float* SW; float* PMAX; int kind; };
template <int NJ> __device__ __forceinline__ void conv_jobs(Frame& F, const ConvJob (&J)[NJ]) {
    const int tid_ = F.wave * 64 + lane_id_opaque(); const int lane = tid_ & 63;
    LAS float* scr = (LAS float*)(F.lds + RING_OFF + F.wave * 16384);
    const int gw = F.vcu * NWAVES + F.wave, NGW = F.G * NWAVES;
    int total = 0;
#pragma unroll
    for (int j = 0; j < NJ; ++j) total += J[j].nitems;
    for (int it = gw; it < total; it += NGW) {
        int r = it;
#pragma unroll
        for (int j = 0; j < NJ; ++j) { if (r >= 0 && r < J[j].nitems) { if (J[j].kind == 1) conv_item8(J[j].W, J[j].K, J[j].N, (unsigned char*)J[j].WT, J[j].rstride, J[j].roff, J[j].f8scale, scr, r, lane); else conv_item(J[j].W, J[j].K, J[j].N, J[j].WT, J[j].rstride, J[j].roff, scr, r, lane); } r -= J[j].nitems; }
    }
}
__device__ __forceinline__ void conv_wo_max(Frame& F, const float* W, float* PMAX) {
    const int lane = lane_id_opaque(); const int gw = F.vcu * NWAVES + F.wave, NGW = F.G * NWAVES;
    for (int it = gw; it < (2 * DM / 64) * (DM / 32); it += NGW) conv_item_max(W, 2 * DM, DM, PMAX, it, lane);
}
__device__ __forceinline__ void conv_wo_q(Frame& F, const float* W, signed char* WT, float* SW, const float* PMAX) {
    const int lane = lane_id_opaque(); const int gw = F.vcu * NWAVES + F.wave, NGW = F.G * NWAVES;
    LAS float* scr = (LAS float*)(F.lds + RING_OFF + F.wave * 16384);
    for (int it = gw; it < (2 * DM / 64) * (DM / 32); it += NGW) conv_item_q<32>(W, 2 * DM, DM, WT, SW, PMAX, 128, 0, scr, it, lane);
}

struct QSet { const float* Win; int Nin; signed char* WinT; float* SWin; const float* W1; const float* W3; int nexp; signed char* W13T; float* SW13; const float* Wo = nullptr; signed char* WoT = nullptr; float* SWo = nullptr; };
__device__ __forceinline__ void conv_q1024(Frame& F, const QSet S) {
    const int tid_ = F.wave * 64 + lane_id_opaque(); const int tid = tid_;
    LAS float* D = (LAS float*)(F.lds + RING_OFF); LAS float* RED = D + 1024 * 32;
    const int nin = S.Nin / 32, nwo = S.Wo != nullptr ? DM / 32 : 0, nff = DFF / 32, total = nin + nwo + S.nexp * 2 * nff;
    f32x4 pre[16];
#define QITEM(it_) const float* W_; int N_, n0_, rs_, ro_; signed char* WT_; float* SW_; \
    if ((it_) < nin) { W_ = S.Win; N_ = S.Nin; n0_ = 32 * (it_); WT_ = S.WinT; SW_ = S.SWin; rs_ = 128; ro_ = 0; } \
    else if ((it_) < nin + nwo) { W_ = S.Wo; N_ = DM; n0_ = 32 * ((it_) - nin); WT_ = S.WoT; SW_ = S.SWo; rs_ = 128; ro_ = 0; } \
    else { const int r_ = (it_) - nin - nwo, e_ = r_ / (2 * nff), q_ = r_ - e_ * 2 * nff, wh_ = q_ >= nff ? 1 : 0; W_ = (wh_ ? S.W3 : S.W1) + (size_t)e_ * DM * DFF; N_ = DFF; n0_ = 32 * (q_ - wh_ * nff); \
           WT_ = S.W13T + (size_t)e_ * 2 * DFF * DM; SW_ = S.SW13 + e_ * 2 * DFF; rs_ = 256; ro_ = 128 * wh_; } \
    (void)W_; (void)N_; (void)n0_; (void)rs_; (void)ro_; (void)WT_; (void)SW_
#define QLOAD(it_) do { QITEM(it_); const float* p_ = W_ + (size_t)(tid >> 3) * N_ + n0_ + (tid & 7) * 4; \
        _Pragma("unroll") for (int j = 0; j < 16; ++j) pre[j] = *(const f32x4*)(p_ + (size_t)(64 * j) * N_); } while (0)
    int it = F.vcu;
    __syncthreads();
    if (it < total) QLOAD(it);
    for (; it < total; it += F.G) {
#pragma unroll
        for (int j = 0; j < 16; ++j) *(LAS f32x4*)(D + (64 * j + (tid >> 3)) * 32 + (tid & 7) * 4) = pre[j];
        __syncthreads();
        if (it + F.G < total) QLOAD(it + F.G);
        const int c = tid & 31, g = tid >> 5;
        float v[64]; float pm = 0.f;
#pragma unroll
        for (int i = 0; i < 64; ++i) { v[i] = D[(64 * g + i) * 32 + c]; pm = fmaxf(pm, fabsf(v[i])); }
        RED[g * 32 + c] = pm;
        __syncthreads();
        float cmax = 0.f;
#pragma unroll
        for (int q = 0; q < 16; ++q) cmax = fmaxf(cmax, RED[q * 32 + c]);
        const float inv = cmax > 0.f ? 127.f / cmax : 0.f;
        QITEM(it);
        const int ng = n0_ + c, drow = (ng >> 7) * rs_ + ro_ + (ng & 127);
        if (g == 0) SW_[drow] = cmax > 0.f ? cmax * (1.f / 127.f) : 1.f;
        v4u* op = (v4u*)(WT_ + (size_t)drow * 1024 + 64 * g);
#pragma unroll
        for (int s4 = 0; s4 < 4; ++s4) { unsigned d[4];
#pragma unroll
            for (int j = 0; j < 4; ++j) { const int b = 16 * s4 + 4 * j;
                d[j] = (unsigned)(rni8(v[b] * inv) & 255) | ((unsigned)(rni8(v[b + 1] * inv) & 255) << 8) | ((unsigned)(rni8(v[b + 2] * inv) & 255) << 16) | ((unsigned)rni8(v[b + 3] * inv) << 24); }
            v4u w; w.x = d[0]; w.y = d[1]; w.z = d[2]; w.w = d[3]; op[s4] = w; }
    }
    __syncthreads();
#undef QLOAD
#undef QITEM
}

template <int SRC, bool ROUTE, bool FINAL>
__device__ __forceinline__ void ln_phase(Frame& F, const float* Y, bf16* XB, float* OUT, const float* gam, const float* bet,
                                         const bf16* OUTB, const int* slot_of_tok,
                                         const float* rw, const float* rb, int* tok_e, float* tok_g, int* wvcnt, signed char* XQ = nullptr, float* SA = nullptr) {
    const int tid_ = F.wave * 64 + lane_id_opaque(); const int lane = tid_ & 63, gw = blockIdx.x * NWAVES + F.wave, NGW = F.G * NWAVES;
    f32x4 g4[4], b4[4];
#pragma unroll
    for (int j = 0; j < 4; ++j) { g4[j] = *(const f32x4*)(gam + 4 * lane + 256 * j); b4[j] = *(const f32x4*)(bet + 4 * lane + 256 * j); }
    float rwv[ROUTE ? 16 : 1][8]; int cnt[8];
    if constexpr (ROUTE) {
#pragma unroll
        for (int j = 0; j < 4; ++j)
#pragma unroll
            for (int c = 0; c < 4; ++c) { const f32x4 a = *(const f32x4*)(rw + (size_t)(4 * lane + 256 * j + c) * 8), b = *(const f32x4*)(rw + (size_t)(4 * lane + 256 * j + c) * 8 + 4);
                rwv[j * 4 + c][0] = a[0]; rwv[j * 4 + c][1] = a[1]; rwv[j * 4 + c][2] = a[2]; rwv[j * 4 + c][3] = a[3]; rwv[j * 4 + c][4] = b[0]; rwv[j * 4 + c][5] = b[1]; rwv[j * 4 + c][6] = b[2]; rwv[j * 4 + c][7] = b[3]; }
#pragma unroll
        for (int e = 0; e < 8; ++e) cnt[e] = 0;
    }
    const int rows_per = M / NGW;
    for (int i = 0; i < rows_per; ++i) {
        const int row = ROUTE ? gw * rows_per + i : gw + i * NGW;
        f32x4 v[4];
        if constexpr (SRC == 0 || SRC == 3) {
            const f32x4* yr = (const f32x4*)(Y + (size_t)row * DM) + lane;
#pragma unroll
            for (int j = 0; j < 4; ++j) v[j] = yr[64 * j];
        } else if constexpr (SRC == 2) {
            const v2u* xr = (const v2u*)(XB + (size_t)row * DM) + lane;
#pragma unroll
            for (int j = 0; j < 4; ++j) { const v2u a = xr[64 * j]; v[j][0] = bflo(a.x); v[j][1] = bfhi(a.x); v[j][2] = bflo(a.y); v[j][3] = bfhi(a.y); }
        } else {
            const int s0 = slot_of_tok[2 * row], s1 = slot_of_tok[2 * row + 1];
            const v2u* xr = (const v2u*)(XB + (size_t)row * DM) + lane; const v2u* o0 = (const v2u*)(OUTB + (size_t)s0 * DM) + lane; const v2u* o1 = (const v2u*)(OUTB + (size_t)s1 * DM) + lane;
#pragma unroll
            for (int j = 0; j < 4; ++j) { const v2u a = xr[64 * j], p = o0[64 * j], q = o1[64 * j];
                v[j][0] = DN_ALPHA * bflo(a.x) + (bflo(p.x) + bflo(q.x)); v[j][1] = DN_ALPHA * bfhi(a.x) + (bfhi(p.x) + bfhi(q.x));
                v[j][2] = DN_ALPHA * bflo(a.y) + (bflo(p.y) + bflo(q.y)); v[j][3] = DN_ALPHA * bfhi(a.y) + (bfhi(p.y) + bfhi(q.y)); }
        }
        float s = 0.f;
#pragma unroll
        for (int j = 0; j < 4; ++j) s += (v[j][0] + v[j][1]) + (v[j][2] + v[j][3]);
        if constexpr (SRC != 3) {
        const float mean = wave_sum(s) * (1.f / DM); float s2 = 0.f;
#pragma unroll
        for (int j = 0; j < 4; ++j) { v[j] = v[j] - mean; s2 += (v[j][0] * v[j][0] + v[j][1] * v[j][1]) + (v[j][2] * v[j][2] + v[j][3] * v[j][3]); }
        const float rstd = 1.f / sqrtf(wave_sum(s2) * (1.f / DM) + LN_EPS);
#pragma unroll
        for (int j = 0; j < 4; ++j) v[j] = v[j] * rstd * g4[j] + b4[j];
        }
        if constexpr (!FINAL) {
            float am = 0.f;
#pragma unroll
            for (int j = 0; j < 4; ++j) am = fmaxf(fmaxf(am, fmaxf(fabsf(v[j][0]), fabsf(v[j][1]))), fmaxf(fabsf(v[j][2]), fabsf(v[j][3])));
#pragma unroll
            for (int o = 1; o < 64; o <<= 1) am = fmaxf(am, __shfl_xor(am, o));
            const float inv = am > 0.f ? 127.f / am : 0.f;
            unsigned* oq = (unsigned*)(XQ + (size_t)row * DM) + lane;
#pragma unroll
            for (int j = 0; j < 4; ++j) oq[64 * j] = (unsigned)(rni8(v[j][0] * inv) & 255) | ((unsigned)(rni8(v[j][1] * inv) & 255) << 8) | ((unsigned)(rni8(v[j][2] * inv) & 255) << 16) | ((unsigned)rni8(v[j][3] * inv) << 24);
            if (lane == 0) SA[row] = am > 0.f ? am * (1.f / 127.f) : 1.f;
        }
        if constexpr (FINAL) {
            f32x4* o = (f32x4*)(OUT + (size_t)row * DM) + lane;
#pragma unroll
            for (int j = 0; j < 4; ++j) o[64 * j] = v[j];
        } else if constexpr (SRC != 3) {
            v2u* o = (v2u*)(XB + (size_t)row * DM) + lane;
#pragma unroll
            for (int j = 0; j < 4; ++j) { v2u w; w.x = pk2(v[j][0], v[j][1]); w.y = pk2(v[j][2], v[j][3]); o[64 * j] = w; }
        }
        if constexpr (ROUTE) {
            float lg[8];
#pragma unroll
            for (int e = 0; e < 8; ++e) { float a = 0.f;
#pragma unroll
                for (int j = 0; j < 4; ++j)
#pragma unroll
                    for (int c = 0; c < 4; ++c) a += v[j][c] * rwv[j * 4 + c][e];
                lg[e] = wave_sum(a) + rb[e]; }
            int e0 = 0; float v0 = lg[0];
#pragma unroll
            for (int e = 1; e < 8; ++e) if (lg[e] > v0) { v0 = lg[e]; e0 = e; }
            int e1 = -1; float v1 = -INFINITY;
#pragma unroll
            for (int e = 0; e < 8; ++e) if (e != e0 && lg[e] > v1) { v1 = lg[e]; e1 = e; }
            const float p1 = 1.f / (1.f + __expf(v0 - v1)), p0 = 1.f - p1;
#pragma unroll
            for (int e = 0; e < 8; ++e) cnt[e] += (e == e0 || e == e1) ? 1 : 0;
            if (lane == 0) { tok_e[2 * row] = e0; tok_e[2 * row + 1] = e1; tok_g[2 * row] = p0; tok_g[2 * row + 1] = p1; }
        }
    }
    if constexpr (ROUTE) { if (lane < 8) { int c = 0;
#pragma unroll
            for (int e = 0; e < 8; ++e) c = (lane == e) ? cnt[e] : c;
            wvcnt[gw * 8 + lane] = c; } }
}

template <bool ROUTE>
__device__ __forceinline__ void panel_ln(Frame& F, bf16* XB, const float* gam, const float* bet,
                                         const float* rw, const float* rb, int* tok_e, float* tok_g, int* wvcnt) {
    const int tid_ = F.wave * 64 + lane_id_opaque(); const int lane = tid_ & 63, wave = F.wave;
    asm volatile("s_waitcnt vmcnt(0)" ::: "memory");
    __syncthreads();
    f32x4 g4[4], b4[4];
#pragma unroll
    for (int j = 0; j < 4; ++j) { g4[j] = *(const f32x4*)(gam + 4 * lane + 256 * j); b4[j] = *(const f32x4*)(bet + 4 * lane + 256 * j); }
    float rwv[ROUTE ? 16 : 1][8]; int cnt[8];
    if constexpr (ROUTE) {
#pragma unroll
        for (int j = 0; j < 4; ++j)
#pragma unroll
            for (int c = 0; c < 4; ++c) { const f32x4 a = *(const f32x4*)(rw + (size_t)(4 * lane + 256 * j + c) * 8), b = *(const f32x4*)(rw + (size_t)(4 * lane + 256 * j + c) * 8 + 4);
                rwv[j * 4 + c][0] = a[0]; rwv[j * 4 + c][1] = a[1]; rwv[j * 4 + c][2] = a[2]; rwv[j * 4 + c][3] = a[3]; rwv[j * 4 + c][4] = b[0]; rwv[j * 4 + c][5] = b[1]; rwv[j * 4 + c][6] = b[2]; rwv[j * 4 + c][7] = b[3]; }
#pragma unroll
        for (int e = 0; e < 8; ++e) cnt[e] = 0;
    }
    const int gw = blockIdx.x * NWAVES + wave;
    for (int i = 0; i < 32; ++i) {
        const int row = blockIdx.x * 256 + wave * 32 + i;
        v2u* xr = (v2u*)(XB + (size_t)row * DM) + lane; f32x4 v[4]; float s = 0.f;
#pragma unroll
        for (int j = 0; j < 4; ++j) { const v2u a = xr[64 * j]; v[j][0] = bflo(a.x); v[j][1] = bfhi(a.x); v[j][2] = bflo(a.y); v[j][3] = bfhi(a.y); s += (v[j][0] + v[j][1]) + (v[j][2] + v[j][3]); }
        const float mean = wave_sum(s) * (1.f / DM); float s2 = 0.f;
#pragma unroll
        for (int j = 0; j < 4; ++j) { v[j] = v[j] - mean; s2 += (v[j][0] * v[j][0] + v[j][1] * v[j][1]) + (v[j][2] * v[j][2] + v[j][3] * v[j][3]); }
        const float rstd = 1.f / sqrtf(wave_sum(s2) * (1.f / DM) + LN_EPS);
#pragma unroll
        for (int j = 0; j < 4; ++j) v[j] = v[j] * rstd * g4[j] + b4[j];
#pragma unroll
        for (int j = 0; j < 4; ++j) { v2u w; w.x = pk2(v[j][0], v[j][1]); w.y = pk2(v[j][2], v[j][3]); xr[64 * j] = w; }
        if constexpr (ROUTE) {
            float lg[8];
#pragma unroll
            for (int e = 0; e < 8; ++e) { float a = 0.f;
#pragma unroll
                for (int j = 0; j < 4; ++j)
#pragma unroll
                    for (int c = 0; c < 4; ++c) a += v[j][c] * rwv[j * 4 + c][e];
                lg[e] = wave_sum(a) + rb[e]; }
            int e0 = 0; float v0 = lg[0];
#pragma unroll
            for (int e = 1; e < 8; ++e) if (lg[e] > v0) { v0 = lg[e]; e0 = e; }
            int e1 = -1; float v1 = -INFINITY;
#pragma unroll
            for (int e = 0; e < 8; ++e) if (e != e0 && lg[e] > v1) { v1 = lg[e]; e1 = e; }
            const float p1 = 1.f / (1.f + __expf(v0 - v1)), p0 = 1.f - p1;
#pragma unroll
            for (int e = 0; e < 8; ++e) cnt[e] += (e == e0 || e == e1) ? 1 : 0;
            if (lane == 0) { tok_e[2 * row] = e0; tok_e[2 * row + 1] = e1; tok_g[2 * row] = p0; tok_g[2 * row + 1] = p1; }
        }
    }
    if constexpr (ROUTE) { if (lane < 8) { int c = 0;
#pragma unroll
            for (int e = 0; e < 8; ++e) c = (lane == e) ? cnt[e] : c;
            wvcnt[gw * 8 + lane] = c; } }
    __syncthreads();
}

__device__ __forceinline__ void assign_phase(Frame& F, const int* wvcnt, const int* tok_e, const float* tok_g, int* slot_of_tok, int* tok_of_slot, float* gate_of_slot, int* tiles, const float* SA, float* SAS) {
    LAS int* sh = (LAS int*)(F.lds + RING_OFF);
    const int tid_ = F.wave * 64 + lane_id_opaque(); const int tid = tid_, lane = tid & 63, wave = F.wave;
    const int gw0 = blockIdx.x * NWAVES;
    int tot[8], pre[8];
#pragma unroll
    for (int e = 0; e < 8; ++e) { tot[e] = 0; pre[e] = 0; }
#pragma unroll
    for (int k = 0; k < 4; ++k) { const int w = 4 * tid + k; const v4u* pp = (const v4u*)(wvcnt + (size_t)w * 8); const v4u a0 = pp[0], a1 = pp[1];
        const int cc[8] = {(int)a0.x, (int)a0.y, (int)a0.z, (int)a0.w, (int)a1.x, (int)a1.y, (int)a1.z, (int)a1.w};
#pragma unroll
        for (int e = 0; e < 8; ++e) { tot[e] += cc[e]; pre[e] += (w < gw0) ? cc[e] : 0; } }
#pragma unroll
    for (int e = 0; e < 8; ++e) {
#pragma unroll
        for (int o = 1; o < 64; o <<= 1) { tot[e] += __shfl_xor(tot[e], o); pre[e] += __shfl_xor(pre[e], o); } }
    if (lane == 0) {
#pragma unroll
        for (int e = 0; e < 8; ++e) { sh[wave * 16 + e] = tot[e]; sh[wave * 16 + 8 + e] = pre[e]; } }
    __syncthreads();
    int T[8], P[8], EB[8];
#pragma unroll
    for (int e = 0; e < 8; ++e) { int a = 0, b = 0;
#pragma unroll
        for (int w = 0; w < 8; ++w) { a += sh[w * 16 + e]; b += sh[w * 16 + 8 + e]; }
        T[e] = a; P[e] = b; }
    { int acc = 0;
#pragma unroll
      for (int e = 0; e < 8; ++e) { EB[e] = acc; acc += (T[e] + 255) & ~255; }
      if (blockIdx.x == 0) {
          const int ntile = acc >> 8;
          if (tid == 0) tiles[0] = ntile;
          for (int t = tid; t < ntile; t += NWAVES * 64) { int ex = 0;
#pragma unroll
              for (int e = 1; e < 8; ++e) if (t * 256 >= EB[e]) ex = e;
              tiles[16 + t] = ex; }
#pragma unroll
          for (int e = 0; e < 8; ++e) { const int lo = EB[e] + T[e], hi = EB[e] + ((T[e] + 255) & ~255);
              for (int s = lo + tid; s < hi; s += NWAVES * 64) { tok_of_slot[s] = 0; gate_of_slot[s] = 0.f; SAS[s] = 1.f; } } } }
    int WP[8];
#pragma unroll
    for (int e = 0; e < 8; ++e) WP[e] = 0;
    for (int w = 0; w < wave; ++w) { const v4u* pp = (const v4u*)(wvcnt + (size_t)(gw0 + w) * 8); const v4u a0 = pp[0], a1 = pp[1];
        WP[0] += (int)a0.x; WP[1] += (int)a0.y; WP[2] += (int)a0.z; WP[3] += (int)a0.w; WP[4] += (int)a1.x; WP[5] += (int)a1.y; WP[6] += (int)a1.z; WP[7] += (int)a1.w; }
    const int t = (gw0 + wave) * 32 + (lane & 31);
    const int e0 = tok_e[2 * t], e1 = tok_e[2 * t + 1]; const float g0 = tok_g[2 * t], g1 = tok_g[2 * t + 1];
    const bool act = lane < 32;
    int s0 = 0, s1 = 0;
#pragma unroll
    for (int e = 0; e < 8; ++e) { const unsigned long long mk = __ballot(act && (e0 == e || e1 == e)); const int rank = __popcll(mk & ((1ull << lane) - 1ull));
        const int sl = EB[e] + P[e] + WP[e] + rank; if (e0 == e) s0 = sl; if (e1 == e) s1 = sl; }
    if (act) { slot_of_tok[2 * t] = s0; slot_of_tok[2 * t + 1] = s1; tok_of_slot[s0] = t; tok_of_slot[s1] = t; gate_of_slot[s0] = g0; gate_of_slot[s1] = g1; const float sat = SA[t]; SAS[s0] = sat; SAS[s1] = sat; }
    __syncthreads();
}

__device__ __forceinline__ f32x4 mfma16(bf16x8 a, bf16x8 b, f32x4 c) { return __builtin_amdgcn_mfma_f32_16x16x32_bf16(a, b, c, 0, 0, 0); }
__device__ __forceinline__ bf16x8 lds_tr8(const LAS bf16* p, int rowstep4  ) {
    const s16x4 lo = __builtin_bit_cast(s16x4, __builtin_amdgcn_ds_read_tr16_b64_v4i16((LAS s16x4*)p));
    const s16x4 hi = __builtin_bit_cast(s16x4, __builtin_amdgcn_ds_read_tr16_b64_v4i16((LAS s16x4*)(p + rowstep4)));
    return (bf16x8){lo[0], lo[1], lo[2], lo[3], hi[0], hi[1], hi[2], hi[3]};
}

constexpr int SG_P = 136;
__device__ __forceinline__ void sgu_phase(Frame& F, const bf16* Wsb, const float* b_s, const float* ln_g, const float* ln_b, const bf16* U, const bf16* V, bf16* MIX) {
    LAS bf16* WS = (LAS bf16*)(F.lds + RING_OFF);
    LAS bf16* VN = WS + 128 * SG_P;
    const int tid_ = F.wave * 64 + lane_id_opaque(); const int tid = tid_, lane = tid & 63, wave = F.wave, fr = lane & 15, fq = lane >> 4;
    int gprev = -1;
    for (int u = F.vcu; u < BATCH * 32 * 4; u += F.G) {
        const int g = u & 3, c = (u >> 2) & 31, b = u >> 7; const size_t row0 = (size_t)b * SEQ + c * 128;
        if (g != gprev) {
            __syncthreads();
#pragma unroll
            for (int i = 0; i < 4; ++i) { const int id = tid + 512 * i, r = id >> 4, ch = id & 15;
                *(LAS v4u*)(WS + r * SG_P + ch * 8) = *(const v4u*)(Wsb + (size_t)g * 16384 + r * 128 + ch * 8); }
            gprev = g;
        }
        { const int s = tid >> 2, qd = tid & 3; const v4u* vp = (const v4u*)(V + (row0 + s) * 512 + g * 128 + qd * 32);
          float x[32];
#pragma unroll
          for (int i = 0; i < 4; ++i) { const v4u w = vp[i]; x[8 * i] = bflo(w.x); x[8 * i + 1] = bfhi(w.x); x[8 * i + 2] = bflo(w.y); x[8 * i + 3] = bfhi(w.y); x[8 * i + 4] = bflo(w.z); x[8 * i + 5] = bfhi(w.z); x[8 * i + 6] = bflo(w.w); x[8 * i + 7] = bfhi(w.w); }
          float sm = 0.f;
#pragma unroll
          for (int i = 0; i < 32; ++i) sm += x[i];
          sm += __shfl_xor(sm, 1); sm += __shfl_xor(sm, 2); const float mean = sm * (1.f / 128.f); float sq = 0.f;
#pragma unroll
          for (int i = 0; i < 32; ++i) { x[i] -= mean; sq += x[i] * x[i]; }
          sq += __shfl_xor(sq, 1); sq += __shfl_xor(sq, 2); const float rstd = 1.f / sqrtf(sq * (1.f / 128.f) + LN_EPS);
          const f32x4* gp = (const f32x4*)(ln_g + g * 128 + qd * 32); const f32x4* bp = (const f32x4*)(ln_b + g * 128 + qd * 32);
#pragma unroll
          for (int i = 0; i < 4; ++i) { const f32x4 g0 = gp[2 * i], g1 = gp[2 * i + 1], b0 = bp[2 * i], b1 = bp[2 * i + 1]; v4u w;
              w.x = pk2(x[8 * i] * rstd * g0[0] + b0[0], x[8 * i + 1] * rstd * g0[1] + b0[1]); w.y = pk2(x[8 * i + 2] * rstd * g0[2] + b0[2], x[8 * i + 3] * rstd * g0[3] + b0[3]);
              w.z = pk2(x[8 * i + 4] * rstd * g1[0] + b1[0], x[8 * i + 5] * rstd * g1[1] + b1[1]); w.w = pk2(x[8 * i + 6] * rstd * g1[2] + b1[2], x[8 * i + 7] * rstd * g1[3] + b1[3]);
              *(LAS v4u*)(VN + s * SG_P + qd * 32 + 8 * i) = w; } }
        __syncthreads();
        f32x4 acc[8];
#pragma unroll
        for (int j = 0; j < 8; ++j) acc[j] = (f32x4){0.f, 0.f, 0.f, 0.f};
        const int ks_end = (16 * wave + 15) >> 5;
        for (int ks = 0; ks <= ks_end; ++ks) {
            const bf16x8 wf = *(const LAS bf16x8*)(WS + (16 * wave + fr) * SG_P + ks * 32 + fq * 8);
#pragma unroll
            for (int j = 0; j < 8; ++j) { const bf16x8 vf = lds_tr8(VN + (32 * ks + 8 * fq + (fr >> 2)) * SG_P + 16 * j + 4 * (fr & 3), 4 * SG_P); acc[j] = mfma16(vf, wf, acc[j]); }
        }
        { const int t = 16 * wave + fr; const float bs = b_s[g * 128 + t];
          const bf16* up = U + (row0 + t) * 512 + g * 128 + 4 * fq; bf16* op = MIX + (row0 + t) * 1024 + g * 128 + 4 * fq;
#pragma unroll
          for (int j = 0; j < 8; ++j) { const v2u uw = *(const v2u*)(up + 16 * j); v2u w;
              w.x = pk2(bflo(uw.x) * (acc[j][0] + bs), bfhi(uw.x) * (acc[j][1] + bs)); w.y = pk2(bflo(uw.y) * (acc[j][2] + bs), bfhi(uw.y) * (acc[j][3] + bs));
              *(v2u*)(op + 16 * j) = w; } }
        __syncthreads();
    }
}

__device__ __forceinline__ void combine_phase(Frame& F, const bf16* O1, const bf16* O2, const float* lq1, const float* lk1, const float* lq2, const float* lk2, const float* subg, float lam_init, const bf16* MIX, signed char* MIX8, float* SA) {
    const int tid_ = F.wave * 64 + lane_id_opaque(); const int lane = tid_ & 63, gw = F.vcu * NWAVES + F.wave, NGW = F.G * NWAVES;
    const float lam = __expf(wave_sum(lq1[lane] * lk1[lane])) - __expf(wave_sum(lq2[lane] * lk2[lane])) + lam_init;
    const int h = lane >> 4, e0 = (lane & 15) * 8; const float post = 1.f - lam_init;
    float sg[8];
#pragma unroll
    for (int i = 0; i < 8; ++i) sg[i] = subg[e0 + i] * post;
    for (int row = gw; row < M; row += NGW) {
        const v4u a = *(const v4u*)(O1 + (size_t)row * 512 + h * 128 + e0), b = *(const v4u*)(O2 + (size_t)row * 512 + h * 128 + e0), ml = *(const v4u*)(MIX + (size_t)row * 1024 + lane * 8);
        float o[8], xl[8];
        o[0] = bflo(a.x) - lam * bflo(b.x); o[1] = bfhi(a.x) - lam * bfhi(b.x); o[2] = bflo(a.y) - lam * bflo(b.y); o[3] = bfhi(a.y) - lam * bfhi(b.y);
        o[4] = bflo(a.z) - lam * bflo(b.z); o[5] = bfhi(a.z) - lam * bfhi(b.z); o[6] = bflo(a.w) - lam * bflo(b.w); o[7] = bfhi(a.w) - lam * bfhi(b.w);
        xl[0] = bflo(ml.x); xl[1] = bfhi(ml.x); xl[2] = bflo(ml.y); xl[3] = bfhi(ml.y); xl[4] = bflo(ml.z); xl[5] = bfhi(ml.z); xl[6] = bflo(ml.w); xl[7] = bfhi(ml.w);
        float ss = 0.f;
#pragma unroll
        for (int i = 0; i < 8; ++i) ss += o[i] * o[i];
        ss += __shfl_xor(ss, 1); ss += __shfl_xor(ss, 2); ss += __shfl_xor(ss, 4); ss += __shfl_xor(ss, 8);
        const float r = 1.f / sqrtf(ss * (1.f / 128.f) + LN_EPS);
        float am = 0.f;
#pragma unroll
        for (int i = 0; i < 8; ++i) { o[i] = o[i] * r * sg[i]; am = fmaxf(am, fmaxf(fabsf(o[i]), fabsf(xl[i]))); }
#pragma unroll
        for (int of = 1; of < 64; of <<= 1) am = fmaxf(am, __shfl_xor(am, of));
        const float inv = am > 0.f ? 127.f / am : 0.f;
        v2u wl, wr;
        wl.x = (unsigned)(rni8(xl[0] * inv) & 255) | ((unsigned)(rni8(xl[1] * inv) & 255) << 8) | ((unsigned)(rni8(xl[2] * inv) & 255) << 16) | ((unsigned)rni8(xl[3] * inv) << 24);
        wl.y = (unsigned)(rni8(xl[4] * inv) & 255) | ((unsigned)(rni8(xl[5] * inv) & 255) << 8) | ((unsigned)(rni8(xl[6] * inv) & 255) << 16) | ((unsigned)rni8(xl[7] * inv) << 24);
        wr.x = (unsigned)(rni8(o[0] * inv) & 255) | ((unsigned)(rni8(o[1] * inv) & 255) << 8) | ((unsigned)(rni8(o[2] * inv) & 255) << 16) | ((unsigned)rni8(o[3] * inv) << 24);
        wr.y = (unsigned)(rni8(o[4] * inv) & 255) | ((unsigned)(rni8(o[5] * inv) & 255) << 8) | ((unsigned)(rni8(o[6] * inv) & 255) << 16) | ((unsigned)rni8(o[7] * inv) << 24);
        *(v2u*)(MIX8 + (size_t)row * 1024 + lane * 8) = wl; *(v2u*)(MIX8 + (size_t)row * 1024 + 512 + h * 128 + e0) = wr;
        if (lane == 0) SA[row] = am > 0.f ? am * (1.f / 127.f) : 1.f;
    }
}

constexpr int RC = 64, RQ_P = 272, RK_P = 272, RV_P = 136, RP_P = 80;
constexpr int R_QS = 0, R_KS = R_QS + RC * RQ_P * 2, R_VS = R_KS + RC * RK_P * 2, R_PS = R_VS + RC * RV_P * 2, R_END = R_PS + RC * RP_P * 2;
static_assert(R_END <= RING_BYTES, "retention LDS");
#define RKSW(r_) (8 * ((((r_) >> 2) ^ ((r_) >> 3)) & 1))
template <int VAR> __device__ __forceinline__ void retention_phase(Frame& F, const bf16* Q, const bf16* K, const bf16* V, bf16* O) {
    LAS bf16* QS = (LAS bf16*)(F.lds + RING_OFF + R_QS); LAS bf16* KS = (LAS bf16*)(F.lds + RING_OFF + R_KS);
    LAS bf16* VS = (LAS bf16*)(F.lds + RING_OFF + R_VS); LAS bf16* PS = (LAS bf16*)(F.lds + RING_OFF + R_PS);
    const int wave = F.wave;
    for (int u = F.vcu; u < BATCH * 4 * 4; u += F.G) {
        const int sl = u & 3, h = (u >> 2) & 3, b = u >> 4;
        const float lg = __log2f(1.0f - __builtin_amdgcn_exp2f(-5.0f - (float)h));
        const float cdec = __builtin_amdgcn_exp2f(lg * (float)RC);
        const bf16* Qg = Q + (size_t)b * SEQ * 1024 + h * 256; const bf16* Kg = K + (size_t)b * SEQ * 1024 + h * 256;
        const bf16* Vg = V + (size_t)b * SEQ * 2048 + h * 512 + sl * 128; bf16* Og = O + (size_t)b * SEQ * 2048 + h * 512 + sl * 128;
        f32x4 st[16];
#pragma unroll
        for (int t = 0; t < 16; ++t) st[t] = (f32x4){0.f, 0.f, 0.f, 0.f};
        float qd[4], kdv[2][8];
        { const int l0 = lane_id_opaque(), fr0 = l0 & 15, fq0 = l0 >> 4;
#pragma unroll
          for (int mi = 0; mi < 4; ++mi) qd[mi] = __builtin_amdgcn_exp2f(lg * (float)(16 * mi + fr0 + 1));
#pragma unroll
          for (int ks = 0; ks < 2; ++ks)
#pragma unroll
              for (int j = 0; j < 8; ++j) kdv[ks][j] = __builtin_amdgcn_exp2f(lg * (float)(RC - 1 - (32 * ks + 8 * fq0 + j))); }
        v4u rq[4], rk[4], rv[2];
#define RET_TID() const int tid_ = F.wave * 64 + lane_id_opaque(); const int tid = tid_, lane = tid & 63, fr = lane & 15, fq = lane >> 4; (void)fr; (void)fq
#define RET_LOAD(c0) do { RET_TID(); const size_t t0_ = (size_t)(c0) * RC; \
            _Pragma("unroll") for (int i = 0; i < 4; ++i) { const int id = tid + 512 * i; rq[i] = *(const v4u*)(Qg + (t0_ + (id >> 5)) * 1024 + (id & 31) * 8); rk[i] = *(const v4u*)(Kg + (t0_ + (id >> 5)) * 1024 + (id & 31) * 8); } \
            _Pragma("unroll") for (int i = 0; i < 2; ++i) { const int id = tid + 512 * i; rv[i] = *(const v4u*)(Vg + (t0_ + (id >> 4)) * 2048 + (id & 15) * 8); } } while (0)
        RET_LOAD(0);
        if (VAR == 2) { asm volatile("" : "+v"(rq[0]), "+v"(rq[1]), "+v"(rq[2]), "+v"(rq[3]), "+v"(rk[0]), "+v"(rk[1]), "+v"(rk[2]), "+v"(rk[3]), "+v"(rv[0]), "+v"(rv[1])); }
        for (int c = 0; c < SEQ / RC; ++c) {
            { RET_TID();
#pragma unroll
              for (int i = 0; i < 4; ++i) { const int id = tid + 512 * i; *(LAS v4u*)(QS + (id >> 5) * RQ_P + (id & 31) * 8) = rq[i]; *(LAS v4u*)(KS + (id >> 5) * RK_P + (((id & 31) ^ RKSW(id >> 5)) * 8)) = rk[i]; }
#pragma unroll
              for (int i = 0; i < 2; ++i) { const int id = tid + 512 * i; *(LAS v4u*)(VS + (id >> 4) * RV_P + (id & 15) * 8) = rv[i]; } }
            if (VAR != 2 && c + 1 < SEQ / RC) RET_LOAD(c + 1);
            __syncthreads();
            if (VAR != 1) {
            { RET_TID(); const int ti = wave >> 1, tj0 = 2 * (wave & 1);
              f32x4 sc[2] = {(f32x4){0.f, 0.f, 0.f, 0.f}, (f32x4){0.f, 0.f, 0.f, 0.f}};
#define LOADS(dst, g_) do { _Pragma("unroll") for (int k2 = 0; k2 < 2; ++k2) { dst[3 * k2] = *(const LAS bf16x8*)(QS + (16 * ti + fr) * RQ_P + (2 * (g_) + k2) * 32 + fq * 8); \
                  dst[3 * k2 + 1] = *(const LAS bf16x8*)(KS + (16 * tj0 + fr) * RK_P + ((((2 * (g_) + k2) * 4 + fq) ^ RKSW(fr)) * 8)); dst[3 * k2 + 2] = *(const LAS bf16x8*)(KS + (16 * (tj0 + 1) + fr) * RK_P + ((((2 * (g_) + k2) * 4 + fq) ^ RKSW(fr)) * 8)); } } while (0)
#define SCORE(f) do { sc[0] = mfma16(f[1], f[0], sc[0]); sc[1] = mfma16(f[2], f[0], sc[1]); sc[0] = mfma16(f[4], f[3], sc[0]); sc[1] = mfma16(f[5], f[3], sc[1]); } while (0)
              bf16x8 fa[6], fb[6];
              LOADS(fa, 0); __builtin_amdgcn_sched_barrier(0);
              LOADS(fb, 1); __builtin_amdgcn_sched_barrier(0); SCORE(fa); __builtin_amdgcn_sched_barrier(0);
              LOADS(fa, 2); __builtin_amdgcn_sched_barrier(0); SCORE(fb); __builtin_amdgcn_sched_barrier(0);
              LOADS(fb, 3); __builtin_amdgcn_sched_barrier(0); SCORE(fa); __builtin_amdgcn_sched_barrier(0);
              SCORE(fb); __builtin_amdgcn_sched_barrier(0);
#undef LOADS
#undef SCORE
              const int q = 16 * ti + fr;
#pragma unroll
              for (int j = 0; j < 2; ++j) { const int key0 = 16 * (tj0 + j) + 4 * fq; float p[4];
#pragma unroll
                  for (int r = 0; r < 4; ++r) p[r] = (q >= key0 + r) ? sc[j][r] * __builtin_amdgcn_exp2f(lg * (float)(q - key0 - r)) : 0.f;
                  v2u w; w.x = pk2(p[0], p[1]); w.y = pk2(p[2], p[3]); *(LAS v2u*)(PS + q * RP_P + key0) = w; } }
            }
            __syncthreads();
            if (VAR != 1) {
            RET_TID();
#define SB() __builtin_amdgcn_sched_barrier(0)
#define LOADQ(dst, ks_) do { _Pragma("unroll") for (int mi = 0; mi < 4; ++mi) dst[mi] = *(const LAS v4u*)(QS + (16 * mi + fr) * RQ_P + (ks_) * 32 + 8 * fq); } while (0)
#define LOADP(dst, ks_) do { _Pragma("unroll") for (int mi = 0; mi < 4; ++mi) dst[mi] = *(const LAS v4u*)(PS + (16 * mi + fr) * RP_P + (ks_) * 32 + fq * 8); } while (0)
#define LOADKT(dst, t_) do { _Pragma("unroll") for (int k2 = 0; k2 < 2; ++k2) { const int cl_ = (4 * ((t_) >> 1) + (fr & 3)) ^ (8 * (fq & 1));     \
                const LAS bf16* pl_ = KS + (32 * k2 + 8 * fq + (fr >> 2)) * RK_P + cl_ * 8 + 4 * ((t_) & 1); const LAS bf16* ph_ = KS + (32 * k2 + 8 * fq + (fr >> 2) + 4) * RK_P + (cl_ ^ 8) * 8 + 4 * ((t_) & 1); \
                const s16x4 lo_ = __builtin_bit_cast(s16x4, __builtin_amdgcn_ds_read_tr16_b64_v4i16((LAS s16x4*)pl_)); const s16x4 hi_ = __builtin_bit_cast(s16x4, __builtin_amdgcn_ds_read_tr16_b64_v4i16((LAS s16x4*)ph_)); \
                dst[k2] = (bf16x8){lo_[0], lo_[1], lo_[2], lo_[3], hi_[0], hi_[1], hi_[2], hi_[3]}; } } while (0)
#define CROSS(ks_, qf) do { const v4u pw_ = {pk2(st[2 * (ks_)][0], st[2 * (ks_)][1]), pk2(st[2 * (ks_)][2], st[2 * (ks_)][3]), pk2(st[2 * (ks_) + 1][0], st[2 * (ks_) + 1][1]), pk2(st[2 * (ks_) + 1][2], st[2 * (ks_) + 1][3])}; \
                const bf16x8 sb_ = __builtin_bit_cast(bf16x8, pw_); _Pragma("unroll") for (int mi = 0; mi < 4; ++mi) acc[mi] = mfma16(sb_, __builtin_bit_cast(bf16x8, qf[mi]), acc[mi]); } while (0)
            f32x4 acc[4];
#pragma unroll
            for (int mi = 0; mi < 4; ++mi) acc[mi] = (f32x4){0.f, 0.f, 0.f, 0.f};
            v4u qa[4], qb[4]; bf16x8 vb[2], vd[2], ka[2], kb[2];
            LOADQ(qa, 0); SB();
            LOADQ(qb, 1); SB(); CROSS(0, qa); SB();
            LOADQ(qa, 2); SB(); CROSS(1, qb); SB();
            LOADQ(qb, 3); SB(); CROSS(2, qa); SB();
            LOADQ(qa, 4); SB(); CROSS(3, qb); SB();
            LOADQ(qb, 5); SB(); CROSS(4, qa); SB();
            LOADQ(qa, 6); SB(); CROSS(5, qb); SB();
            LOADQ(qb, 7); SB(); CROSS(6, qa); SB();
#pragma unroll
            for (int ks = 0; ks < 2; ++ks) vb[ks] = lds_tr8(VS + (32 * ks + 8 * fq + (fr >> 2)) * RV_P + 16 * wave + 4 * (fr & 3), 4 * RV_P);
            LOADP(qa, 0); SB(); CROSS(7, qb); SB();
#pragma unroll
            for (int mi = 0; mi < 4; ++mi) acc[mi] = acc[mi] * qd[mi];
            LOADP(qb, 1); SB();
#pragma unroll
            for (int mi = 0; mi < 4; ++mi) acc[mi] = mfma16(vb[0], __builtin_bit_cast(bf16x8, qa[mi]), acc[mi]);
            SB(); LOADKT(ka, 0); SB();
#pragma unroll
            for (int mi = 0; mi < 4; ++mi) acc[mi] = mfma16(vb[1], __builtin_bit_cast(bf16x8, qb[mi]), acc[mi]);
            SB();
#pragma unroll
            for (int ks = 0; ks < 2; ++ks) { const v4u vw = __builtin_bit_cast(v4u, vb[ks]); v4u dw;
                dw.x = pk2(bflo(vw.x) * kdv[ks][0], bfhi(vw.x) * kdv[ks][1]); dw.y = pk2(bflo(vw.y) * kdv[ks][2], bfhi(vw.y) * kdv[ks][3]);
                dw.z = pk2(bflo(vw.z) * kdv[ks][4], bfhi(vw.z) * kdv[ks][5]); dw.w = pk2(bflo(vw.w) * kdv[ks][6], bfhi(vw.w) * kdv[ks][7]);
                vd[ks] = __builtin_bit_cast(bf16x8, dw); }
            if (VAR != 3) { bf16* op = Og + ((size_t)c * RC + fr) * 2048 + 16 * wave + 4 * fq;
#pragma unroll
              for (int mi = 0; mi < 4; ++mi) { v2u w; w.x = pk2(acc[mi][0], acc[mi][1]); w.y = pk2(acc[mi][2], acc[mi][3]); *(v2u*)(op + (size_t)(16 * mi) * 2048) = w; } }
            SB();
#define STATE(t_, kf) do { st[t_] = st[t_] * cdec; st[t_] = mfma16(kf[0], vd[0], st[t_]); st[t_] = mfma16(kf[1], vd[1], st[t_]); } while (0)
#pragma unroll
            for (int t = 0; t < 16; t += 2) {
                LOADKT(kb, t + 1); SB(); STATE(t, ka); SB();
                if (t + 2 < 16) { LOADKT(ka, t + 2); } SB(); STATE(t + 1, kb); SB(); }
#undef SB
#undef LOADQ
#undef LOADP
#undef LOADKT
#undef CROSS
#undef STATE
            }
            __syncthreads();
        }
#undef RET_LOAD
#undef RET_TID
    }
}

__device__ __forceinline__ void gate_phase(Frame& F, const bf16* O, const bf16* G, const float* gn_g, signed char* G8, float* SA) {
    const int tid_ = F.wave * 64 + lane_id_opaque(); const int lane = tid_ & 63, gw = F.vcu * NWAVES + F.wave, NGW = F.G * NWAVES;
    float gg[32];
#pragma unroll
    for (int i = 0; i < 32; ++i) gg[i] = gn_g[lane * 32 + i];
    for (int row = gw; row < M; row += NGW) {
        const v4u* op = (const v4u*)(O + (size_t)row * 2048 + lane * 32); const v4u* gp = (const v4u*)(G + (size_t)row * 2048 + lane * 32);
        float x[32], gt[32];
#pragma unroll
        for (int i = 0; i < 4; ++i) { const v4u w = op[i], z = gp[i];
            x[8 * i] = bflo(w.x); x[8 * i + 1] = bfhi(w.x); x[8 * i + 2] = bflo(w.y); x[8 * i + 3] = bfhi(w.y); x[8 * i + 4] = bflo(w.z); x[8 * i + 5] = bfhi(w.z); x[8 * i + 6] = bflo(w.w); x[8 * i + 7] = bfhi(w.w);
            gt[8 * i] = bflo(z.x); gt[8 * i + 1] = bfhi(z.x); gt[8 * i + 2] = bflo(z.y); gt[8 * i + 3] = bfhi(z.y); gt[8 * i + 4] = bflo(z.z); gt[8 * i + 5] = bfhi(z.z); gt[8 * i + 6] = bflo(z.w); gt[8 * i + 7] = bfhi(z.w); }
        float sm = 0.f;
#pragma unroll
        for (int i = 0; i < 32; ++i) sm += x[i];
        sm += __shfl_xor(sm, 1); sm += __shfl_xor(sm, 2); sm += __shfl_xor(sm, 4); sm += __shfl_xor(sm, 8);
        const float mean = sm * (1.f / 512.f); float sq = 0.f;
#pragma unroll
        for (int i = 0; i < 32; ++i) { x[i] -= mean; sq += x[i] * x[i]; }
        sq += __shfl_xor(sq, 1); sq += __shfl_xor(sq, 2); sq += __shfl_xor(sq, 4); sq += __shfl_xor(sq, 8);
        const float rstd = 1.f / sqrtf(sq * (1.f / 512.f) + LN_EPS);
        float am = 0.f;
#pragma unroll
        for (int i = 0; i < 32; ++i) { x[i] = x[i] * rstd * gg[i] * gt[i]; am = fmaxf(am, fabsf(x[i])); }
#pragma unroll
        for (int o = 1; o < 64; o <<= 1) am = fmaxf(am, __shfl_xor(am, o));
        const float inv = am > 0.f ? 127.f / am : 0.f;
        v4u* qp = (v4u*)(G8 + (size_t)row * 2048 + lane * 32);
#pragma unroll
        for (int i = 0; i < 2; ++i) { v4u w; unsigned d[4];
#pragma unroll
            for (int j = 0; j < 4; ++j) { const float* y = x + 16 * i + 4 * j;
                d[j] = (unsigned)(rni8(y[0] * inv) & 255) | ((unsigned)(rni8(y[1] * inv) & 255) << 8) | ((unsigned)(rni8(y[2] * inv) & 255) << 16) | ((unsigned)rni8(y[3] * inv) << 24); }
            w.x = d[0]; w.y = d[1]; w.z = d[2]; w.w = d[3]; qp[i] = w; }
        if (lane == 0) SA[row] = am > 0.f ? am * (1.f / 127.f) : 1.f;
    }
}

struct Args {
    const float* in[31]; float* out; unsigned char* ws; int ph_lo, ph_hi; int pad0, pad1;
};
enum { I_X = 0, I_EWIN, I_EWS, I_EBS, I_EVLG, I_EVLB, I_LQ1, I_LK1, I_LQ2, I_LK2, I_SUBG, I_EWO, I_ELN1G, I_ELN1B, I_FW1, I_FW3, I_FW2, I_ELN2G, I_ELN2B,
       I_OWIN, I_OGN, I_OWO, I_OLN1G, I_OLN1B, I_RW, I_RB, I_MW1, I_MW3, I_MW2, I_OLN2G, I_OLN2B };
constexpr int PH_EVEN = 8, PH_ODD = 9, PH_TOTAL = 1 + 2 * (PH_EVEN + PH_ODD);

__global__ void __launch_bounds__(NWAVES * 64, 2) mk_fwd(Args args) {
    extern __shared__ __attribute__((aligned(16))) unsigned char lds[];
    Frame F;
    F.lds = (LAS unsigned char*)lds;
    F.wave = __builtin_amdgcn_readfirstlane((int)threadIdx.x >> 6);
    F.G = gridDim.x; { const int bx = blockIdx.x; F.vcu = (F.G % 8 == 0) ? (bx % 8) * (F.G / 8) + bx / 8 : bx; }
    unsigned* ctl = (unsigned*)(args.ws + WS_CTL);
    for (int u = threadIdx.x; u < (LDS_BYTES - LDSCTL_OFF) / 4; u += NWAVES * 64) ((LAS unsigned*)(F.lds + LDSCTL_OFF))[u] = 0u;
    __syncthreads();
    const int lo = args.ph_lo, hi = args.ph_hi;
    XcdBarrier bar; bar.bar = ctl + CW_BAR; bar.x = 0; bar.st = nullptr;
    if (hi - lo > 1) bar = xcd_barrier_post(ctl + CW_BAR, (volatile LAS unsigned*)(F.lds + LDSCTL_OFF + 32));
#define IN(k) (lo <= (k) && (k) < hi)
#ifndef ONLY_PH
#define ONLY_PH -1
#endif
#define KEEP(n) (ONLY_PH < 0 || ONLY_PH == (n))
#ifndef DUP_MASK
#define DUP_MASK 0
#endif
#define NREP(n) ((((n) == 1 || (n) == 4 || (n) == 6 || (n) == 7 || (n) == 10 || (n) == 13) && (DUP_MASK & 1)) || (((n) == 16 || (n) == 17) && (DUP_MASK & 2)) || ((n) == 2 && (DUP_MASK & 4)) || ((n) == 11 && (DUP_MASK & 8)) || \
    (((n) == 0 || (n) == 3 || (n) == 5 || (n) == 8 || (n) == 9 || (n) == 14 || (n) == 15) && (DUP_MASK & 16)) ? 2 : 1)
#define SEAM(k) do { if (IN(k) && IN((k) + 1)) xcd_barrier(bar); } while (0)

#define PH_LOCALS int z_ = 0; asm volatile("" : "+s"(z_)); unsigned char* const ws = args.ws + z_; (void)ws; \
    bf16* const XB = (bf16*)(ws + WS_XB); (void)XB; signed char* const XQ = (signed char*)(ws + WS_WB + WB_XQ); (void)XQ; float* const SA = (float*)(ws + WS_SA); (void)SA; float* const SW = (float*)(ws + WS_SW); (void)SW; float* const SAS = (float*)(ws + WS_SAS); (void)SAS; float* const Y = args.out + z_; (void)Y; unsigned char* const act = ws + WS_ACT; (void)act; unsigned char* const wb = ws + WS_WB; (void)wb
#define INP(i) (args.in[(i) + z_])
#define MOE_PTRS int* const tok_e = (int*)(ws + WS_TOKE); float* const tok_g = (float*)(ws + WS_TOKG); int* const slot_of_tok = (int*)(ws + WS_SLOT); \
    int* const tok_of_slot = (int*)(ws + WS_TOKS); float* const gate_of_slot = (float*)(ws + WS_GATS); int* const wvcnt = (int*)(ws + WS_WCNT); int* const tiles = (int*)(ws + WS_TILE); \
    (void)tok_e; (void)tok_g; (void)slot_of_tok; (void)tok_of_slot; (void)gate_of_slot; (void)wvcnt; (void)tiles
#define EVEN_PTRS bf16* const WinT = (bf16*)(wb + WB_E_IN); bf16* const WoT = (bf16*)(wb + WB_E_O); bf16* const W13T = (bf16*)(wb + WB_E_13); bf16* const W2T = (bf16*)(wb + WB_E_2); \
    bf16* const Wsb = (bf16*)(ws + WS_WSB); \
    bf16* const U = (bf16*)(act + A_U); bf16* const Vg = (bf16*)(act + A_V); bf16* const Qa = (bf16*)(act + A_Q); bf16* const Ka = (bf16*)(act + A_K); bf16* const Va = (bf16*)(act + A_VA); \
    bf16* const O1 = (bf16*)(act + A_O1); bf16* const O2 = (bf16*)(act + A_O2); bf16* const MIX = (bf16*)(act + A_MIX); bf16* const Hh = (bf16*)(act + A_H); \
    (void)WinT; (void)WoT; (void)W13T; (void)W2T; (void)Wsb; (void)U; (void)Vg; (void)Qa; (void)Ka; (void)Va; (void)O1; (void)O2; (void)MIX; (void)Hh
#define ODD_PTRS bf16* const WinT = (bf16*)(wb + WB_O_IN); bf16* const WoT = (bf16*)(wb + WB_O_O); unsigned char* const MW13 = wb + WB_O_13; unsigned char* const MW2 = wb + WB_O_2; \
    bf16* const Qr = (bf16*)(act + AO_Q); bf16* const Kr = (bf16*)(act + AO_K); bf16* const Vr = (bf16*)(act + AO_V); bf16* const Gr = (bf16*)(act + AO_G); \
    bf16* const Or = (bf16*)Y; unsigned char* const HM = act + AM_H; bf16* const OUTB = (bf16*)(act + AM_OUT); \
    (void)WinT; (void)WoT; (void)MW13; (void)MW2; (void)Qr; (void)Kr; (void)Vr; (void)Gr; (void)Or; (void)HM; (void)OUTB

    int ph = 0;
    for (int l = 0; l < 4; ++l) {
        const int li = l >> 1;
        if ((l & 1) == 0) {
            if (l == 0) {
            if (KEEP(0) && IN(ph)) for (int rep_ = 0; rep_ < NREP(0); ++rep_) { PH_LOCALS; EVEN_PTRS;
                conv_q1024(F, QSet{INP(I_EWIN) + (size_t)li * DM * EVEN_IN, EVEN_IN, (signed char*)WinT, SW + SW_EIN, INP(I_FW1) + (size_t)li * DM * DFF, INP(I_FW3) + (size_t)li * DM * DFF, 1, (signed char*)W13T, SW + SW_E13,
                                   INP(I_EWO) + (size_t)li * DM * DM, (signed char*)WoT, SW + SW_EWO});
                const ConvJob J[1] = {
                    {INP(I_FW2) + (size_t)li * DFF * DM, W2T, DFF, DM, 128, 0, (DFF / 64) * (DM / 32), W8_SCALE, nullptr, nullptr, 1}};
                conv_jobs<1>(F, J);
                { float* const PN = (float*)(act + A_PMAX) + (size_t)((l + 1) & 1) * PMAX_FLOATS;
                  conv_wo_max(F, INP(I_OWO) + (size_t)li * 2 * DM * DM, PN + PM_WO); }
                const int tq = F.wave * 64 + lane_id_opaque();
                { const float* wsrc = INP(I_EWS) + (size_t)li * 4 * 128 * 128;
                  for (int i = blockIdx.x * 512 + tq; i < 4 * 128 * 128; i += F.G * 512) { const int s = i & 127, t = (i >> 7) & 127; Wsb[i] = (bf16)f2bf(s <= t ? wsrc[i] : 0.f); } }
                if (l == 0) ln_phase<3, false, false>(F, INP(I_X), XB, nullptr, INP(I_ELN1G), INP(I_ELN1B), nullptr, nullptr, nullptr, nullptr, nullptr, nullptr, nullptr, XQ, SA);
            }
            SEAM(ph); ++ph;
            }
            if (KEEP(1) && IN(ph)) for (int rep_ = 0; rep_ < NREP(1); ++rep_) { PH_LOCALS; EVEN_PTRS;
                pg8::Gemm g{(const bf16*)XQ, WinT, M, EVEN_IN, DM}; pg8::StaticOrder S; S.init(M, EVEN_IN, F.G, (int)blockIdx.x);
                pg8::EpiRouteQ E{{U, Vg, Qa, Ka, Va}, {512, 512, 512, 512, 512}, {0, 2, 4, 6, 8}, {1, 1, 0, 0, 0}, {1.f, 1.f, attn_body::C2, 1.f, 1.f}, 5, SA, SW + SW_EIN, nullptr};
                pg8::gemm_phase<pg8::EpiRouteQ, pg8::StaticOrder, true, true, 2>(F.lds + RING_OFF, g, S, E, F.wave);
            }
            SEAM(ph); ++ph;
            if (KEEP(2) && IN(ph)) for (int rep_ = 0; rep_ < NREP(2); ++rep_) { PH_LOCALS; EVEN_PTRS;
                attn_body::attn_phase<40>((char*)lds + RING_OFF, (const attn_body::bf16*)Qa, (const attn_body::bf16*)Ka, (const attn_body::bf16*)Va, (attn_body::bf16*)O1, (attn_body::bf16*)O2, F.vcu, F.G, F.wave);
                sgu_phase(F, Wsb, INP(I_EBS) + li * 512, INP(I_EVLG) + li * 512, INP(I_EVLB) + li * 512, U, Vg, MIX);
            }
            SEAM(ph); ++ph;
            if (KEEP(3) && IN(ph)) for (int rep_ = 0; rep_ < NREP(3); ++rep_) { PH_LOCALS; EVEN_PTRS;
                const float lam_init = 0.8f - 0.6f * __expf(-0.3f * (float)l);
                combine_phase(F, O1, O2, INP(I_LQ1) + li * 64, INP(I_LK1) + li * 64, INP(I_LQ2) + li * 64, INP(I_LK2) + li * 64, INP(I_SUBG) + li * 128, lam_init, MIX, (signed char*)(act + A_MIX8), SA);
            }
            SEAM(ph); ++ph;
            if (KEEP(4) && IN(ph)) for (int rep_ = 0; rep_ < NREP(4); ++rep_) { PH_LOCALS; EVEN_PTRS;
                pg8::Gemm g{(const bf16*)(act + A_MIX8), WoT, M, DM, DM}; pg8::StaticOrder S; S.init(M, DM, F.G, (int)blockIdx.x);
                if (l == 0) { pg8::EpiResFromF32Q E{INP(I_X), XB, DM, DN_ALPHA, SA, SW + SW_EWO, nullptr};
                    pg8::gemm_phase<pg8::EpiResFromF32Q, pg8::StaticOrder, true, true, 2>(F.lds + RING_OFF, g, S, E, F.wave); }
                else { pg8::EpiResInplaceQ E{XB, DM, DN_ALPHA, SA, SW + SW_EWO, nullptr};
                    pg8::gemm_phase<pg8::EpiResInplaceQ, pg8::StaticOrder, true, true, 2>(F.lds + RING_OFF, g, S, E, F.wave); }
            }
            SEAM(ph); ++ph;
            if (KEEP(5) && IN(ph)) for (int rep_ = 0; rep_ < NREP(5); ++rep_) { PH_LOCALS; EVEN_PTRS; ln_phase<2, false, false>(F, nullptr, XB, nullptr, INP(I_ELN1G) + li * DM, INP(I_ELN1B) + li * DM, nullptr, nullptr, nullptr, nullptr, nullptr, nullptr, nullptr, XQ, SA); }
            SEAM(ph); ++ph;
            if (KEEP(6) && IN(ph)) for (int rep_ = 0; rep_ < NREP(6); ++rep_) { PH_LOCALS; EVEN_PTRS;
                pg8::Gemm g{(const bf16*)XQ, W13T, M, 2 * DFF, DM}; pg8::StaticOrder S; S.init(M, 2 * DFF, F.G, (int)blockIdx.x);
                pg8::EpiSwigluQ<true> E{Hh, DFF, SA, SW + SW_E13, nullptr};
                pg8::gemm_phase<pg8::EpiSwigluQ<true>, pg8::StaticOrder, true, true, 2>(F.lds + RING_OFF, g, S, E, F.wave);
            }
            SEAM(ph); ++ph;
            if (KEEP(7) && IN(ph)) for (int rep_ = 0; rep_ < NREP(7); ++rep_) { PH_LOCALS; EVEN_PTRS;
                pg8::Gemm g{Hh, W2T, M, DM, DFF}; pg8::StaticOrder S; S.init(M, DM, F.G, (int)blockIdx.x);
                pg8::EpiResInplace E{XB, DM, DN_ALPHA, 1.f / W8_SCALE};
                pg8::gemm_phase<pg8::EpiResInplace, pg8::StaticOrder, true, true, 1, true>(F.lds + RING_OFF, g, S, E, F.wave);
            }
            SEAM(ph); ++ph;
            if (KEEP(8) && IN(ph)) for (int rep_ = 0; rep_ < NREP(8); ++rep_) { PH_LOCALS; EVEN_PTRS; ln_phase<2, false, false>(F, nullptr, XB, nullptr, INP(I_ELN2G) + li * DM, INP(I_ELN2B) + li * DM, nullptr, nullptr, nullptr, nullptr, nullptr, nullptr, nullptr, XQ, SA);
                { ODD_PTRS; MOE_PTRS;
                float* const PM = (float*)(act + A_PMAX) + (size_t)((l + 1) & 1) * PMAX_FLOATS;
                conv_q1024(F, QSet{INP(I_OWIN) + (size_t)li * DM * ODD_IN, ODD_IN, (signed char*)WinT, SW + SW_OIN, INP(I_MW1) + (size_t)li * NEXP * DM * DFF, INP(I_MW3) + (size_t)li * NEXP * DM * DFF, NEXP, (signed char*)MW13, SW + SW_M13});
                conv_wo_q(F, INP(I_OWO) + (size_t)li * 2 * DM * DM, (signed char*)WoT, SW + SW_OWO, PM + PM_WO);
                for (int e = 0; e < NEXP; ++e) { const ConvJob J[1] = {
                    {INP(I_MW2) + ((size_t)li * NEXP + e) * DFF * DM, (bf16*)(MW2 + (size_t)e * DM * DFF), DFF, DM, 128, 0, (DFF / 64) * (DM / 32), W8_SCALE, nullptr, nullptr, 1}};
                    conv_jobs<1>(F, J); }
                } }
            SEAM(ph); ++ph;
        } else {
            if (KEEP(10) && IN(ph)) for (int rep_ = 0; rep_ < NREP(10); ++rep_) { PH_LOCALS; ODD_PTRS; MOE_PTRS;
                pg8::Gemm g{(const bf16*)XQ, WinT, M, ODD_IN, DM}; pg8::StaticOrder S; S.init(M, ODD_IN, F.G, (int)blockIdx.x);
                pg8::EpiRouteQ E{{Qr, Kr, Vr, Gr, Gr}, {1024, 1024, 2048, 2048, 2048}, {0, 4, 8, 16, 1 << 30}, {0, 0, 0, 2, 0}, {1.f, 0.0625f, 1.f, 1.f, 1.f}, 4, SA, SW + SW_OIN, nullptr};
                pg8::gemm_phase<pg8::EpiRouteQ, pg8::StaticOrder, true, true, 2>(F.lds + RING_OFF, g, S, E, F.wave);
            }
            SEAM(ph); ++ph;
            if (KEEP(11) && IN(ph)) for (int rep_ = 0; rep_ < NREP(11); ++rep_) { PH_LOCALS; ODD_PTRS; MOE_PTRS;
#ifdef DUP_VARIANT
                if (args.pad0 == 1) retention_phase<1>(F, Qr, Kr, Vr, Or); else if (args.pad0 == 2) retention_phase<2>(F, Qr, Kr, Vr, Or); else if (args.pad0 == 3) retention_phase<3>(F, Qr, Kr, Vr, Or); else
#endif
                retention_phase<0>(F, Qr, Kr, Vr, Or); }
            SEAM(ph); ++ph;
            if (KEEP(12) && IN(ph)) for (int rep_ = 0; rep_ < NREP(12); ++rep_) { PH_LOCALS; ODD_PTRS; MOE_PTRS; gate_phase(F, Or, Gr, INP(I_OGN) + li * 2048, (signed char*)Qr, SA); }
            SEAM(ph); ++ph;
            if (KEEP(13) && IN(ph)) for (int rep_ = 0; rep_ < NREP(13); ++rep_) { PH_LOCALS; ODD_PTRS; MOE_PTRS;
                pg8::Gemm g{Qr, WoT, M, DM, 2 * DM}; pg8::StaticOrder S; S.init(M, DM, F.G, (int)blockIdx.x);
                pg8::EpiResInplaceQ E{XB, DM, DN_ALPHA, SA, SW + SW_OWO, nullptr};
                pg8::gemm_phase<pg8::EpiResInplaceQ, pg8::StaticOrder, true, true, 2>(F.lds + RING_OFF, g, S, E, F.wave);
            }
            SEAM(ph); ++ph;
            if (KEEP(14) && IN(ph)) for (int rep_ = 0; rep_ < NREP(14); ++rep_) { PH_LOCALS; ODD_PTRS; MOE_PTRS; ln_phase<2, true, false>(F, nullptr, XB, nullptr, INP(I_OLN1G) + li * DM, INP(I_OLN1B) + li * DM, nullptr, nullptr,
                                                 INP(I_RW) + (size_t)li * DM * NEXP, INP(I_RB) + li * NEXP, tok_e, tok_g, wvcnt, XQ, SA); }
            SEAM(ph); ++ph;
            if (KEEP(15) && IN(ph)) for (int rep_ = 0; rep_ < NREP(15); ++rep_) { PH_LOCALS; ODD_PTRS; MOE_PTRS; assign_phase(F, wvcnt, tok_e, tok_g, slot_of_tok, tok_of_slot, gate_of_slot, tiles, SA, SAS); }
            SEAM(ph); ++ph;
            if (KEEP(16) && IN(ph)) for (int rep_ = 0; rep_ < NREP(16); ++rep_) { PH_LOCALS; ODD_PTRS; MOE_PTRS;
                const int nt = tiles[0];
                pg8::Gemm g{(const bf16*)XQ, (const bf16*)MW13, 0, 0, DM}; pg8::MoeOrder<true> S; S.init(nt, 2 * DFF / 256, F.G, (int)blockIdx.x, tiles + 16, tok_of_slot);
                pg8::EpiSwigluQ<true> E{HM, DFF, SAS, SW + SW_M13, nullptr};
                pg8::gemm_phase<pg8::EpiSwigluQ<true>, pg8::MoeOrder<true>, true, true, 2>(F.lds + RING_OFF, g, S, E, F.wave);
            }
            SEAM(ph); ++ph;
            if (KEEP(17) && IN(ph)) for (int rep_ = 0; rep_ < NREP(17); ++rep_) { PH_LOCALS; ODD_PTRS; MOE_PTRS;
                const int nt = tiles[0];
                pg8::Gemm g{(const bf16*)HM, (const bf16*)MW2, 0, 0, DFF}; pg8::MoeOrder<false> S; S.init(nt, DM / 256, F.G, (int)blockIdx.x, tiles + 16, nullptr);
                pg8::EpiMoeDown E{OUTB, DM, gate_of_slot, 1.f / W8_SCALE, nullptr};
                pg8::gemm_phase<pg8::EpiMoeDown, pg8::MoeOrder<false>, true, true, 1, true>(F.lds + RING_OFF, g, S, E, F.wave);
            }
            SEAM(ph); ++ph;
            if (KEEP(18) && IN(ph)) for (int rep_ = 0; rep_ < NREP(18); ++rep_) { PH_LOCALS; ODD_PTRS; MOE_PTRS;
                if (l == 3) ln_phase<1, false, true>(F, nullptr, XB, Y, INP(I_OLN2G) + li * DM, INP(I_OLN2B) + li * DM, OUTB, slot_of_tok, nullptr, nullptr, nullptr, nullptr, nullptr);
                else        ln_phase<1, false, false>(F, nullptr, XB, nullptr, INP(I_OLN2G) + li * DM, INP(I_OLN2B) + li * DM, OUTB, slot_of_tok, nullptr, nullptr, nullptr, nullptr, nullptr, XQ, SA);
                if (l + 1 < 4) { EVEN_PTRS;
                conv_q1024(F, QSet{INP(I_EWIN) + (size_t)(li + 1) * DM * EVEN_IN, EVEN_IN, (signed char*)WinT, SW + SW_EIN, INP(I_FW1) + (size_t)(li + 1) * DM * DFF, INP(I_FW3) + (size_t)(li + 1) * DM * DFF, 1, (signed char*)W13T, SW + SW_E13,
                                   INP(I_EWO) + (size_t)(li + 1) * DM * DM, (signed char*)WoT, SW + SW_EWO});
                const ConvJob J[1] = {
                    {INP(I_FW2) + (size_t)(li + 1) * DFF * DM, W2T, DFF, DM, 128, 0, (DFF / 64) * (DM / 32), W8_SCALE, nullptr, nullptr, 1}};
                conv_jobs<1>(F, J);
                { float* const PN = (float*)(act + A_PMAX) + (size_t)((l + 2) & 1) * PMAX_FLOATS;
                  conv_wo_max(F, INP(I_OWO) + (size_t)(li + 1) * 2 * DM * DM, PN + PM_WO); }
                const int tq = F.wave * 64 + lane_id_opaque();
                { const float* wsrc = INP(I_EWS) + (size_t)(li + 1) * 4 * 128 * 128;
                  for (int i = blockIdx.x * 512 + tq; i < 4 * 128 * 128; i += F.G * 512) { const int s = i & 127, t = (i >> 7) & 127; Wsb[i] = (bf16)f2bf(s <= t ? wsrc[i] : 0.f); } }
                }
            }
            SEAM(ph); ++ph;
        }
    }
#undef IN
#undef SEAM
#undef PH_LOCALS
#undef INP
#undef MOE_PTRS
#undef EVEN_PTRS
#undef ODD_PTRS
}

extern "C" void kernel_launch(void* const* d_in, const int* in_sizes, int n_in, void* d_out, int out_size, void* d_ws, size_t ws_size, hipStream_t stream) {
    static int grid = 0;
    if (grid == 0) {
        if (n_in != 31 || in_sizes[0] != M * DM || out_size != M * DM || ws_size < WS_END) { fprintf(stderr, "kernel_launch: unexpected shapes (n_in %d, in0 %d, out %d, ws %zu < %zu); nothing launched\n", n_in, n_in > 0 ? in_sizes[0] : -1, out_size, ws_size, (size_t)WS_END); grid = -1; return; }
        int dev = 0, cus = 0, per_cu = 0;
        if (hipGetDevice(&dev) != hipSuccess || hipDeviceGetAttribute(&cus, hipDeviceAttributeMultiprocessorCount, dev) != hipSuccess) { grid = -1; return; }
        if (hipFuncSetAttribute((const void*)mk_fwd, hipFuncAttributeMaxDynamicSharedMemorySize, LDS_BYTES) != hipSuccess) { fprintf(stderr, "kernel_launch: hipFuncSetAttribute failed\n"); grid = -1; return; }
        if (hipOccupancyMaxActiveBlocksPerMultiprocessor(&per_cu, (const void*)mk_fwd, NWAVES * 64, LDS_BYTES) != hipSuccess || per_cu < 1) { fprintf(stderr, "kernel_launch: occupancy query says %d workgroups per CU\n", per_cu); }
        (void)hipGetLastError();
        grid = cus;
        if (grid != 256) { fprintf(stderr, "kernel_launch: built for a 256-CU device, found %d CUs; nothing launched\n", cus); grid = -1; return; }
    }
    if (grid < 0) return;
    if (hipMemsetAsync((char*)d_ws + WS_CTL, 0, CTL_ZERO_BYTES, stream) != hipSuccess) return;
    Args a{};
    for (int i = 0; i < 31; ++i) a.in[i] = (const float*)d_in[i];
    a.out = (float*)d_out; a.ws = (unsigned char*)d_ws;
#if MK_ONE_LAUNCH
    a.ph_lo = 0; a.ph_hi = PH_TOTAL;
    hipLaunchKernelGGL(mk_fwd, dim3(grid), dim3(NWAVES * 64), LDS_BYTES, stream, a);
#else
#ifndef DUP_N_MASK
#define DUP_N_MASK 0
#endif
    for (int p = 0; p < PH_TOTAL; ++p) { const int q = p == 0 ? 0 : (p - 1) % (PH_EVEN + PH_ODD); const int n = p == 0 ? 0 : (q < PH_EVEN ? q + 1 : 10 + (q - PH_EVEN));
        const int reps = ((DUP_N_MASK >> n) & 1) ? 2 : 1;
        for (int r = 0; r < reps; ++r) { a.ph_lo = p; a.ph_hi = p + 1;
#ifdef DUP_VARIANT
            a.pad0 = (reps == 2 && r == 0) ? DUP_VARIANT : 0;
#endif
            hipLaunchKernelGGL(mk_fwd, dim3(grid), dim3(NWAVES * 64), LDS_BYTES, stream, a); } }
#endif
}
```

```cpp
#include <hip/hip_runtime.h>
#include <hip/hip_bf16.h>
#include <cstdio>
#include <cstdint>
#include <cmath>

#ifndef MK_ONE_LAUNCH
#define MK_ONE_LAUNCH 1
#endif

namespace pg8 {
#define PG8_LAS __attribute__((address_space(3)))
typedef unsigned short bf16_t;
typedef short bf16x8 __attribute__((ext_vector_type(8)));
typedef float f32x4 __attribute__((ext_vector_type(4)));
typedef float f32x2 __attribute__((ext_vector_type(2)));
typedef unsigned u32x4 __attribute__((ext_vector_type(4)));
typedef unsigned u32x2 __attribute__((ext_vector_type(2)));
typedef int v8i_t __attribute__((ext_vector_type(8)));
typedef int v4i_t __attribute__((ext_vector_type(4)));
constexpr int BM = 256, BK = 64, HALF = 128, HTB = HALF * BK * 2  , STAGE_BYTES = 8 * HTB, NXCD = 8, WGM = 8;

__host__ __device__ __forceinline__ int lds_byte(int r, int c) { const int st = (r >> 4) * 2 + (c >> 5), rr = r & 15, cc = c & 31, ob = rr * 64 + cc * 2; return st * 1024 + (ob ^ (((ob >> 9) & 1) << 5)); }
__host__ __device__ __forceinline__ void stage_rc(int b, int& R, int& C) { const int st = b / 1024, sb = b % 1024, swz = sb ^ (((sb >> 9) & 1) << 5); R = (st >> 1) * 16 + swz / 64; C = (st & 1) * 32 + (swz % 64) / 2; }
__host__ __device__ __forceinline__ int perm32(int rho) { const int n = rho >> 4, i = rho & 15; return 8 * (i >> 2) + 4 * n + (i & 3); }

struct Unit { int pm, pn, pb; };
struct Gemm { const bf16_t* A; const bf16_t* Bt; int M, N, K; };

struct StaticOrder {
    static constexpr bool GATHER = false;
    int nM, nN, nwg, G, c;
    __host__ __device__ void init(int M, int N, int G_, int c_) { nM = M / BM; nN = N / BM; nwg = nM * nN; G = G_; c = c_; }
    __host__ __device__ bool next(int i, Unit& u) const {
        const long L = (long)i * G + c; if (L >= nwg) return false;
        int wgid = (int)L; { const int q = nwg / NXCD, r = nwg % NXCD, xcd = wgid % NXCD, off = wgid / NXCD; wgid = (xcd < r ? xcd * (q + 1) : r * (q + 1) + (xcd - r) * q) + off; }
        const int nig = WGM * nN, gid = wgid / nig, fm = gid * WGM, gsz = (nM - fm) < WGM ? (nM - fm) : WGM;
        u.pm = fm + ((wgid % nig) % gsz); u.pn = (wgid % nig) / gsz; u.pb = u.pn; return true;
    }
    __device__ __forceinline__ unsigned a_row(const Unit& u, int r) const { return (unsigned)(u.pm * BM + r); }
};
struct PanelOrder {
    static constexpr bool GATHER = false;
    int nN, c;
    __device__ bool next(int i, Unit& u) const { if (i >= nN) return false; u.pm = c; u.pn = i; u.pb = i; return true; }
    __device__ __forceinline__ unsigned a_row(const Unit& u, int r) const { return (unsigned)(u.pm * BM + r); }
};
template <bool GATHER_> struct MoeOrder {
    static constexpr bool GATHER = GATHER_;
    int nM, nN, nwg, G, c; const int* tile_expert; const int* rowidx;
    __device__ void init(int nM_, int nN_, int G_, int c_, const int* te, const int* ri) { nM = nM_; nN = nN_; nwg = nM * nN; G = G_; c = c_; tile_expert = te; rowidx = ri; }
    __device__ bool next(int i, Unit& u) const {
        const long L = (long)i * G + c; if (L >= nwg) return false;
        int wgid = (int)L; { const int q = nwg / NXCD, r = nwg % NXCD, xcd = wgid % NXCD, off = wgid / NXCD; wgid = (xcd < r ? xcd * (q + 1) : r * (q + 1) + (xcd - r) * q) + off; }
        const int nig = WGM * nN, gid = wgid / nig, fm = gid * WGM, gsz = (nM - fm) < WGM ? (nM - fm) : WGM;
        u.pm = fm + ((wgid % nig) % gsz); u.pn = (wgid % nig) / gsz; u.pb = tile_expert[u.pm] * nN + u.pn; return true;
    }
    __device__ __forceinline__ unsigned a_row(const Unit& u, int r) const { return GATHER_ ? (unsigned)rowidx[u.pm * BM + r] : (unsigned)(u.pm * BM + r); }
};

__device__ __forceinline__ unsigned cvt_pk_bf16(float lo, float hi) { unsigned r; asm volatile("v_cvt_pk_bf16_f32 %0, %1, %2" : "=v"(r) : "v"(lo), "v"(hi)); return r; }
__device__ __forceinline__ f32x2 gelu_pk(f32x2 v) {
    const f32x2 av = __builtin_elementwise_abs(v), d = av * 0.2316418882f + 1.0f;
    f32x2 t; t.x = __builtin_amdgcn_rcpf(d.x); t.y = __builtin_amdgcn_rcpf(d.y);
    f32x2 q = t * 0.5307027145f + (-0.7265760135f); q = q * t + 0.7107068705f; q = q * t + (-0.142248368f); q = q * t + 0.127414796f; q = q * t;
    const f32x2 s = (v * v) * (-0.72134752044f);
    f32x2 e; e.x = __builtin_amdgcn_exp2f(s.x); e.y = __builtin_amdgcn_exp2f(s.y);
    const f32x2 m = v * (q * e), r = v - m;
    f32x2 o; o.x = v.x < 0.f ? m.x : r.x; o.y = v.y < 0.f ? m.y : r.y; return o;
}
__device__ __forceinline__ float silu_f(float v) { return v * __builtin_amdgcn_rcpf(1.0f + __builtin_amdgcn_exp2f(-1.4426950408889634f * v)); }


struct EpiRoute {
    static constexpr bool PERM = true, AFTER_DRAIN = false, LDS_SCALES = false;
    bf16_t* base[5]; int ldc[5]; int t0[5];
    int act[5];
    float scale[5]; int nseg;
    __device__ __forceinline__ void operator()(const f32x4 (&acc)[2][2][4][2], const Unit& u, int wr, int wc, int fr, int fq) const {
        bf16_t* O = base[0]; int ld = ldc[0], a = act[0], tt = t0[0]; float sc = scale[0];
#pragma unroll
        for (int k = 1; k < 5; ++k) if (k < nseg && u.pn >= t0[k]) { O = base[k]; ld = ldc[k]; a = act[k]; tt = t0[k]; sc = scale[k]; }
        const int row0 = u.pm * BM + wr * 64 + fr, col0 = (u.pn - tt) * BM + wc * 32 + 8 * fq;
#pragma unroll
        for (int ai = 0; ai < 2; ++ai)
#pragma unroll
            for (int m = 0; m < 4; ++m) { bf16_t* rowp = O + (size_t)(row0 + ai * HALF + m * 16) * ld + col0;
#pragma unroll
                for (int bj = 0; bj < 2; ++bj) { f32x4 v0 = acc[ai][bj][m][0], v1 = acc[ai][bj][m][1];
                    if (a == 1) { f32x2 p = gelu_pk((f32x2){v0[0], v0[1]}), q = gelu_pk((f32x2){v0[2], v0[3]}), r = gelu_pk((f32x2){v1[0], v1[1]}), t = gelu_pk((f32x2){v1[2], v1[3]});
                        v0 = (f32x4){p.x, p.y, q.x, q.y}; v1 = (f32x4){r.x, r.y, t.x, t.y}; }
                    else if (a == 2) {
#pragma unroll
                        for (int j = 0; j < 4; ++j) { v0[j] = silu_f(v0[j]); v1[j] = silu_f(v1[j]); } }
                    v0 = v0 * sc; v1 = v1 * sc; u32x4 w; w.x = cvt_pk_bf16(v0[0], v0[1]); w.y = cvt_pk_bf16(v0[2], v0[3]); w.z = cvt_pk_bf16(v1[0], v1[1]); w.w = cvt_pk_bf16(v1[2], v1[3]);
                    *(u32x4*)(rowp + bj * HALF) = w; } }
    }
};
struct EpiResF32 {
    static constexpr bool PERM = false, AFTER_DRAIN = false, LDS_SCALES = false;
    float* Y; const bf16_t* XB; int ldc; float alpha;
    __device__ __forceinline__ void operator()(const f32x4 (&acc)[2][2][4][2], const Unit& u, int wr, int wc, int fr, int fq) const {
        const int row0 = u.pm * BM + wr * 64 + fr, col0 = u.pn * BM + wc * 32 + 4 * fq;
#pragma unroll
        for (int ai = 0; ai < 2; ++ai)
#pragma unroll
            for (int m = 0; m < 4; ++m) { const size_t off = (size_t)(row0 + ai * HALF + m * 16) * ldc + col0;
#pragma unroll
                for (int bj = 0; bj < 2; ++bj)
#pragma unroll
                    for (int n = 0; n < 2; ++n) { const u32x2 xb = *(const u32x2*)(XB + off + bj * HALF + n * 16);
                        f32x4 r; r[0] = __uint_as_float(xb.x << 16); r[1] = __uint_as_float(xb.x & 0xffff0000u); r[2] = __uint_as_float(xb.y << 16); r[3] = __uint_as_float(xb.y & 0xffff0000u);
                        *(f32x4*)(Y + off + bj * HALF + n * 16) = r * alpha + acc[ai][bj][m][n]; } }
    }
};
struct EpiResFromF32 {
    static constexpr bool PERM = false, AFTER_DRAIN = false, LDS_SCALES = false;
    const float* XF; bf16_t* XB; int ldc; float alpha;
    __device__ __forceinline__ void operator()(const f32x4 (&acc)[2][2][4][2], const Unit& u, int wr, int wc, int fr, int fq) const {
        const int row0 = u.pm * BM + wr * 64 + fr, col0 = u.pn * BM + wc * 32 + 4 * fq;
#pragma unroll
        for (int ai = 0; ai < 2; ++ai)
#pragma unroll
            for (int m = 0; m < 4; ++m) { const size_t off = (size_t)(row0 + ai * HALF + m * 16) * ldc + col0;
#pragma unroll
                for (int bj = 0; bj < 2; ++bj)
#pragma unroll
                    for (int n = 0; n < 2; ++n) { f32x4 r = *(const f32x4*)(XF + off + bj * HALF + n * 16);
                        r = r * alpha + acc[ai][bj][m][n];
                        u32x2 w; w.x = cvt_pk_bf16(r[0], r[1]); w.y = cvt_pk_bf16(r[2], r[3]); *(u32x2*)(XB + off + bj * HALF + n * 16) = w; } }
    }
};
struct EpiResInplace {
    static constexpr bool PERM = true, AFTER_DRAIN = false, LDS_SCALES = false;
    bf16_t* XB; int ldc; float alpha; float inv;
    __device__ __forceinline__ void operator()(const f32x4 (&acc)[2][2][4][2], const Unit& u, int wr, int wc, int fr, int fq) const {
        const int row0 = u.pm * BM + wr * 64 + fr, col0 = u.pn * BM + wc * 32 + 8 * fq;
#pragma unroll
        for (int ai = 0; ai < 2; ++ai)
#pragma unroll
            for (int m = 0; m < 4; ++m) { const size_t off = (size_t)(row0 + ai * HALF + m * 16) * ldc + col0;
#pragma unroll
                for (int bj = 0; bj < 2; ++bj) { u32x4* p = (u32x4*)(XB + off + bj * HALF); const u32x4 xb = *p;
                    f32x4 r0, r1; r0[0] = __uint_as_float(xb.x << 16); r0[1] = __uint_as_float(xb.x & 0xffff0000u); r0[2] = __uint_as_float(xb.y << 16); r0[3] = __uint_as_float(xb.y & 0xffff0000u);
                    r1[0] = __uint_as_float(xb.z << 16); r1[1] = __uint_as_float(xb.z & 0xffff0000u); r1[2] = __uint_as_float(xb.w << 16); r1[3] = __uint_as_float(xb.w & 0xffff0000u);
                    r0 = r0 * alpha + acc[ai][bj][m][0] * inv; r1 = r1 * alpha + acc[ai][bj][m][1] * inv;
                    u32x4 w; w.x = cvt_pk_bf16(r0[0], r0[1]); w.y = cvt_pk_bf16(r0[2], r0[3]); w.z = cvt_pk_bf16(r1[0], r1[1]); w.w = cvt_pk_bf16(r1[2], r1[3]); *p = w; } }
    }
};
struct EpiSwiglu {
    static constexpr bool PERM = true, AFTER_DRAIN = false, LDS_SCALES = false;
    bf16_t* H; int ldc;
    __device__ __forceinline__ void operator()(const f32x4 (&acc)[2][2][4][2], const Unit& u, int wr, int wc, int fr, int fq) const {
        const int row0 = u.pm * BM + wr * 64 + fr, col0 = u.pn * HALF + wc * 32 + 8 * fq;
#pragma unroll
        for (int ai = 0; ai < 2; ++ai)
#pragma unroll
            for (int m = 0; m < 4; ++m) { bf16_t* rowp = H + (size_t)(row0 + ai * HALF + m * 16) * ldc + col0;
                f32x4 v0, v1;
#pragma unroll
                for (int j = 0; j < 4; ++j) { v0[j] = silu_f(acc[ai][0][m][0][j]) * acc[ai][1][m][0][j]; v1[j] = silu_f(acc[ai][0][m][1][j]) * acc[ai][1][m][1][j]; }
                u32x4 w; w.x = cvt_pk_bf16(v0[0], v0[1]); w.y = cvt_pk_bf16(v0[2], v0[3]); w.z = cvt_pk_bf16(v1[0], v1[1]); w.w = cvt_pk_bf16(v1[2], v1[3]);
                *(u32x4*)rowp = w; }
    }
};
struct EpiSwiglu8 {
    static constexpr bool PERM = true, AFTER_DRAIN = false, LDS_SCALES = false;
    unsigned char* H; int ldc; float inv;
    __device__ __forceinline__ void operator()(const f32x4 (&acc)[2][2][4][2], const Unit& u, int wr, int wc, int fr, int fq) const {
        const int row0 = u.pm * BM + wr * 64 + fr, col0 = u.pn * HALF + wc * 32 + 8 * fq;
#pragma unroll
        for (int ai = 0; ai < 2; ++ai)
#pragma unroll
            for (int m = 0; m < 4; ++m) { unsigned char* rowp = H + (size_t)(row0 + ai * HALF + m * 16) * ldc + col0;
                float v[8];
#pragma unroll
                for (int j = 0; j < 4; ++j) { v[j] = silu_f(acc[ai][0][m][0][j] * inv) * (acc[ai][1][m][0][j] * inv); v[4 + j] = silu_f(acc[ai][0][m][1][j] * inv) * (acc[ai][1][m][1][j] * inv); }
                int w0 = 0, w1 = 0;
                w0 = __builtin_amdgcn_cvt_pk_fp8_f32(v[0], v[1], w0, false); w0 = __builtin_amdgcn_cvt_pk_fp8_f32(v[2], v[3], w0, true);
                w1 = __builtin_amdgcn_cvt_pk_fp8_f32(v[4], v[5], w1, false); w1 = __builtin_amdgcn_cvt_pk_fp8_f32(v[6], v[7], w1, true);
                u32x2 w; w.x = (unsigned)w0; w.y = (unsigned)w1; *(u32x2*)rowp = w; }
    }
};
__device__ __forceinline__ f32x4 i2f4(const f32x4& a) { const v4i_t i = __builtin_bit_cast(v4i_t, a); return (f32x4){(float)i[0], (float)i[1], (float)i[2], (float)i[3]}; }
struct EpiResInplaceQ {
    static constexpr bool PERM = true, AFTER_DRAIN = false, LDS_SCALES = true;
    bf16_t* XB; int ldc; float alpha; const float* sa; const float* sw; PG8_LAS unsigned char* sbuf;
    __device__ __forceinline__ const float* row_src(const Unit& u) const { return sa + u.pm * BM; }
    __device__ __forceinline__ const float* col_src(const Unit& u) const { return sw + u.pb * BM; }
    __device__ __forceinline__ void operator()(const f32x4 (&acc)[2][2][4][2], const Unit& u, int wr, int wc, int fr, int fq) const {
        const int row0 = u.pm * BM + wr * 64 + fr, col0 = u.pn * BM + wc * 32 + 8 * fq;
        const PG8_LAS float* LR = (const PG8_LAS float*)sbuf + wr * 64 + fr; const PG8_LAS float* LC = (const PG8_LAS float*)(sbuf + 1024) + wc * 32 + 8 * fq;
        f32x4 cw[2][2];
#pragma unroll
        for (int bj = 0; bj < 2; ++bj)
#pragma unroll
            for (int n = 0; n < 2; ++n) cw[bj][n] = *(const PG8_LAS f32x4*)(LC + bj * HALF + 4 * n);
#pragma unroll
        for (int ai = 0; ai < 2; ++ai)
#pragma unroll
            for (int m = 0; m < 4; ++m) { const size_t off = (size_t)(row0 + ai * HALF + m * 16) * ldc + col0; const float rs = LR[ai * HALF + m * 16];
#pragma unroll
                for (int bj = 0; bj < 2; ++bj) { u32x4* p = (u32x4*)(XB + off + bj * HALF); const u32x4 xb = *p;
                    f32x4 r0, r1; r0[0] = __uint_as_float(xb.x << 16); r0[1] = __uint_as_float(xb.x & 0xffff0000u); r0[2] = __uint_as_float(xb.y << 16); r0[3] = __uint_as_float(xb.y & 0xffff0000u);
                    r1[0] = __uint_as_float(xb.z << 16); r1[1] = __uint_as_float(xb.z & 0xffff0000u); r1[2] = __uint_as_float(xb.w << 16); r1[3] = __uint_as_float(xb.w & 0xffff0000u);
                    r0 = r0 * alpha + i2f4(acc[ai][bj][m][0]) * rs * cw[bj][0]; r1 = r1 * alpha + i2f4(acc[ai][bj][m][1]) * rs * cw[bj][1];
                    u32x4 w; w.x = cvt_pk_bf16(r0[0], r0[1]); w.y = cvt_pk_bf16(r0[2], r0[3]); w.z = cvt_pk_bf16(r1[0], r1[1]); w.w = cvt_pk_bf16(r1[2], r1[3]); *p = w; } }
    }
};
struct EpiResFromF32Q {
    static constexpr bool PERM = true, AFTER_DRAIN = false, LDS_SCALES = true;
    const float* XF; bf16_t* XB; int ldc; float alpha; const float* sa; const float* sw; PG8_LAS unsigned char* sbuf;
    __device__ __forceinline__ const float* row_src(const Unit& u) const { return sa + u.pm * BM; }
    __device__ __forceinline__ const float* col_src(const Unit& u) const { return sw + u.pb * BM; }
    __device__ __forceinline__ void operator()(const f32x4 (&acc)[2][2][4][2], const Unit& u, int wr, int wc, int fr, int fq) const {
        const int row0 = u.pm * BM + wr * 64 + fr, col0 = u.pn * BM + wc * 32 + 8 * fq;
        const PG8_LAS float* LR = (const PG8_LAS float*)sbuf + wr * 64 + fr; const PG8_LAS float* LC = (const PG8_LAS float*)(sbuf + 1024) + wc * 32 + 8 * fq;
        f32x4 cw[2][2];
#pragma unroll
        for (int bj = 0; bj < 2; ++bj)
#pragma unroll
            for (int n = 0; n < 2; ++n) cw[bj][n] = *(const PG8_LAS f32x4*)(LC + bj * HALF + 4 * n);
#pragma unroll
        for (int ai = 0; ai < 2; ++ai)
#pragma unroll
            for (int m = 0; m < 4; ++m) { const size_t off = (size_t)(row0 + ai * HALF + m * 16) * ldc + col0; const float rs = LR[ai * HALF + m * 16];
#pragma unroll
                for (int bj = 0; bj < 2; ++bj) { f32x4 r0 = *(const f32x4*)(XF + off + bj * HALF), r1 = *(const f32x4*)(XF + off + bj * HALF + 4);
                    r0 = r0 * alpha + i2f4(acc[ai][bj][m][0]) * rs * cw[bj][0]; r1 = r1 * alpha + i2f4(acc[ai][bj][m][1]) * rs * cw[bj][1];
                    u32x4 w; w.x = cvt_pk_bf16(r0[0], r0[1]); w.y = cvt_pk_bf16(r0[2], r0[3]); w.z = cvt_pk_bf16(r1[0], r1[1]); w.w = cvt_pk_bf16(r1[2], r1[3]); *(u32x4*)(XB + off + bj * HALF) = w; } }
    }
};
struct EpiRouteQ {
    static constexpr bool PERM = true, AFTER_DRAIN = false, LDS_SCALES = true;
    bf16_t* base[5]; int ldc[5]; int t0[5]; int act[5]; float scale[5]; int nseg; const float* sa; const float* sw; PG8_LAS unsigned char* sbuf;
    __device__ __forceinline__ const float* row_src(const Unit& u) const { return sa + u.pm * BM; }
    __device__ __forceinline__ const float* col_src(const Unit& u) const { return sw + u.pb * BM; }
    __device__ __forceinline__ void operator()(const f32x4 (&acc)[2][2][4][2], const Unit& u, int wr, int wc, int fr, int fq) const {
        bf16_t* O = base[0]; int ld = ldc[0], a = act[0], tt = t0[0]; float sc = scale[0];
#pragma unroll
        for (int k = 1; k < 5; ++k) if (k < nseg && u.pn >= t0[k]) { O = base[k]; ld = ldc[k]; a = act[k]; tt = t0[k]; sc = scale[k]; }
        const int row0 = u.pm * BM + wr * 64 + fr, col0 = (u.pn - tt) * BM + wc * 32 + 8 * fq;
        const PG8_LAS float* LR = (const PG8_LAS float*)sbuf + wr * 64 + fr; const PG8_LAS float* LC = (const PG8_LAS float*)(sbuf + 1024) + wc * 32 + 8 * fq;
        f32x4 cw[2][2];
        const float csc = (a == 0) ? sc : 1.f;
#pragma unroll
        for (int bj = 0; bj < 2; ++bj)
#pragma unroll
            for (int n = 0; n < 2; ++n) cw[bj][n] = *(const PG8_LAS f32x4*)(LC + bj * HALF + 4 * n) * csc;
#pragma unroll
        for (int ai = 0; ai < 2; ++ai)
#pragma unroll
            for (int m = 0; m < 4; ++m) { const int row = row0 + ai * HALF + m * 16; const float rs = LR[ai * HALF + m * 16]; bf16_t* rowp = O + (size_t)row * ld + col0;
#pragma unroll
                for (int bj = 0; bj < 2; ++bj) { f32x4 v0 = i2f4(acc[ai][bj][m][0]) * rs * cw[bj][0], v1 = i2f4(acc[ai][bj][m][1]) * rs * cw[bj][1];
                    if (a == 1) { f32x2 p = gelu_pk((f32x2){v0[0], v0[1]}), q = gelu_pk((f32x2){v0[2], v0[3]}), r = gelu_pk((f32x2){v1[0], v1[1]}), t = gelu_pk((f32x2){v1[2], v1[3]});
                        v0 = (f32x4){p.x, p.y, q.x, q.y}; v1 = (f32x4){r.x, r.y, t.x, t.y}; }
                    else if (a == 2) {
#pragma unroll
                        for (int j = 0; j < 4; ++j) { v0[j] = silu_f(v0[j]); v1[j] = silu_f(v1[j]); } }
                    if (a != 0 && sc != 1.f) { v0 = v0 * sc; v1 = v1 * sc; } u32x4 w; w.x = cvt_pk_bf16(v0[0], v0[1]); w.y = cvt_pk_bf16(v0[2], v0[3]); w.z = cvt_pk_bf16(v1[0], v1[1]); w.w = cvt_pk_bf16(v1[2], v1[3]);
                    *(u32x4*)(rowp + bj * HALF) = w; } }
    }
};
template <bool OUT8> struct EpiSwigluQ {
    static constexpr bool PERM = true, AFTER_DRAIN = false, LDS_SCALES = true;
    void* H; int ldc; const float* sa; const float* sw; PG8_LAS unsigned char* sbuf;
    __device__ __forceinline__ const float* row_src(const Unit& u) const { return sa + u.pm * BM; }
    __device__ __forceinline__ const float* col_src(const Unit& u) const { return sw + u.pb * BM; }
    __device__ __forceinline__ void operator()(const f32x4 (&acc)[2][2][4][2], const Unit& u, int wr, int wc, int fr, int fq) const {
        const int row0 = u.pm * BM + wr * 64 + fr, col0 = u.pn * HALF + wc * 32 + 8 * fq;
        const PG8_LAS float* LR = (const PG8_LAS float*)sbuf + wr * 64 + fr; const PG8_LAS float* LC = (const PG8_LAS float*)(sbuf + 1024) + wc * 32 + 8 * fq;
        f32x4 cw[2][2], cwl[2];
#pragma unroll
        for (int bj = 0; bj < 2; ++bj)
#pragma unroll
            for (int n = 0; n < 2; ++n) cw[bj][n] = *(const PG8_LAS f32x4*)(LC + bj * HALF + 4 * n);
        cwl[0] = cw[0][0] * -1.4426950408889634f; cwl[1] = cw[0][1] * -1.4426950408889634f;
        const f32x4 cab[2] = {cw[0][0] * cw[1][0], cw[0][1] * cw[1][1]};
        unsigned char* const hb = (unsigned char*)H + ((size_t)(u.pm * (ldc / HALF) + u.pn) * 4 + wc) * 8192 + (wr * 64 + fr) * 32 + 8 * fq;
        (void)hb;
#pragma unroll
        for (int ai = 0; ai < 2; ++ai)
#pragma unroll
            for (int m = 0; m < 4; ++m) { const int row = row0 + ai * HALF + m * 16; const float rs = LR[ai * HALF + m * 16], rs2 = rs * rs;
                float v[8];
#pragma unroll
                for (int n = 0; n < 2; ++n) { const f32x4 fa = i2f4(acc[ai][0][m][n]), fb = i2f4(acc[ai][1][m][n]); const f32x4 t = (fa * cwl[n]) * rs, mm = ((fa * fb) * cab[n]) * rs2;
                    f32x4 e; e[0] = __builtin_amdgcn_exp2f(t[0]); e[1] = __builtin_amdgcn_exp2f(t[1]); e[2] = __builtin_amdgcn_exp2f(t[2]); e[3] = __builtin_amdgcn_exp2f(t[3]);
                    e = e + 1.0f; f32x4 r; r[0] = __builtin_amdgcn_rcpf(e[0]); r[1] = __builtin_amdgcn_rcpf(e[1]); r[2] = __builtin_amdgcn_rcpf(e[2]); r[3] = __builtin_amdgcn_rcpf(e[3]);
                    const f32x4 o = mm * r; v[4 * n] = o[0]; v[4 * n + 1] = o[1]; v[4 * n + 2] = o[2]; v[4 * n + 3] = o[3]; }
                if constexpr (OUT8) { int w0 = 0, w1 = 0;
                    w0 = __builtin_amdgcn_cvt_pk_fp8_f32(v[0], v[1], w0, false); w0 = __builtin_amdgcn_cvt_pk_fp8_f32(v[2], v[3], w0, true);
                    w1 = __builtin_amdgcn_cvt_pk_fp8_f32(v[4], v[5], w1, false); w1 = __builtin_amdgcn_cvt_pk_fp8_f32(v[6], v[7], w1, true);
                    u32x2 w; w.x = (unsigned)w0; w.y = (unsigned)w1;
                    *(u32x2*)(hb + ai * 4096 + m * 512) = w; }
                else { u32x4 w; w.x = cvt_pk_bf16(v[0], v[1]); w.y = cvt_pk_bf16(v[2], v[3]); w.z = cvt_pk_bf16(v[4], v[5]); w.w = cvt_pk_bf16(v[6], v[7]);
                    *(u32x4*)((bf16_t*)H + (size_t)row * ldc + col0) = w; } }
    }
};
struct EpiMoeDown {
    static constexpr bool PERM = true, AFTER_DRAIN = false, LDS_SCALES = true;
    bf16_t* O; int ldc; const float* gate; float inv; PG8_LAS unsigned char* sbuf;
    __device__ __forceinline__ const float* row_src(const Unit& u) const { return gate + u.pm * BM; }
    __device__ __forceinline__ const float* col_src(const Unit& u) const { return gate + u.pm * BM; }
    __device__ __forceinline__ void operator()(const f32x4 (&acc)[2][2][4][2], const Unit& u, int wr, int wc, int fr, int fq) const {
        const int row0 = u.pm * BM + wr * 64 + fr, col0 = u.pn * BM + wc * 32 + 8 * fq;
        const PG8_LAS float* LR = (const PG8_LAS float*)sbuf + wr * 64 + fr;
#pragma unroll
        for (int ai = 0; ai < 2; ++ai)
#pragma unroll
            for (int m = 0; m < 4; ++m) { const int row = row0 + ai * HALF + m * 16; const float gt = LR[ai * HALF + m * 16] * inv; bf16_t* rowp = O + (size_t)row * ldc + col0;
#pragma unroll
                for (int bj = 0; bj < 2; ++bj) { const f32x4 v0 = acc[ai][bj][m][0] * gt, v1 = acc[ai][bj][m][1] * gt;
                    u32x4 w; w.x = cvt_pk_bf16(v0[0], v0[1]); w.y = cvt_pk_bf16(v0[2], v0[3]); w.z = cvt_pk_bf16(v1[0], v1[1]); w.w = cvt_pk_bf16(v1[2], v1[3]);
                    *(u32x4*)(rowp + bj * HALF) = w; } }
    }
};

template <class Epi, class Sched, bool ALIGN_EPI = false, bool SP2 = false, int MODE = 0, bool AT = false>
__device__ __forceinline__ void gemm_phase(PG8_LAS unsigned char* lds, const Gemm g, const Sched& S, Epi& E, int wave_) {
    int tid_; { int l_; asm volatile("v_mbcnt_lo_u32_b32 %0, -1, 0\n\tv_mbcnt_hi_u32_b32 %0, -1, %0" : "=v"(l_)); tid_ = wave_ * 64 + l_; }
    constexpr bool GATHER = Sched::GATHER;
    const int tid = tid_, wid = __builtin_amdgcn_readfirstlane(wave_), lane = tid & 63, wr = wid >> 2, wc = wid & 3, fr = lane & 15, fq = lane >> 4;
    constexpr bool FP8 = (MODE == 1), I8 = (MODE == 2); constexpr int ES = MODE ? 1 : 2;
    const int K = g.K, nt = K * ES / (BK * 2);
    unsigned voffA[2], voffB[2]; int RA[2], CA[2];
#pragma unroll
    for (int i = 0; i < 2; ++i) { int R, C; stage_rc(tid * 16 + i * 8192, R, C); const int Rb = Epi::PERM ? ((R & ~31) + perm32(R & 31)) : R;
        RA[i] = R; CA[i] = C * 2; voffA[i] = AT ? (unsigned)(((C * 2) >> 5) * 8192 + R * 32 + ((C * 2) & 16)) : (unsigned)(R * K * ES + C * 2); voffB[i] = (unsigned)(Rb * K * ES + C * 2); }
    const unsigned K2 = (unsigned)(K * ES);
#define PG8_MKVA(dst, u) do { if constexpr (GATHER) { _Pragma("unroll") for (int _h = 0; _h < 2; ++_h) _Pragma("unroll") for (int _i = 0; _i < 2; ++_i) dst[_h][_i] = S.a_row(u, _h * HALF + RA[_i]) * K2 + (unsigned)CA[_i]; } } while (0)
#define PG8_ABASE(u) (GATHER ? (const char*)g.A : (const char*)g.A + (size_t)(u).pm * tstep)
    const size_t kstep = (size_t)(BK * 2);
    const size_t hstep = (size_t)HALF * K * ES;
    const size_t kstepA = AT ? (size_t)32768 : kstep, hstepA = AT ? (size_t)HALF * 32 : hstep;
    const size_t tstep = 2 * hstep;
    const unsigned ldsw = (unsigned)wid * 1024u;
    const int aoff = lds_byte(wr * 64 + fr, fq * 8), boff = lds_byte(wc * 32 + fr, fq * 8);
#define PG8_SA(b, h) (((b) * 2 + (h)) * HTB)
#define PG8_SB(b, h) ((4 + (b) * 2 + (h)) * HTB)
#define PG8_STAGE(bufoff, gbase, voff) do { _Pragma("unroll") for (int _i = 0; _i < 2; ++_i) \
        __builtin_amdgcn_global_load_lds((const unsigned*)((const char*)(gbase) + (voff)[_i]), (PG8_LAS unsigned*)(lds + (bufoff) + ldsw + _i * 8192), 16, 0, 0); } while (0)
#define PG8_STAGE_A(bufoff, gbase, VA, h) do { if constexpr (GATHER) { _Pragma("unroll") for (int _i = 0; _i < 2; ++_i) \
        __builtin_amdgcn_global_load_lds((const unsigned*)((const char*)(gbase) + (VA)[h][_i]), (PG8_LAS unsigned*)(lds + (bufoff) + ldsw + _i * 8192), 16, 0, 0); } \
        else { _Pragma("unroll") for (int _i = 0; _i < 2; ++_i) \
        __builtin_amdgcn_global_load_lds((const unsigned*)((const char*)(gbase) + (h) * hstepA + voffA[_i]), (PG8_LAS unsigned*)(lds + (bufoff) + ldsw + _i * 8192), 16, 0, 0); } } while (0)
#define PG8_LDA(dst, b, h) do { _Pragma("unroll") for (int m = 0; m < 4; ++m) _Pragma("unroll") for (int k = 0; k < 2; ++k) dst[m][k] = *(const PG8_LAS bf16x8*)(lds + PG8_SA(b, h) + aoff + m * 2048 + k * 1024); } while (0)
#define PG8_LDB(dst, b, h) do { _Pragma("unroll") for (int n = 0; n < 2; ++n) _Pragma("unroll") for (int k = 0; k < 2; ++k) dst[n][k] = *(const PG8_LAS bf16x8*)(lds + PG8_SB(b, h) + boff + n * 2048 + k * 1024); } while (0)
#define PG8_CAT(x) __builtin_bit_cast(v8i_t, __builtin_shufflevector(x[0], x[1], 0, 1, 2, 3, 4, 5, 6, 7, 8, 9, 10, 11, 12, 13, 14, 15))
#define PG8_MMA(ai, bj, At, Bt) do { __builtin_amdgcn_s_setprio(1); if constexpr (FP8) { _Pragma("unroll") for (int m = 0; m < 4; ++m) _Pragma("unroll") for (int n = 0; n < 2; ++n) \
        { const v8i_t a8_ = PG8_CAT(Bt[n]), b8_ = PG8_CAT(At[m]); asm volatile("v_mfma_f32_16x16x128_f8f6f4 %0, %1, %2, %0" : "+v"(acc[ai][bj][m][n]) : "v"(a8_), "v"(b8_)); } } \
        else if constexpr (I8) { _Pragma("unroll") for (int m = 0; m < 4; ++m) _Pragma("unroll") for (int n = 0; n < 2; ++n) _Pragma("unroll") for (int k = 0; k < 2; ++k) \
        acc[ai][bj][m][n] = __builtin_bit_cast(f32x4, __builtin_amdgcn_mfma_i32_16x16x64_i8(__builtin_bit_cast(v4i_t, Bt[n][k]), __builtin_bit_cast(v4i_t, At[m][k]), __builtin_bit_cast(v4i_t, acc[ai][bj][m][n]), 0, 0, 0)); } \
        else { _Pragma("unroll") for (int m = 0; m < 4; ++m) _Pragma("unroll") for (int n = 0; n < 2; ++n) _Pragma("unroll") for (int k = 0; k < 2; ++k) \
        acc[ai][bj][m][n] = __builtin_amdgcn_mfma_f32_16x16x32_bf16(Bt[n][k], At[m][k], acc[ai][bj][m][n], 0, 0, 0); } __builtin_amdgcn_s_setprio(0); } while (0)
#define PG8_WAIT_V(n) asm volatile("s_waitcnt vmcnt(" #n ")" ::: "memory")
#define PG8_WAIT_L(n) asm volatile("s_waitcnt lgkmcnt(" #n ")" ::: "memory")
#define PG8_BAR __builtin_amdgcn_s_barrier()
#define PG8_SCHED __builtin_amdgcn_sched_barrier(0)
    Unit cur, nxt; int ui = 0;
    if (!S.next(0, cur)) return;
    f32x4 acc[2][2][4][2];
#pragma unroll
    for (int a = 0; a < 2; ++a)
#pragma unroll
        for (int b = 0; b < 2; ++b)
#pragma unroll
            for (int m = 0; m < 4; ++m)
#pragma unroll
                for (int n = 0; n < 2; ++n) acc[a][b][m][n] = (f32x4){0.f, 0.f, 0.f, 0.f};
    bf16x8 At[4][2], B0[2][2], B1[2][2];
    const char* cA = PG8_ABASE(cur); const char* cB = (const char*)g.Bt + (size_t)cur.pb * tstep;
    unsigned va[2][2] = {{0u, 0u}, {0u, 0u}}, nva[2][2] = {{0u, 0u}, {0u, 0u}}; PG8_MKVA(va, cur);
#define PG8_SCALES(u, b) do { if constexpr (Epi::LDS_SCALES) { if (wid < 2) { const float* s_ = (wid == 0) ? E.row_src(u) : E.col_src(u); \
        __builtin_amdgcn_global_load_lds((const unsigned*)(s_ + lane * 4), (PG8_LAS unsigned*)(lds + STAGE_BYTES + (b) * 2048 + wid * 1024), 16, 0, 0); } } } while (0)
    PG8_SCALES(cur, 0);
    if constexpr (SP2) {
        PG8_STAGE(PG8_SB(0, 0), cB, voffB); PG8_STAGE(PG8_SB(0, 1), cB + hstep, voffB); PG8_STAGE_A(PG8_SA(0, 0), cA, va, 0); PG8_STAGE_A(PG8_SA(0, 1), cA, va, 1);
        if (wr == 1) PG8_BAR;
        PG8_WAIT_V(2); PG8_BAR;
        PG8_STAGE(PG8_SB(1, 0), cB + kstep, voffB); PG8_STAGE_A(PG8_SA(1, 0), cA + kstepA, va, 0); PG8_STAGE(PG8_SB(1, 1), cB + hstep + kstep, voffB);
        PG8_WAIT_V(6); PG8_BAR;
    } else {
        PG8_STAGE(PG8_SB(0, 0), cB, voffB); PG8_STAGE_A(PG8_SA(0, 0), cA, va, 0); PG8_STAGE(PG8_SB(0, 1), cB + hstep, voffB); PG8_STAGE_A(PG8_SA(0, 1), cA, va, 1);
        if (wr == 1) PG8_BAR;
        PG8_WAIT_V(4); PG8_BAR;
        PG8_STAGE(PG8_SB(1, 0), cB + kstep, voffB); PG8_STAGE_A(PG8_SA(1, 0), cA + kstepA, va, 0); PG8_STAGE(PG8_SB(1, 1), cB + hstep + kstep, voffB);
        PG8_WAIT_V(6); PG8_BAR;
    }
    for (;;) {
        const bool has_next = S.next(ui + 1, nxt);
        const char* nA = has_next ? PG8_ABASE(nxt) : cA; const char* nB = has_next ? (const char*)g.Bt + (size_t)nxt.pb * tstep : cB;
        if (has_next) PG8_SCALES(nxt, (ui + 1) % 3);
        if constexpr (GATHER) { if (has_next) PG8_MKVA(nva, nxt); else { _Pragma("unroll") for (int _h = 0; _h < 2; ++_h) _Pragma("unroll") for (int _i = 0; _i < 2; ++_i) nva[_h][_i] = va[_h][_i]; } }
#pragma unroll 1
        for (int t = 0; t < nt; t += 2) {
            const bool last = (t == nt - 2);
            const char* a1 = cA + (size_t)(t + 1) * kstepA;
            const char* a2 = last ? nA : cA + (size_t)(t + 2) * kstepA; const char* b2 = last ? nB : cB + (size_t)(t + 2) * kstep;
            const char* a3 = a2 + kstepA; const char* b3 = b2 + kstep;
            unsigned o2[2][2] = {{0u, 0u}, {0u, 0u}};
            if constexpr (GATHER) {
#pragma unroll
                for (int _h = 0; _h < 2; ++_h)
#pragma unroll
                    for (int _i = 0; _i < 2; ++_i) o2[_h][_i] = last ? nva[_h][_i] : va[_h][_i]; }
            if constexpr (SP2) {
            PG8_LDB(B0, 0, 0); PG8_LDB(B1, 0, 1); PG8_SCHED; PG8_LDA(At, 0, 0); PG8_STAGE_A(PG8_SA(1, 1), a1, va, 1);
            PG8_WAIT_V(8); PG8_WAIT_L(0); PG8_BAR; PG8_MMA(0, 0, At, B0); PG8_MMA(0, 1, At, B1); PG8_BAR; PG8_SCHED;
            PG8_LDA(At, 0, 1); PG8_STAGE(PG8_SB(0, 0), b2, voffB); PG8_STAGE(PG8_SB(0, 1), b2 + hstep, voffB); PG8_STAGE_A(PG8_SA(0, 0), a2, o2, 0);
            PG8_WAIT_V(8); PG8_WAIT_L(0); PG8_BAR; PG8_MMA(1, 0, At, B0); PG8_MMA(1, 1, At, B1); PG8_BAR; PG8_SCHED;
            PG8_LDB(B0, 1, 0); PG8_LDB(B1, 1, 1); PG8_SCHED; PG8_LDA(At, 1, 0); PG8_STAGE_A(PG8_SA(0, 1), a2, o2, 1);
            PG8_WAIT_V(8); PG8_WAIT_L(0); PG8_BAR; PG8_MMA(0, 0, At, B0); PG8_MMA(0, 1, At, B1); PG8_BAR; PG8_SCHED;
            PG8_LDA(At, 1, 1); PG8_STAGE(PG8_SB(1, 0), b3, voffB); PG8_STAGE(PG8_SB(1, 1), b3 + hstep, voffB); PG8_STAGE_A(PG8_SA(1, 0), a3, o2, 0);
            PG8_WAIT_V(8); PG8_WAIT_L(0); PG8_BAR; PG8_MMA(1, 0, At, B0); PG8_MMA(1, 1, At, B1); PG8_BAR; PG8_SCHED;
            } else {
            PG8_LDB(B0, 0, 0); PG8_SCHED; PG8_LDA(At, 0, 0); PG8_STAGE_A(PG8_SA(1, 1), a1, va, 1);
            PG8_WAIT_L(8); PG8_BAR; PG8_WAIT_L(0); PG8_MMA(0, 0, At, B0); PG8_BAR; PG8_SCHED;
            PG8_LDB(B1, 0, 1); PG8_STAGE(PG8_SB(0, 0), b2, voffB);
            PG8_BAR; PG8_WAIT_L(0); PG8_MMA(0, 1, At, B1); PG8_BAR;
            PG8_LDA(At, 0, 1); PG8_STAGE_A(PG8_SA(0, 0), a2, o2, 0);
            PG8_BAR; PG8_WAIT_L(0); PG8_MMA(1, 0, At, B0); PG8_BAR; PG8_SCHED;
            PG8_STAGE(PG8_SB(0, 1), b2 + hstep, voffB);
            PG8_WAIT_V(6); PG8_BAR; PG8_MMA(1, 1, At, B1); PG8_BAR;
            PG8_LDB(B0, 1, 0); PG8_SCHED; PG8_LDA(At, 1, 0); PG8_STAGE_A(PG8_SA(0, 1), a2, o2, 1);
            PG8_WAIT_L(8); PG8_BAR; PG8_WAIT_L(0); PG8_MMA(0, 0, At, B0); PG8_BAR; PG8_SCHED;
            PG8_LDB(B1, 1, 1); PG8_STAGE(PG8_SB(1, 0), b3, voffB);
            PG8_BAR; PG8_WAIT_L(0); PG8_MMA(0, 1, At, B1); PG8_BAR;
            PG8_LDA(At, 1, 1); PG8_STAGE_A(PG8_SA(1, 0), a3, o2, 0);
            PG8_BAR; PG8_WAIT_L(0); PG8_MMA(1, 0, At, B0); PG8_BAR; PG8_SCHED;
            PG8_STAGE(PG8_SB(1, 1), b3 + hstep, voffB);
            PG8_WAIT_V(6); PG8_BAR; PG8_MMA(1, 1, At, B1); PG8_BAR;
            }
        }
        if constexpr (ALIGN_EPI) { if (wr == 0) PG8_BAR; }
        if constexpr (FP8) asm volatile("s_nop 15\n\ts_nop 7" ::: "memory");
        if constexpr (Epi::LDS_SCALES) E.sbuf = lds + STAGE_BYTES + (ui % 3) * 2048;
        E(acc, cur, wr, wc, fr, fq);
        if (!has_next) break;
#pragma unroll
        for (int a = 0; a < 2; ++a)
#pragma unroll
            for (int b = 0; b < 2; ++b)
#pragma unroll
                for (int m = 0; m < 4; ++m)
#pragma unroll
                    for (int n = 0; n < 2; ++n) acc[a][b][m][n] = (f32x4){0.f, 0.f, 0.f, 0.f};
        cur = nxt; cA = nA; cB = nB; ++ui;
        if constexpr (GATHER) {
#pragma unroll
            for (int _h = 0; _h < 2; ++_h)
#pragma unroll
                for (int _i = 0; _i < 2; ++_i) va[_h][_i] = nva[_h][_i]; }
        if constexpr (ALIGN_EPI) { if (wr == 1) PG8_BAR; }
    }
    PG8_WAIT_V(0);
    if constexpr (!ALIGN_EPI) { if (wr == 0) PG8_BAR; }
    PG8_BAR;
#undef PG8_SA
#undef PG8_SB
#undef PG8_STAGE
#undef PG8_STAGE_A
#undef PG8_MKVA
#undef PG8_ABASE
#undef PG8_LDA
#undef PG8_LDB
#undef PG8_MMA
#undef PG8_SCALES
#undef PG8_CAT
#undef PG8_WAIT_V
#undef PG8_WAIT_L
#undef PG8_BAR
#undef PG8_SCHED
}
}

#include <hip/hip_bf16.h>
#include <cmath>
namespace attn_body {
using bf16=__hip_bfloat16;
using bf16x8=__attribute__((ext_vector_type(8)))short;
using s16x4=__attribute__((ext_vector_type(4)))short;
using f32x16=__attribute__((ext_vector_type(16)))float;
using u32x4=__attribute__((ext_vector_type(4)))unsigned;
constexpr int SEQ=4096,D=64,DM=512;
constexpr int NW=8,QBLK=32,QB=QBLK*NW,KVBLK=64,NQB=SEQ/QB;
constexpr int ATTN_PITCH=DM, ATTN_UNIT_ROWS=QB;
__device__ __forceinline__ int crow(int r,int hi){return (r&3)+8*(r>>2)+4*hi;}
#define SBAR() __builtin_amdgcn_sched_barrier(0)
__device__ __forceinline__ void cmask(f32x16&p0,f32x16&p1,int jb,int qrel,int hi){
  const float NEG=-INFINITY; int kb=64*jb+4*hi;
  #pragma unroll
  for(int r=0;r<16;++r){int kv=kb+(r&3)+8*(r>>2); if(kv>qrel)p0[r]=NEG; if(kv+32>qrel)p1[r]=NEG;}
}

constexpr int NSLOT=3, SLOTB=8192;
constexpr int LDS_K=0, LDS_V=NSLOT*SLOTB, LDS_WS=3*NSLOT*SLOTB, LDS_OST=LDS_WS+NW*64*4, LDS_BYTES=LDS_OST+NW*8192;
constexpr float C2=0.125f*1.4426950408889634f;
__device__ __forceinline__ void glds16(const void*gsrc,unsigned lds_dst){unsigned keep;
  asm volatile("s_mov_b32 %0, m0\n\ts_mov_b32 m0, %2\n\ts_nop 0\n\tglobal_load_lds_dwordx4 %1, off\n\ts_mov_b32 m0, %0":"=&s"(keep):"v"(gsrc),"s"(lds_dst):"memory");}
__device__ __forceinline__ void glds16s(unsigned voff,const void*sbase,unsigned lds_dst){unsigned keep;
  const unsigned long long b=(unsigned long long)sbase; const unsigned blo=__builtin_amdgcn_readfirstlane((unsigned)b),bhi=__builtin_amdgcn_readfirstlane((unsigned)(b>>32));
  const unsigned long long sb=((unsigned long long)bhi<<32)|blo;
  asm volatile("s_mov_b32 %0, m0\n\ts_mov_b32 m0, %2\n\ts_nop 4\n\tglobal_load_lds_dwordx4 %1, %3\n\ts_mov_b32 m0, %0":"=&s"(keep):"v"(voff),"s"(lds_dst),"s"(sb):"memory");}
__device__ __forceinline__ float max3f(float a,float b,float c){float r;asm("v_max3_f32 %0, %1, %2, %3":"=v"(r):"v"(a),"v"(b),"v"(c));return r;}
__device__ __forceinline__ float max2f(float a,float b){float r;asm("v_max_f32_e32 %0, %1, %2":"=v"(r):"v"(a),"v"(b));return r;}
__device__ __forceinline__ float fadd_s(float a,float b){float r;asm("v_add_f32_e32 %0, %1, %2":"=v"(r):"v"(a),"v"(b));return r;}
__device__ __forceinline__ float fsub_s(float a,float b){float r;asm("v_sub_f32_e32 %0, %1, %2":"=v"(r):"v"(a),"v"(b));return r;}
typedef float f32x2_t __attribute__((ext_vector_type(2))); typedef __bf16 bf16x2_t __attribute__((ext_vector_type(2)));
__device__ __forceinline__ unsigned cvtpk_s(float lo,float hi){f32x2_t v={lo,hi};bf16x2_t b=__builtin_convertvector(v,bf16x2_t);return __builtin_bit_cast(unsigned,b);}
#define WAIT_BAR(N) asm volatile("s_waitcnt vmcnt(" #N ") lgkmcnt(0)\n\ts_barrier":::"memory")

__device__ __forceinline__ void qkt(f32x16&p0,f32x16&p1,const char*Kslot,const bf16x8*qr,const f32x16&c0,const f32x16&c1,int r32,int hi){
  const char*kb=Kslot+hi*1024+r32*16;
  #pragma unroll
  for(int d0=0;d0<4;++d0){
    const bf16x8 b0=*reinterpret_cast<const bf16x8*>(kb+d0*2048);
    const bf16x8 b1=*reinterpret_cast<const bf16x8*>(kb+d0*2048+512);
    if(d0==0){p0=__builtin_amdgcn_mfma_f32_32x32x16_bf16(b0,qr[0],c0,0,0,0);p1=__builtin_amdgcn_mfma_f32_32x32x16_bf16(b1,qr[0],c1,0,0,0);}
    else{p0=__builtin_amdgcn_mfma_f32_32x32x16_bf16(b0,qr[d0],p0,0,0,0);p1=__builtin_amdgcn_mfma_f32_32x32x16_bf16(b1,qr[d0],p1,0,0,0);}}
}
typedef __attribute__((address_space(3))) const char* lds_cptr;
typedef short v4i16_t __attribute__((ext_vector_type(4)));
__device__ __forceinline__ void kload8(bf16x8*kf,lds_cptr kp){
  kf[0]=*(const __attribute__((address_space(3))) bf16x8*)(kp);      kf[1]=*(const __attribute__((address_space(3))) bf16x8*)(kp+512);
  kf[2]=*(const __attribute__((address_space(3))) bf16x8*)(kp+2048); kf[3]=*(const __attribute__((address_space(3))) bf16x8*)(kp+2560);
  kf[4]=*(const __attribute__((address_space(3))) bf16x8*)(kp+4096); kf[5]=*(const __attribute__((address_space(3))) bf16x8*)(kp+4608);
  kf[6]=*(const __attribute__((address_space(3))) bf16x8*)(kp+6144); kf[7]=*(const __attribute__((address_space(3))) bf16x8*)(kp+6656);
}
__device__ __forceinline__ void kload2(bf16x8*kf,lds_cptr kp,int j){ kf[2*j]=*(const __attribute__((address_space(3))) bf16x8*)(kp+j*2048); kf[2*j+1]=*(const __attribute__((address_space(3))) bf16x8*)(kp+j*2048+512); }
__device__ __forceinline__ s16x4 vtr(lds_cptr p){ return __builtin_bit_cast(s16x4,__builtin_amdgcn_ds_read_tr16_b64_v4i16((__attribute__((address_space(3))) v4i16_t*)p)); }
__device__ __forceinline__ float rowmax(const f32x16&p0,const f32x16&p1){
  float a=max3f(p0[0],p0[1],p1[0]),b=max3f(p0[2],p0[3],p1[1]);a=max3f(a,p1[2],p1[3]);
  #pragma unroll
  for(int r=4;r<16;r+=4){a=max3f(a,p0[r],p0[r+1]);b=max3f(b,p0[r+2],p0[r+3]);a=max3f(a,p1[r],p1[r+1]);b=max3f(b,p1[r+2],p1[r+3]);}
  const float m=max2f(a,b);
  auto rr=__builtin_amdgcn_permlane32_swap(__float_as_uint(m),__float_as_uint(m),false,false);
  return max2f(__uint_as_float(rr[0]),__uint_as_float(rr[1]));
}
__device__ __forceinline__ void pv(f32x16*o,int vb,bf16x8 pa0,bf16x8 pa1,bf16x8 pa2,bf16x8 pa3){
  #pragma unroll
  for(int d0=0;d0<4;++d0){s16x4 lo[4],hi[4];
    #pragma unroll
    for(int ks=0;ks<4;++ks){
      asm volatile("ds_read_b64_tr_b16 %0,%1 offset:%c2":"=&v"(lo[ks]):"v"(vb),"i"(d0*4096+ks*1024):"memory");
      asm volatile("ds_read_b64_tr_b16 %0,%1 offset:%c2":"=&v"(hi[ks]):"v"(vb),"i"(d0*4096+ks*1024+512):"memory");}
    asm volatile("s_waitcnt lgkmcnt(0)":::"memory");SBAR();
    #define PK(k) (bf16x8){lo[k][0],lo[k][1],lo[k][2],lo[k][3],hi[k][0],hi[k][1],hi[k][2],hi[k][3]}
    o[d0]=__builtin_amdgcn_mfma_f32_32x32x16_bf16(pa0,PK(0),o[d0],0,0,0);
    o[d0]=__builtin_amdgcn_mfma_f32_32x32x16_bf16(pa1,PK(1),o[d0],0,0,0);
    o[d0]=__builtin_amdgcn_mfma_f32_32x32x16_bf16(pa2,PK(2),o[d0],0,0,0);
    o[d0]=__builtin_amdgcn_mfma_f32_32x32x16_bf16(pa3,PK(3),o[d0],0,0,0);
    #undef PK
  }
}

#ifndef ATTN_STORE16
#define ATTN_STORE16(p,v) (*(u32x4*)(p)=(v))
#endif
template<int THRL> __device__ __forceinline__ void attn_unit(int b,int hq,int hv  ,float sl2,int qb,const bf16*Q,const bf16*__restrict__ K,const bf16*__restrict__ V,bf16*O,char*shm,int wave_){
  int lane_; asm volatile("v_mbcnt_lo_u32_b32 %0, -1, 0\n\tv_mbcnt_hi_u32_b32 %0, -1, %0":"=v"(lane_)); const int wid=__builtin_amdgcn_readfirstlane(wave_),lane=lane_,r32=lane&31,hi=lane>>5;
  const long rowbase=(long)b*SEQ; const int q0=qb*QB;
  const bf16*Qw=Q+(rowbase+q0+wid*QBLK)*DM+hq*D;
  const bf16*Kh=K+rowbase*DM+hq*D,*Vh=V+rowbase*DM+hv*(2*D);
  const unsigned lds0=(unsigned)(uintptr_t)shm;
  float*wsf=(float*)(shm+LDS_WS)+wid*64;
  const unsigned koff=(unsigned)(lane*DM+wid*8)*2u;
  const unsigned voff=(unsigned)((16*(wid&3)+(lane>>2))*DM+(wid>>2)*32+(lane&3)*8)*2u;
  const unsigned kdst=lds0+LDS_K+wid*1024, vdst=lds0+LDS_V+wid*1024;
  #define DMA_K(t,slot) glds16s(koff,Kh+(long)(t)*KVBLK*DM,(unsigned)__builtin_amdgcn_readfirstlane(kdst+(slot)))
  #define DMA_V(t,slot) do{ glds16s(voff,Vh+(long)(t)*KVBLK*DM,(unsigned)__builtin_amdgcn_readfirstlane(vdst+2*(slot))); glds16s(voff,Vh+64+(long)(t)*KVBLK*DM,(unsigned)__builtin_amdgcn_readfirstlane(vdst+2*(slot)+8192)); }while(0)
  const char*Kbase=shm+LDS_K; bf16x8 kf[8];
  const lds_cptr shm3=(lds_cptr)shm; const lds_cptr kp0=shm3+LDS_K+hi*1024+r32*16; const lds_cptr vp0=shm3+LDS_V+((lane>>4)&1)*32+(lane&3)*8+(4*hi+((lane&15)>>2))*64;
  const int NT=(q0+QB)/KVBLK;
  DMA_K(0,0);DMA_V(0,0);DMA_K(1,SLOTB);
  bf16x8 qr[4];
  #pragma unroll
  for(int d0=0;d0<4;++d0)qr[d0]=*reinterpret_cast<const bf16x8*>(&Qw[(long)r32*DM+d0*16+hi*8]);
  float l_reg=0.f;f32x16 o[4];o[0]=f32x16{};o[1]=f32x16{};o[2]=f32x16{};o[3]=f32x16{};
  const int qrel=wid*QBLK+r32;
  float nb=sl2*(float)(4*hi-(q0+qrel));
  #define MKC0(C0) do{ _Pragma("unroll") for(int r=0;r<16;++r)C0[r]=__builtin_fmaf(sl2,(float)((r&3)+8*(r>>2)),nb); }while(0)
  #define MKC1(C1) do{ _Pragma("unroll") for(int r=0;r<16;++r)C1[r]=__builtin_fmaf(sl2,(float)((r&3)+8*(r>>2)+32),nb); }while(0)
  #define CMASK(P0,P1,t) do{int jb_=(t)-(NT-4); if(jb_>=0)cmask(P0,P1,jb_,qrel,hi);}while(0)
  bool resc=false;
  #define START(P0,P1) do{ const float rm=rowmax(P0,P1); resc=false; \
    { const float dl=rm; nb=fsub_s(nb,dl); \
      _Pragma("unroll") for(int r=0;r<16;++r){P0[r]=fsub_s(P0[r],dl);P1[r]=fsub_s(P1[r],dl);} } \
    _Pragma("unroll") for(int r=0;r<16;++r)P0[r]=__builtin_amdgcn_exp2f(P0[r]); }while(0)
  #define RESC() do{ if(resc){ asm volatile("s_waitcnt lgkmcnt(0)":::"memory"); \
      _Pragma("unroll") for(int d_=0;d_<4;++d_) _Pragma("unroll") for(int r=0;r<16;++r)o[d_][r]*=wsf[crow(r,hi)]; } }while(0)
  f32x16 pA0,pA1,pB0,pB1;
  int sl_prev=0,sl_cur=0,sl_next=SLOTB;
  #define ROT() do{sl_prev=sl_cur;sl_cur=sl_next;sl_next=(sl_next==(NSLOT-1)*SLOTB)?0:sl_next+SLOTB;}while(0)
  DMA_K(2,2*SLOTB);
  WAIT_BAR(4);
  { f32x16 ci0,ci1; MKC0(ci0); MKC1(ci1); qkt(pA0,pA1,Kbase,qr,ci0,ci1,r32,hi); } asm volatile("s_nop 15\n\ts_nop 7":"+v"(pA0),"+v"(pA1));CMASK(pA0,pA1,0);
  START(pA0,pA1);
  _Pragma("unroll") for(int r=0;r<16;++r)pA1[r]=__builtin_amdgcn_exp2f(pA1[r]);
  WAIT_BAR(0);
  DMA_K(3,0);DMA_V(1,SLOTB);
  ROT();
  kload8(kf,kp0+sl_cur);
  WAIT_BAR(3);
  s16x4 vlo[8],vhi[8]; u32x4 pw0,pw1,pw2,pw3;
  #define PKW(P,B) cvtpk_s(P[B],P[B+1])
  #define PAF(k) __builtin_bit_cast(bf16x8,pw##k)
  #define VFR(i) (bf16x8){vlo[i][0],vlo[i][1],vlo[i][2],vlo[i][3],vhi[i][0],vhi[i][1],vhi[i][2],vhi[i][3]}
  #define PIN(x) asm volatile("":"+v"(x))
  #define MX3(a,b,c) __builtin_fmaxf(__builtin_fmaxf((a),(b)),(c))
  #define GAPA(MF,A0,A1,A2,A3,W0,W1,PW) do{ MF; sacc+=A0; sacc+=A1; sacc+=A2; sacc+=A3; PIN(sacc); W0; W1; PIN(PW); SBAR(); }while(0)
  #define EX(v) __builtin_amdgcn_exp2f(v)
  #define GAPB(MF,X,B) do{ MF; X[B]=EX(X[B]); X[B+1]=EX(X[B+1]); PIN(X); SBAR(); }while(0)
  #define VRD2(i) do{ vlo[i]=vtr(vp_+((((i)>>2)+2)*4096+((i)&3)*1024)); vhi[i]=vtr(vp_+((((i)>>2)+2)*4096+((i)&3)*1024+512)); }while(0)
  #define VRD(i) do{ vlo[i]=vtr(vp_+(((i)>>2)*4096+((i)&3)*1024)); vhi[i]=vtr(vp_+(((i)>>2)*4096+((i)&3)*1024+512)); }while(0)
  #define KRD(G,j) do{ if(G){ kload2(kf,kp0+sl_next,j); SBAR(); } }while(0)
  #define STEP(C0,C1,P0,P1,t,GK,GV,GL) do{ SBAR(); \
    nb=__builtin_fmaf(sl2,64.f,nb); MKC0(C0); PIN(C0); SBAR(); \
    const lds_cptr vp_=vp0+2*sl_prev; \
    VRD(0); SBAR(); float sacc=(P0[0]+P0[1]); \
    GAPA(C0=__builtin_amdgcn_mfma_f32_32x32x16_bf16(kf[0],qr[0],C0,0,0,0), P0[2],P0[3],P0[4],P0[5],     pw0[0]=PKW(P0,0), pw0[1]=PKW(P0,2), pw0); \
    MKC1(C1); PIN(C1); VRD(4); SBAR(); GAPA(C1=__builtin_amdgcn_mfma_f32_32x32x16_bf16(kf[1],qr[0],C1,0,0,0), P0[6],P0[7],P0[8],P0[9],     pw0[2]=PKW(P0,4), pw0[3]=PKW(P0,6), pw0); \
    VRD(1); SBAR(); GAPA(C0=__builtin_amdgcn_mfma_f32_32x32x16_bf16(kf[2],qr[1],C0,0,0,0),   P0[10],P0[11],P0[12],P0[13], pw1[0]=PKW(P0,8), pw1[1]=PKW(P0,10), pw1); \
    VRD(5); SBAR(); GAPA(C1=__builtin_amdgcn_mfma_f32_32x32x16_bf16(kf[3],qr[1],C1,0,0,0),   P0[14],P0[15],P1[0],P1[1],   pw1[2]=PKW(P0,12),pw1[3]=PKW(P0,14), pw1); \
    VRD(2); SBAR(); GAPA(C0=__builtin_amdgcn_mfma_f32_32x32x16_bf16(kf[4],qr[2],C0,0,0,0),   P1[2],P1[3],P1[4],P1[5],     pw2[0]=PKW(P1,0), pw2[1]=PKW(P1,2), pw2); \
    VRD(6); SBAR(); GAPA(C1=__builtin_amdgcn_mfma_f32_32x32x16_bf16(kf[5],qr[2],C1,0,0,0),   P1[6],P1[7],P1[8],P1[9],     pw2[2]=PKW(P1,4), pw2[3]=PKW(P1,6), pw2); \
    VRD(3); SBAR(); GAPA(C0=__builtin_amdgcn_mfma_f32_32x32x16_bf16(kf[6],qr[3],C0,0,0,0),   P1[10],P1[11],P1[12],P1[13], pw3[0]=PKW(P1,8), pw3[1]=PKW(P1,10), pw3); \
    VRD(7); SBAR(); GAPA(C1=__builtin_amdgcn_mfma_f32_32x32x16_bf16(kf[7],qr[3],C1,0,0,0),   P1[14],P1[15],0.f,0.f,       pw3[2]=PKW(P1,12),pw3[3]=PKW(P1,14), pw3); \
    l_reg+=sacc; \
    if(GK){DMA_K((t)+3,sl_cur);} if(GV){DMA_V((t)+1,sl_next);} \
    CMASK(C0,C1,t); \
    { float a=MX3(C0[0],C0[1],C1[0]),b=MX3(C0[2],C0[3],C1[1]); a=MX3(a,C1[2],C1[3]); \
      _Pragma("unroll") for(int r=4;r<16;r+=4){a=MX3(a,C0[r],C0[r+1]);b=MX3(b,C0[r+2],C0[r+3]);a=MX3(a,C1[r],C1[r+1]);b=MX3(b,C1[r+2],C1[r+3]);} \
      float rm=__builtin_fmaxf(a,b); { auto rr=__builtin_amdgcn_permlane32_swap(__float_as_uint(rm),__float_as_uint(rm),false,false); rm=__builtin_fmaxf(__uint_as_float(rr[0]),__uint_as_float(rr[1])); } \
      resc=false; \
      if(__builtin_expect(__any(rm>(float)THRL),0)){ const float dl=__builtin_fmaxf(rm,0.f); nb-=dl; \
        _Pragma("unroll") for(int r=0;r<16;++r){C0[r]-=dl;C1[r]-=dl;} \
        const float f=__builtin_amdgcn_exp2f(-dl); l_reg*=f; { int l_=lane; asm volatile("":"+v"(l_)); if(l_<32)wsf[l_]=f; } resc=true; } } \
    SBAR(); \
    GAPB(o[0]=__builtin_amdgcn_mfma_f32_32x32x16_bf16(PAF(0),VFR(0),o[0],0,0,0); VRD2(0), C0,0); \
    GAPB(o[1]=__builtin_amdgcn_mfma_f32_32x32x16_bf16(PAF(0),VFR(4),o[1],0,0,0); VRD2(4), C0,2); \
    KRD(GL,0); GAPB(o[0]=__builtin_amdgcn_mfma_f32_32x32x16_bf16(PAF(1),VFR(1),o[0],0,0,0); VRD2(1), C0,4); \
    KRD(GL,1); GAPB(o[1]=__builtin_amdgcn_mfma_f32_32x32x16_bf16(PAF(1),VFR(5),o[1],0,0,0); VRD2(5), C0,6); \
    KRD(GL,2); GAPB(o[0]=__builtin_amdgcn_mfma_f32_32x32x16_bf16(PAF(2),VFR(2),o[0],0,0,0); VRD2(2), C0,8); \
    KRD(GL,3); GAPB(o[1]=__builtin_amdgcn_mfma_f32_32x32x16_bf16(PAF(2),VFR(6),o[1],0,0,0); VRD2(6), C0,10); \
    GAPB(o[0]=__builtin_amdgcn_mfma_f32_32x32x16_bf16(PAF(3),VFR(3),o[0],0,0,0); VRD2(3), C0,12); \
    GAPB(o[1]=__builtin_amdgcn_mfma_f32_32x32x16_bf16(PAF(3),VFR(7),o[1],0,0,0); VRD2(7), C0,14); \
    GAPB(o[2]=__builtin_amdgcn_mfma_f32_32x32x16_bf16(PAF(0),VFR(0),o[2],0,0,0), C1,0); \
    GAPB(o[3]=__builtin_amdgcn_mfma_f32_32x32x16_bf16(PAF(0),VFR(4),o[3],0,0,0), C1,2); \
    GAPB(o[2]=__builtin_amdgcn_mfma_f32_32x32x16_bf16(PAF(1),VFR(1),o[2],0,0,0), C1,4); \
    GAPB(o[3]=__builtin_amdgcn_mfma_f32_32x32x16_bf16(PAF(1),VFR(5),o[3],0,0,0), C1,6); \
    GAPB(o[2]=__builtin_amdgcn_mfma_f32_32x32x16_bf16(PAF(2),VFR(2),o[2],0,0,0), C1,8); \
    GAPB(o[3]=__builtin_amdgcn_mfma_f32_32x32x16_bf16(PAF(2),VFR(6),o[3],0,0,0), C1,10); \
    GAPB(o[2]=__builtin_amdgcn_mfma_f32_32x32x16_bf16(PAF(3),VFR(3),o[2],0,0,0), C1,12); \
    GAPB(o[3]=__builtin_amdgcn_mfma_f32_32x32x16_bf16(PAF(3),VFR(7),o[3],0,0,0), C1,14); \
    }while(0)
  int t=1;
  #undef CMASK
  #define CMASK(P0,P1,t) do{}while(0)
  for(;t+5<NT;t+=2){
    STEP(pB0,pB1,pA0,pA1,t,true,true,true);     WAIT_BAR(3); RESC(); ROT();
    STEP(pA0,pA1,pB0,pB1,t+1,true,true,true);   WAIT_BAR(3); RESC(); ROT();
  }
  #undef CMASK
  #define CMASK(P0,P1,t) do{int jb_=(t)-(NT-4); if(jb_>=0)cmask(P0,P1,jb_,qrel,hi);}while(0)
  #define ENDW(tt) do{ if((tt)+3<NT){WAIT_BAR(3);} else if((tt)+2<NT){WAIT_BAR(2);} else {WAIT_BAR(0);} }while(0)
  for(;t+1<NT;t+=2){
    STEP(pB0,pB1,pA0,pA1,t,(t+3<NT),(t+1<NT),(t+1<NT));       ENDW(t);   RESC(); ROT();
    STEP(pA0,pA1,pB0,pB1,t+1,(t+4<NT),(t+2<NT),(t+2<NT));     ENDW(t+1); RESC(); ROT();
  }
  STEP(pB0,pB1,pA0,pA1,NT-1,false,false,false); RESC();
  { float sacc=pB0[0]+pB0[1]; _Pragma("unroll") for(int r=2;r<16;++r)sacc+=pB0[r]; _Pragma("unroll") for(int r=0;r<16;++r)sacc+=pB1[r]; l_reg+=sacc;
    pw0=(u32x4){PKW(pB0,0),PKW(pB0,2),PKW(pB0,4),PKW(pB0,6)};pw1=(u32x4){PKW(pB0,8),PKW(pB0,10),PKW(pB0,12),PKW(pB0,14)};pw2=(u32x4){PKW(pB1,0),PKW(pB1,2),PKW(pB1,4),PKW(pB1,6)};pw3=(u32x4){PKW(pB1,8),PKW(pB1,10),PKW(pB1,12),PKW(pB1,14)};
    SBAR(); { int l_=lane; asm volatile("":"+v"(l_)); const int vb_=(int)(lds0+LDS_V)+((l_>>4)&1)*32+(l_&3)*8+(4*(l_>>5)+((l_&15)>>2))*64; pv(o,vb_+2*sl_cur,PAF(0),PAF(1),PAF(2),PAF(3)); } }
  #undef PKW
  #undef PAF
  #undef VFR
  #undef PIN
  #undef MX3
  #undef GAPA
  #undef GAPB
  #undef EX
  #undef VRD
  #undef VRD2
  #undef KRD
  #undef STEP
  #undef ENDW
  {auto rr=__builtin_amdgcn_permlane32_swap(__float_as_uint(l_reg),__float_as_uint(l_reg),false,false);l_reg=__uint_as_float(rr[0])+__uint_as_float(rr[1]);}
  if(hi==0)wsf[32+r32]=l_reg;asm volatile("s_waitcnt lgkmcnt(0)":::"memory");
  float rli[16];
  #pragma unroll
  for(int r=0;r<16;++r)rli[r]=__builtin_amdgcn_rcpf(wsf[32+crow(r,hi)]);
  bf16*Ow=O+(rowbase+q0+wid*QBLK)*DM+hv*(2*D);
  { bf16*stg=(bf16*)(shm+LDS_OST)+wid*4096;
    #pragma unroll
    for(int r=0;r<16;++r){const int orow=crow(r,hi);
      #pragma unroll
      for(int d0=0;d0<4;++d0)stg[orow*128+d0*32+r32]=__float2bfloat16(o[d0][r]*rli[r]);}
    asm volatile("s_waitcnt lgkmcnt(0)":::"memory");
    #pragma unroll
    for(int i=0;i<8;++i){const int row=i*4+(lane>>4),ch=lane&15; const u32x4 v=*(const u32x4*)(stg+row*128+ch*8); ATTN_STORE16(Ow+(long)row*DM+ch*8,v);} }
  asm volatile("s_waitcnt lgkmcnt(0)\n\ts_barrier":::"memory");
  #undef DMA_K
  #undef DMA_V
  #undef CMASK
  #undef START
  #undef RESC
  #undef ROT
  #undef MKC0
  #undef MKC1
}
constexpr int ATTN_LDS_BYTES=LDS_BYTES;
template<int THRL=8> __device__ __forceinline__ void attn_phase(char*lds,const bf16*Q,const bf16*K,const bf16*V,bf16*O1,bf16*O2,int vcu,int G,int wave_){
  for(int v=vcu;v<256;v+=G){
    const int j=v>>1,s=v&1,b=j>>3,h=(j&7)>>1,c=j&1;
    const float sl2=__builtin_amdgcn_exp2f(-2.0f*(float)(h+1))*1.4426950408889634f;
    for(int i=NQB/2-1;i>=0;--i){ const int qb=2*i+((i^s)&1); attn_unit<THRL>(b,h*2+c,h,sl2,qb,Q,K,V,c?O2:O1,lds,wave_); }
  }
}
#undef SBAR
#undef WAIT_BAR
}
constexpr int NWAVES = 8;
constexpr int BATCH = 16, SEQ = 4096, DM = 1024, M = BATCH * SEQ;
constexpr int EVEN_IN = 2560, ODD_IN = 6144, DFF = 3584, NEXP = 8;
constexpr float LN_EPS = 1e-5f;
constexpr float DN_ALPHA = 1.6817928305074290f;
constexpr int TSLOTS = 133120;
constexpr float W8_SCALE = 64.f;

constexpr size_t MiB = 1u << 20;
constexpr size_t WS_CTL = 0, CTL_ZERO_BYTES = 64 * 1024;
constexpr size_t WS_TOKE = 1 * MiB;
constexpr size_t WS_TOKG = WS_TOKE + (size_t)M * 2 * 4;
constexpr size_t WS_SLOT = WS_TOKG + (size_t)M * 2 * 4;
constexpr size_t WS_TOKS = WS_SLOT + (size_t)M * 2 * 4;
constexpr size_t WS_GATS = WS_TOKS + (size_t)TSLOTS * 4;
constexpr size_t WS_WCNT = WS_GATS + (size_t)TSLOTS * 4;
constexpr size_t WS_TILE = WS_WCNT + (size_t)2048 * 8 * 4;
constexpr size_t WS_WSB = 8 * MiB;
constexpr size_t WS_SA = 9 * MiB;
constexpr size_t WS_SAS = 9 * MiB + 512 * 1024;
constexpr size_t WS_SW = 10 * MiB;
constexpr int SW_EIN = 0, SW_E13 = 4096, SW_OIN = 12288, SW_M13 = 20480, SW_OWO = 77824, SW_EWO = 78848;
constexpr size_t A_PMAX = 768 * MiB;
constexpr int PM_WIN = 0, PM_A = 6144 * 16, PM_B = PM_A + 8 * 3584 * 16, PM_WO = PM_B + 8 * 3584 * 16, PMAX_FLOATS = PM_WO + 1024 * 32;
static_assert((size_t)2 * PMAX_FLOATS * 4 <= 8 * MiB, "PMAX");
constexpr size_t WS_WB = 16 * MiB;
constexpr size_t WB_E_IN = 0, WB_E_O = 5 * MiB, WB_E_13 = 7 * MiB, WB_E_2 = 21 * MiB;
constexpr size_t WB_O_IN = 0, WB_O_O = 12 * MiB, WB_O_13 = 16 * MiB, WB_O_2 = 72 * MiB, WB_XQ = 104 * MiB;
constexpr size_t WS_XB = 200 * MiB;
constexpr size_t WS_ACT = 328 * MiB;
constexpr size_t A_U = 0, A_V = 64 * MiB, A_Q = 128 * MiB, A_K = 192 * MiB, A_VA = 256 * MiB, A_O1 = 320 * MiB, A_O2 = 384 * MiB, A_MIX = 448 * MiB, A_MIX8 = 640 * MiB, A_H = 0;
constexpr size_t AO_Q = 0, AO_K = 128 * MiB, AO_V = 256 * MiB, AO_G = 512 * MiB;
constexpr size_t AM_H = 0, AM_OUT = 462 * MiB;
constexpr size_t WS_END = 1104 * MiB;
static_assert(WS_TILE + 2 * 320 * 4 <= WS_WSB, "ws map");
static_assert((size_t)TSLOTS * DFF <= 462 * MiB && AM_OUT + (size_t)TSLOTS * 1024 * 2 <= 776 * MiB && WB_XQ + (size_t)M * DM <= 184 * MiB, "ws map");
constexpr int CW_BAR = 4096;

constexpr int RING_OFF = 0, RING_BYTES = 143360;
constexpr int LDSCTL_OFF = RING_BYTES;
constexpr int LDS_BYTES = 147456;

#define GAS __attribute__((address_space(1)))
#define LAS __attribute__((address_space(3)))
typedef unsigned short bf16;
typedef unsigned v4u __attribute__((ext_vector_type(4)));
typedef unsigned v2u __attribute__((ext_vector_type(2)));
typedef float f32x4 __attribute__((ext_vector_type(4)));
typedef short bf16x8 __attribute__((ext_vector_type(8)));
typedef short s16x4 __attribute__((ext_vector_type(4)));
#define LDS_WAIT() asm volatile("s_waitcnt lgkmcnt(0)" ::: "memory")
#define VM_WAIT() asm volatile("s_waitcnt vmcnt(0)" ::: "memory")
typedef float f32x2_t __attribute__((ext_vector_type(2))); typedef __bf16 bf16x2_t __attribute__((ext_vector_type(2)));
__device__ __forceinline__ unsigned pk2(float lo, float hi) { f32x2_t v = {lo, hi}; bf16x2_t b = __builtin_convertvector(v, bf16x2_t); return __builtin_bit_cast(unsigned, b); }
__device__ __forceinline__ unsigned f2bf(float f) { return pk2(f, f) & 0xffffu; }
__device__ __forceinline__ float bflo(unsigned w) { return __uint_as_float(w << 16); }
__device__ __forceinline__ float bfhi(unsigned w) { return __uint_as_float(w & 0xffff0000u); }
__device__ __forceinline__ float bf2f(bf16 b) { return __uint_as_float(((unsigned)b) << 16); }
__device__ __forceinline__ int lane_id_opaque() { int l; asm volatile("v_mbcnt_lo_u32_b32 %0, -1, 0\n\tv_mbcnt_hi_u32_b32 %0, -1, %0" : "=v"(l)); return l; }
template <int CTRL> __device__ __forceinline__ float dpp_f(float v) { return __int_as_float(__builtin_amdgcn_update_dpp(0, __float_as_int(v), CTRL, 0xF, 0xF, true)); }
__device__ __forceinline__ float quad_sum(float v) { v += dpp_f<0xB1>(v); v += dpp_f<0x4E>(v); return v; }
__device__ __forceinline__ float row16_sum(float v) { v += dpp_f<0xB1>(v); v += dpp_f<0x4E>(v); v += dpp_f<0x141>(v); v += dpp_f<0x140>(v); return v; }
__device__ __forceinline__ float row16_max(float v) { v = fmaxf(v, dpp_f<0xB1>(v)); v = fmaxf(v, dpp_f<0x4E>(v)); v = fmaxf(v, dpp_f<0x141>(v)); v = fmaxf(v, dpp_f<0x140>(v)); return v; }
__device__ __forceinline__ float wave_sum(float v) { v = row16_sum(v);
    { const auto r = __builtin_amdgcn_permlane16_swap(__float_as_uint(v), __float_as_uint(v), false, false); v = __uint_as_float(r[0]) + __uint_as_float(r[1]); }
    { const auto r = __builtin_amdgcn_permlane32_swap(__float_as_uint(v), __float_as_uint(v), false, false); v = __uint_as_float(r[0]) + __uint_as_float(r[1]); }
    return v; }
__device__ __forceinline__ float wave_max(float v) { v = row16_max(v);
    { const auto r = __builtin_amdgcn_permlane16_swap(__float_as_uint(v), __float_as_uint(v), false, false); v = fmaxf(__uint_as_float(r[0]), __uint_as_float(r[1])); }
    { const auto r = __builtin_amdgcn_permlane32_swap(__float_as_uint(v), __float_as_uint(v), false, false); v = fmaxf(__uint_as_float(r[0]), __uint_as_float(r[1])); }
    return v; }

#define XB_TMO      128
#define XB_XCNT(j)  (256  + 64 * (j))
#define XB_XSUB(j)  (1280 + 64 * (j))
#define XB_XGEN(j)  (2304 + 64 * (j))
#define XB_TOP      3328
#define XB_TOPGEN   3392
#define XCD_BAR_WORDS 3456
#define XB_SPIN_CAP (1u << 18)

__device__ __forceinline__ unsigned xb_ld(unsigned* p)              { return __hip_atomic_load(p, __ATOMIC_RELAXED, __HIP_MEMORY_SCOPE_AGENT); }
__device__ __forceinline__ unsigned xb_add(unsigned* p, unsigned v) { return __hip_atomic_fetch_add(p, v, __ATOMIC_RELAXED, __HIP_MEMORY_SCOPE_AGENT); }
__device__ __forceinline__ unsigned xb_xcc_id() { return (unsigned)__builtin_amdgcn_s_getreg((3 << 11) | 20) & 0xFu; }
#define XB_SPIN(cond, bar) do { unsigned _sp = 0; while (cond) { __builtin_amdgcn_s_sleep(1); \
    if ((++_sp & 255u) == 0u) { if (xb_ld(&(bar)[XB_TMO])) break; if (_sp > XB_SPIN_CAP) { atomicAdd(&(bar)[XB_TMO], 1u); break; } } } } while (0)

struct XcdBarrier {
    unsigned* bar; unsigned x;
    volatile LAS unsigned* st;
};

__device__ __forceinline__ XcdBarrier xcd_barrier_post(unsigned* bar, volatile LAS unsigned* st) {
    XcdBarrier b; b.bar = bar; b.x = xb_xcc_id(); b.st = st;
    if (threadIdx.x == 0) (void)xb_add(&bar[XB_XCNT(b.x)], 1u);
    return b;
}
__device__ __forceinline__ void xcd_barrier_complete(unsigned* bar, unsigned x, unsigned& nloc, unsigned& nx) {
    const unsigned G = gridDim.x * gridDim.y * gridDim.z;
    unsigned sum, cnt, mine, sp = 0u;
    for (;;) {
        sum = 0u; cnt = 0u; mine = 0u;
#pragma unroll
        for (unsigned j = 0; j < 16; ++j) { const unsigned c = xb_ld(&bar[XB_XCNT(j)]); sum += c; cnt += (c > 0u) ? 1u : 0u; mine = (j == x) ? c : mine; }
        if (sum == G) break;
        __builtin_amdgcn_s_sleep(1);
        if ((++sp & 255u) == 0u) { if (xb_ld(&bar[XB_TMO])) break; if (sp > XB_SPIN_CAP) { atomicAdd(&bar[XB_TMO], 1u); break; } }
    }
    nloc = mine > 0u ? mine : 1u; nx = cnt > 0u ? cnt : 1u;
}

__device__ __forceinline__ void xcd_barrier(const XcdBarrier& b) {
    asm volatile("s_waitcnt vmcnt(0)" ::: "memory");
    __syncthreads();
    if (threadIdx.x == 0) {
        unsigned* bar = b.bar;
        __builtin_amdgcn_s_waitcnt(0);
        unsigned nloc = b.st[0], nx = b.st[1];
        if (nloc == 0u) { xcd_barrier_complete(bar, b.x, nloc, nx); b.st[0] = nloc; b.st[1] = nx; }
        const unsigned old = xb_add(&bar[XB_XSUB(b.x)], 1u);
        const unsigned gen = old / nloc;
        if (old + 1u == (gen + 1u) * nloc) {
            __builtin_amdgcn_fence(__ATOMIC_RELEASE, "agent");
            asm volatile("s_waitcnt vmcnt(0)" ::: "memory");
            const unsigned og = xb_add(&bar[XB_TOP], 1u);
            const unsigned tg = og / nx;
            if (og + 1u == (tg + 1u) * nx) xb_add(&bar[XB_TOPGEN], 1u);
            else XB_SPIN(xb_ld(&bar[XB_TOPGEN]) == tg, bar);
            __builtin_amdgcn_fence(__ATOMIC_ACQUIRE, "agent");
            xb_add(&bar[XB_XGEN(b.x)], 1u);
            asm volatile("s_waitcnt vmcnt(0)" ::: "memory");
        } else {
            XB_SPIN(xb_ld(&bar[XB_XGEN(b.x)]) == gen, bar);
            __builtin_amdgcn_fence(__ATOMIC_ACQUIRE, "agent");
            asm volatile("s_waitcnt vmcnt(0)" ::: "memory");
        }
    }
    __syncthreads();
}

struct Frame {
    LAS unsigned char* lds;
    int wave;
    int vcu, G;
};

__device__ __forceinline__ void conv_item(const float* W, int K, int N, bf16* WT, int rstride, int roff, LAS float* scr, int item, int lane) {
    const int nblk = N / 32, kb = item / nblk, nb = item % nblk, k0 = 64 * kb, n0 = 32 * nb;
    { float wv[32]; const float* wp = W + (size_t)(k0 + (lane >> 5)) * N + n0 + (lane & 31);
#pragma unroll
      for (int i = 0; i < 32; ++i) wv[i] = wp[(size_t)(2 * i) * N];
#pragma unroll
      for (int i = 0; i < 32; ++i) scr[(2 * i + (lane >> 5)) * 33 + (lane & 31)] = wv[i]; }
    LDS_WAIT(); asm volatile("" ::: "memory");
    const int c = lane & 7;
#pragma unroll
    for (int j = 0; j < 4; ++j) { const int n = (lane >> 3) + 8 * j; const LAS float* s = scr + (8 * c) * 33 + n;
        v4u o; o.x = pk2(s[0 * 33], s[1 * 33]); o.y = pk2(s[2 * 33], s[3 * 33]); o.z = pk2(s[4 * 33], s[5 * 33]); o.w = pk2(s[6 * 33], s[7 * 33]);
        const int ng = n0 + n, drow = (ng >> 7) * rstride + roff + (ng & 127);
        *(GAS v4u*)(WT + (size_t)drow * K + k0 + 8 * c) = o; }
    LDS_WAIT(); asm volatile("" ::: "memory");
}
__device__ __forceinline__ void conv_item8(const float* W, int K, int N, unsigned char* WT, int rstride, int roff, float scale, LAS float* scr, int item, int lane) {
    const int nblk = N / 32, kb = item / nblk, nb = item % nblk, k0 = 64 * kb, n0 = 32 * nb;
    { float wv[32]; const float* wp = W + (size_t)(k0 + (lane >> 5)) * N + n0 + (lane & 31);
#pragma unroll
      for (int i = 0; i < 32; ++i) wv[i] = wp[(size_t)(2 * i) * N];
#pragma unroll
      for (int i = 0; i < 32; ++i) scr[(2 * i + (lane >> 5)) * 33 + (lane & 31)] = wv[i]; }
    LDS_WAIT(); asm volatile("" ::: "memory");
    const int c = lane & 7;
#pragma unroll
    for (int j = 0; j < 4; ++j) { const int n = (lane >> 3) + 8 * j; const LAS float* s = scr + (8 * c) * 33 + n;
        int w0 = 0, w1 = 0;
        w0 = __builtin_amdgcn_cvt_pk_fp8_f32(s[0 * 33] * scale, s[1 * 33] * scale, w0, false); w0 = __builtin_amdgcn_cvt_pk_fp8_f32(s[2 * 33] * scale, s[3 * 33] * scale, w0, true);
        w1 = __builtin_amdgcn_cvt_pk_fp8_f32(s[4 * 33] * scale, s[5 * 33] * scale, w1, false); w1 = __builtin_amdgcn_cvt_pk_fp8_f32(s[6 * 33] * scale, s[7 * 33] * scale, w1, true);
        const int ng = n0 + n, drow = (ng >> 7) * rstride + roff + (ng & 127);
        v2u o; o.x = (unsigned)w0; o.y = (unsigned)w1; *(GAS v2u*)(WT + (size_t)drow * K + k0 + 8 * c) = o; }
    LDS_WAIT(); asm volatile("" ::: "memory");
}
__device__ __forceinline__ int rni8(float x) { return (int)__builtin_rintf(x); }
__device__ __forceinline__ void conv_item_max(const float* W, int K, int N, float* PMAX, int item, int lane) {
    const int nblk = N / 32, kb = item / nblk, nb = item % nblk, k0 = 64 * kb, n0 = 32 * nb;
    const float* wp = W + (size_t)(k0 + (lane >> 5)) * N + n0 + (lane & 31); float wv[32];
#pragma unroll
    for (int i = 0; i < 32; ++i) wv[i] = wp[(size_t)(2 * i) * N];
    float cmax = 0.f;
#pragma unroll
    for (int i = 0; i < 32; ++i) cmax = fmaxf(cmax, fabsf(wv[i]));
    cmax = fmaxf(cmax, __shfl_xor(cmax, 32));
    if (lane < 32) PMAX[(size_t)kb * N + n0 + lane] = cmax;
}
template <int NB = 16> __device__ __forceinline__ void conv_item_q(const float* W, int K, int N, signed char* WT, float* SW, const float* PMAX, int rstride, int roff, LAS float* scr, int item, int lane) {
    const int nblk = N / 32, kb = item / nblk, nb = item % nblk, k0 = 64 * kb, n0 = 32 * nb;
    float wv[32], pm[NB]; const float* wp = W + (size_t)(k0 + (lane >> 5)) * N + n0 + (lane & 31);
#pragma unroll
    for (int i = 0; i < 32; ++i) wv[i] = wp[(size_t)(2 * i) * N];
#pragma unroll
    for (int b = 0; b < NB; ++b) pm[b] = PMAX[(size_t)b * N + n0 + (lane & 31)];
    float cmax = 0.f;
#pragma unroll
    for (int b = 0; b < NB; ++b) cmax = fmaxf(cmax, pm[b]);
    const float inv = cmax > 0.f ? 127.f / cmax : 0.f;
    if (kb == 0 && lane < 32) { const int ng = n0 + lane, drow = (ng >> 7) * rstride + roff + (ng & 127); SW[drow] = cmax > 0.f ? cmax * (1.f / 127.f) : 1.f; }
    {
#pragma unroll
      for (int i = 0; i < 32; ++i) scr[(2 * i + (lane >> 5)) * 33 + (lane & 31)] = wv[i] * inv; }
    LDS_WAIT(); asm volatile("" ::: "memory");
    const int c = lane & 7;
#pragma unroll
    for (int j = 0; j < 4; ++j) { const int n = (lane >> 3) + 8 * j; const LAS float* s = scr + (8 * c) * 33 + n;
        const unsigned w0 = (unsigned)(rni8(s[0 * 33]) & 255) | ((unsigned)(rni8(s[1 * 33]) & 255) << 8) | ((unsigned)(rni8(s[2 * 33]) & 255) << 16) | ((unsigned)rni8(s[3 * 33]) << 24);
        const unsigned w1 = (unsigned)(rni8(s[4 * 33]) & 255) | ((unsigned)(rni8(s[5 * 33]) & 255) << 8) | ((unsigned)(rni8(s[6 * 33]) & 255) << 16) | ((unsigned)rni8(s[7 * 33]) << 24);
        const int ng = n0 + n, drow = (ng >> 7) * rstride + roff + (ng & 127);
        v2u o; o.x = w0; o.y = w1; *(GAS v2u*)(WT + (size_t)drow * K + k0 + 8 * c) = o; }
    LDS_WAIT(); asm volatile("" ::: "memory");
}
struct ConvJob { const float* W; bf16* WT; int K, N, rstride, roff, nitems; float f8scale; float* SW; float* PMAX; int kind; };
template <int NJ> __device__ __forceinline__ void conv_jobs(Frame& F, const ConvJob (&J)[NJ]) {
    const int tid_ = F.wave * 64 + lane_id_opaque(); const int lane = tid_ & 63;
    LAS float* scr = (LAS float*)(F.lds + RING_OFF + F.wave * 16384);
    const int gw = F.vcu * NWAVES + F.wave, NGW = F.G * NWAVES;
    int total = 0;
#pragma unroll
    for (int j = 0; j < NJ; ++j) total += J[j].nitems;
    for (int it = gw; it < total; it += NGW) {
        int r = it;
#pragma unroll
        for (int j = 0; j < NJ; ++j) { if (r >= 0 && r < J[j].nitems) { if (J[j].kind == 1) conv_item8(J[j].W, J[j].K, J[j].N, (unsigned char*)J[j].WT, J[j].rstride, J[j].roff, J[j].f8scale, scr, r, lane); else conv_item(J[j].W, J[j].K, J[j].N, J[j].WT, J[j].rstride, J[j].roff, scr, r, lane); } r -= J[j].nitems; }
    }
}
__device__ __forceinline__ void conv_wo_max(Frame& F, const float* W, float* PMAX) {
    const int lane = lane_id_opaque(); const int gw = F.vcu * NWAVES + F.wave, NGW = F.G * NWAVES;
    for (int it = gw; it < (2 * DM / 64) * (DM / 32); it += NGW) conv_item_max(W, 2 * DM, DM, PMAX, it, lane);
}
__device__ __forceinline__ void conv_wo_q(Frame& F, const float* W, signed char* WT, float* SW, const float* PMAX) {
    const int lane = lane_id_opaque(); const int gw = F.vcu * NWAVES + F.wave, NGW = F.G * NWAVES;
    LAS float* scr = (LAS float*)(F.lds + RING_OFF + F.wave * 16384);
    for (int it = gw; it < (2 * DM / 64) * (DM / 32); it += NGW) conv_item_q<32>(W, 2 * DM, DM, WT, SW, PMAX, 128, 0, scr, it, lane);
}

struct QSet { const float* Win; int Nin; signed char* WinT; float* SWin; const float* W1; const float* W3; int nexp; signed char* W13T; float* SW13; const float* Wo = nullptr; signed char* WoT = nullptr; float* SWo = nullptr; };
__device__ __forceinline__ void conv_q1024(Frame& F, const QSet S) {
    const int tid_ = F.wave * 64 + lane_id_opaque(); const int tid = tid_;
    LAS float* D = (LAS float*)(F.lds + RING_OFF); LAS float* RED = D + 1024 * 32;
    const int nin = S.Nin / 32, nwo = S.Wo != nullptr ? DM / 32 : 0, nff = DFF / 32, total = nin + nwo + S.nexp * 2 * nff;
    f32x4 pre[16];
#define QITEM(it_) const float* W_; int N_, n0_, rs_, ro_; signed char* WT_; float* SW_; \
    if ((it_) < nin) { W_ = S.Win; N_ = S.Nin; n0_ = 32 * (it_); WT_ = S.WinT; SW_ = S.SWin; rs_ = 128; ro_ = 0; } \
    else if ((it_) < nin + nwo) { W_ = S.Wo; N_ = DM; n0_ = 32 * ((it_) - nin); WT_ = S.WoT; SW_ = S.SWo; rs_ = 128; ro_ = 0; } \
    else { const int r_ = (it_) - nin - nwo, e_ = r_ / (2 * nff), q_ = r_ - e_ * 2 * nff, wh_ = q_ >= nff ? 1 : 0; W_ = (wh_ ? S.W3 : S.W1) + (size_t)e_ * DM * DFF; N_ = DFF; n0_ = 32 * (q_ - wh_ * nff); \
           WT_ = S.W13T + (size_t)e_ * 2 * DFF * DM; SW_ = S.SW13 + e_ * 2 * DFF; rs_ = 256; ro_ = 128 * wh_; } \
    (void)W_; (void)N_; (void)n0_; (void)rs_; (void)ro_; (void)WT_; (void)SW_
#define QLOAD(it_) do { QITEM(it_); const float* p_ = W_ + (size_t)(tid >> 3) * N_ + n0_ + (tid & 7) * 4; \
        _Pragma("unroll") for (int j = 0; j < 16; ++j) pre[j] = *(const f32x4*)(p_ + (size_t)(64 * j) * N_); } while (0)
    int it = F.vcu;
    __syncthreads();
    if (it < total) QLOAD(it);
    for (; it < total; it += F.G) {
#pragma unroll
        for (int j = 0; j < 16; ++j) *(LAS f32x4*)(D + (64 * j + (tid >> 3)) * 32 + (tid & 7) * 4) = pre[j];
        __syncthreads();
        if (it + F.G < total) QLOAD(it + F.G);
        const int c = tid & 31, g = tid >> 5;
        float v[64]; float pm = 0.f;
#pragma unroll
        for (int i = 0; i < 64; ++i) { v[i] = D[(64 * g + i) * 32 + c]; pm = fmaxf(pm, fabsf(v[i])); }
        RED[g * 32 + c] = pm;
        __syncthreads();
        float cmax = 0.f;
#pragma unroll
        for (int q = 0; q < 16; ++q) cmax = fmaxf(cmax, RED[q * 32 + c]);
        const float inv = cmax > 0.f ? 127.f / cmax : 0.f;
        QITEM(it);
        const int ng = n0_ + c, drow = (ng >> 7) * rs_ + ro_ + (ng & 127);
        if (g == 0) SW_[drow] = cmax > 0.f ? cmax * (1.f / 127.f) : 1.f;
        v4u* op = (v4u*)(WT_ + (size_t)drow * 1024 + 64 * g);
#pragma unroll
        for (int s4 = 0; s4 < 4; ++s4) { unsigned d[4];
#pragma unroll
            for (int j = 0; j < 4; ++j) { const int b = 16 * s4 + 4 * j;
                d[j] = (unsigned)(rni8(v[b] * inv) & 255) | ((unsigned)(rni8(v[b + 1] * inv) & 255) << 8) | ((unsigned)(rni8(v[b + 2] * inv) & 255) << 16) | ((unsigned)rni8(v[b + 3] * inv) << 24); }
            v4u w; w.x = d[0]; w.y = d[1]; w.z = d[2]; w.w = d[3]; op[s4] = w; }
    }
    __syncthreads();
#undef QLOAD
#undef QITEM
}

template <int SRC, bool ROUTE, bool FINAL>
__device__ __forceinline__ void ln_phase(Frame& F, const float* Y, bf16* XB, float* OUT, const float* gam, const float* bet,
                                         const bf16* OUTB, const int* slot_of_tok,
                                         const float* rw, const float* rb, int* tok_e, float* tok_g, int* wvcnt, signed char* XQ = nullptr, float* SA = nullptr) {
    const int tid_ = F.wave * 64 + lane_id_opaque(); const int lane = tid_ & 63, gw = blockIdx.x * NWAVES + F.wave, NGW = F.G * NWAVES;
    f32x4 g4[4], b4[4];
#pragma unroll
    for (int j = 0; j < 4; ++j) { g4[j] = *(const f32x4*)(gam + 4 * lane + 256 * j); b4[j] = *(const f32x4*)(bet + 4 * lane + 256 * j); }
    float rwv[ROUTE ? 16 : 1][8]; int cnt[8];
    if constexpr (ROUTE) {
#pragma unroll
        for (int j = 0; j < 4; ++j)
#pragma unroll
            for (int c = 0; c < 4; ++c) { const f32x4 a = *(const f32x4*)(rw + (size_t)(4 * lane + 256 * j + c) * 8), b = *(const f32x4*)(rw + (size_t)(4 * lane + 256 * j + c) * 8 + 4);
                rwv[j * 4 + c][0] = a[0]; rwv[j * 4 + c][1] = a[1]; rwv[j * 4 + c][2] = a[2]; rwv[j * 4 + c][3] = a[3]; rwv[j * 4 + c][4] = b[0]; rwv[j * 4 + c][5] = b[1]; rwv[j * 4 + c][6] = b[2]; rwv[j * 4 + c][7] = b[3]; }
#pragma unroll
        for (int e = 0; e < 8; ++e) cnt[e] = 0;
    }
    const int rows_per = M / NGW;
#define LN_ROW(i_) (ROUTE ? gw * rows_per + (i_) : gw + (i_) * NGW)
    constexpr int NR = 2;
    f32x4 rf[NR][4]; v2u ra[NR][4], rp[NR][4], rq[NR][4]; int sl0[NR], sl1[NR];
    (void)rf; (void)ra; (void)rp; (void)rq;
#pragma unroll
    for (int r = 0; r < NR; ++r) { sl0[r] = 0; sl1[r] = 0; }
#define LN_SLOTS(r_, row_) do { if constexpr (SRC == 1) { sl0[r_] = slot_of_tok[2 * (row_)]; sl1[r_] = slot_of_tok[2 * (row_) + 1]; } } while (0)
#define LN_LOAD(r_, row_) do { if constexpr (SRC == 0 || SRC == 3) { const f32x4* yr_ = (const f32x4*)(Y + (size_t)(row_) * DM) + lane; _Pragma("unroll") for (int j = 0; j < 4; ++j) rf[r_][j] = yr_[64 * j]; } \
        else if constexpr (SRC == 2) { const v2u* xr_ = (const v2u*)(XB + (size_t)(row_) * DM) + lane; _Pragma("unroll") for (int j = 0; j < 4; ++j) ra[r_][j] = xr_[64 * j]; } \
        else { const v2u* xr_ = (const v2u*)(XB + (size_t)(row_) * DM) + lane; const v2u* o0_ = (const v2u*)(OUTB + (size_t)sl0[r_] * DM) + lane; const v2u* o1_ = (const v2u*)(OUTB + (size_t)sl1[r_] * DM) + lane; \
               _Pragma("unroll") for (int j = 0; j < 4; ++j) { ra[r_][j] = xr_[64 * j]; rp[r_][j] = o0_[64 * j]; rq[r_][j] = o1_[64 * j]; } } } while (0)
#pragma unroll
    for (int r = 0; r < NR; ++r) LN_SLOTS(r, LN_ROW(r));
#pragma unroll
    for (int r = 0; r < NR; ++r) LN_LOAD(r, LN_ROW(r));
    if (rows_per > NR) {
#pragma unroll
        for (int r = 0; r < NR; ++r) LN_SLOTS(r, LN_ROW(NR + r)); }
    for (int i = 0; i < rows_per; i += NR) {
        f32x4 vv[NR][4];
#pragma unroll
        for (int r = 0; r < NR; ++r) {
            if constexpr (SRC == 0 || SRC == 3) {
#pragma unroll
                for (int j = 0; j < 4; ++j) vv[r][j] = rf[r][j];
            } else if constexpr (SRC == 2) {
#pragma unroll
                for (int j = 0; j < 4; ++j) { const v2u a = ra[r][j]; vv[r][j][0] = bflo(a.x); vv[r][j][1] = bfhi(a.x); vv[r][j][2] = bflo(a.y); vv[r][j][3] = bfhi(a.y); }
            } else {
#pragma unroll
                for (int j = 0; j < 4; ++j) { const v2u a = ra[r][j], p = rp[r][j], q = rq[r][j];
                    vv[r][j][0] = DN_ALPHA * bflo(a.x) + (bflo(p.x) + bflo(q.x)); vv[r][j][1] = DN_ALPHA * bfhi(a.x) + (bfhi(p.x) + bfhi(q.x));
                    vv[r][j][2] = DN_ALPHA * bflo(a.y) + (bflo(p.y) + bflo(q.y)); vv[r][j][3] = DN_ALPHA * bfhi(a.y) + (bfhi(p.y) + bfhi(q.y)); }
            }
        }
        if (i + NR < rows_per) {
#pragma unroll
            for (int r = 0; r < NR; ++r) LN_LOAD(r, LN_ROW(i + NR + r));
            if (i + 2 * NR < rows_per) {
#pragma unroll
                for (int r = 0; r < NR; ++r) LN_SLOTS(r, LN_ROW(i + 2 * NR + r)); } }
#pragma unroll
        for (int r = 0; r < NR; ++r) { const int row = LN_ROW(i + r); f32x4 (&v)[4] = vv[r];
        float s = 0.f;
#pragma unroll
        for (int j = 0; j < 4; ++j) s += (v[j][0] + v[j][1]) + (v[j][2] + v[j][3]);
        if constexpr (SRC != 3) {
        const float mean = wave_sum(s) * (1.f / DM); float s2 = 0.f;
#pragma unroll
        for (int j = 0; j < 4; ++j) { v[j] = v[j] - mean; s2 += (v[j][0] * v[j][0] + v[j][1] * v[j][1]) + (v[j][2] * v[j][2] + v[j][3] * v[j][3]); }
        const float rstd = 1.f / sqrtf(wave_sum(s2) * (1.f / DM) + LN_EPS);
#pragma unroll
        for (int j = 0; j < 4; ++j) v[j] = v[j] * rstd * g4[j] + b4[j];
        }
        if constexpr (!FINAL) {
            float am = 0.f;
#pragma unroll
            for (int j = 0; j < 4; ++j) am = fmaxf(fmaxf(am, fmaxf(fabsf(v[j][0]), fabsf(v[j][1]))), fmaxf(fabsf(v[j][2]), fabsf(v[j][3])));
            am = wave_max(am);
            const float inv = am > 0.f ? 127.f / am : 0.f;
            unsigned* oq = (unsigned*)(XQ + (size_t)row * DM) + lane;
#pragma unroll
            for (int j = 0; j < 4; ++j) oq[64 * j] = (unsigned)(rni8(v[j][0] * inv) & 255) | ((unsigned)(rni8(v[j][1] * inv) & 255) << 8) | ((unsigned)(rni8(v[j][2] * inv) & 255) << 16) | ((unsigned)rni8(v[j][3] * inv) << 24);
            if (lane == 0) SA[row] = am > 0.f ? am * (1.f / 127.f) : 1.f;
        }
        if constexpr (FINAL) {
            f32x4* o = (f32x4*)(OUT + (size_t)row * DM) + lane;
#pragma unroll
            for (int j = 0; j < 4; ++j) o[64 * j] = v[j];
        } else if constexpr (SRC != 3) {
            v2u* o = (v2u*)(XB + (size_t)row * DM) + lane;
#pragma unroll
            for (int j = 0; j < 4; ++j) { v2u w; w.x = pk2(v[j][0], v[j][1]); w.y = pk2(v[j][2], v[j][3]); o[64 * j] = w; }
        }
        if constexpr (ROUTE) {
            float lg[8];
#pragma unroll
            for (int e = 0; e < 8; ++e) { float a = 0.f;
#pragma unroll
                for (int j = 0; j < 4; ++j)
#pragma unroll
                    for (int c = 0; c < 4; ++c) a += v[j][c] * rwv[j * 4 + c][e];
                lg[e] = wave_sum(a) + rb[e]; }
            int e0 = 0; float v0 = lg[0];
#pragma unroll
            for (int e = 1; e < 8; ++e) if (lg[e] > v0) { v0 = lg[e]; e0 = e; }
            int e1 = -1; float v1 = -INFINITY;
#pragma unroll
            for (int e = 0; e < 8; ++e) if (e != e0 && lg[e] > v1) { v1 = lg[e]; e1 = e; }
            const float p1 = 1.f / (1.f + __expf(v0 - v1)), p0 = 1.f - p1;
#pragma unroll
            for (int e = 0; e < 8; ++e) cnt[e] += (e == e0 || e == e1) ? 1 : 0;
            if (lane == 0) { tok_e[2 * row] = e0; tok_e[2 * row + 1] = e1; tok_g[2 * row] = p0; tok_g[2 * row + 1] = p1; }
        }
            }
    }
    if constexpr (ROUTE) { if (lane < 8) { int c = 0;
#pragma unroll
            for (int e = 0; e < 8; ++e) c = (lane == e) ? cnt[e] : c;
            wvcnt[gw * 8 + lane] = c; } }
#undef LN_LOAD
#undef LN_SLOTS
#undef LN_ROW
}

template <bool ROUTE>
__device__ __forceinline__ void panel_ln(Frame& F, bf16* XB, const float* gam, const float* bet,
                                         const float* rw, const float* rb, int* tok_e, float* tok_g, int* wvcnt) {
    const int tid_ = F.wave * 64 + lane_id_opaque(); const int lane = tid_ & 63, wave = F.wave;
    asm volatile("s_waitcnt vmcnt(0)" ::: "memory");
    __syncthreads();
    f32x4 g4[4], b4[4];
#pragma unroll
    for (int j = 0; j < 4; ++j) { g4[j] = *(const f32x4*)(gam + 4 * lane + 256 * j); b4[j] = *(const f32x4*)(bet + 4 * lane + 256 * j); }
    float rwv[ROUTE ? 16 : 1][8]; int cnt[8];
    if constexpr (ROUTE) {
#pragma unroll
        for (int j = 0; j < 4; ++j)
#pragma unroll
            for (int c = 0; c < 4; ++c) { const f32x4 a = *(const f32x4*)(rw + (size_t)(4 * lane + 256 * j + c) * 8), b = *(const f32x4*)(rw + (size_t)(4 * lane + 256 * j + c) * 8 + 4);
                rwv[j * 4 + c][0] = a[0]; rwv[j * 4 + c][1] = a[1]; rwv[j * 4 + c][2] = a[2]; rwv[j * 4 + c][3] = a[3]; rwv[j * 4 + c][4] = b[0]; rwv[j * 4 + c][5] = b[1]; rwv[j * 4 + c][6] = b[2]; rwv[j * 4 + c][7] = b[3]; }
#pragma unroll
        for (int e = 0; e < 8; ++e) cnt[e] = 0;
    }
    const int gw = blockIdx.x * NWAVES + wave;
    for (int i = 0; i < 32; ++i) {
        const int row = blockIdx.x * 256 + wave * 32 + i;
        v2u* xr = (v2u*)(XB + (size_t)row * DM) + lane; f32x4 v[4]; float s = 0.f;
#pragma unroll
        for (int j = 0; j < 4; ++j) { const v2u a = xr[64 * j]; v[j][0] = bflo(a.x); v[j][1] = bfhi(a.x); v[j][2] = bflo(a.y); v[j][3] = bfhi(a.y); s += (v[j][0] + v[j][1]) + (v[j][2] + v[j][3]); }
        const float mean = wave_sum(s) * (1.f / DM); float s2 = 0.f;
#pragma unroll
        for (int j = 0; j < 4; ++j) { v[j] = v[j] - mean; s2 += (v[j][0] * v[j][0] + v[j][1] * v[j][1]) + (v[j][2] * v[j][2] + v[j][3] * v[j][3]); }
        const float rstd = 1.f / sqrtf(wave_sum(s2) * (1.f / DM) + LN_EPS);
#pragma unroll
        for (int j = 0; j < 4; ++j) v[j] = v[j] * rstd * g4[j] + b4[j];
#pragma unroll
        for (int j = 0; j < 4; ++j) { v2u w; w.x = pk2(v[j][0], v[j][1]); w.y = pk2(v[j][2], v[j][3]); xr[64 * j] = w; }
        if constexpr (ROUTE) {
            float lg[8];
#pragma unroll
            for (int e = 0; e < 8; ++e) { float a = 0.f;
#pragma unroll
                for (int j = 0; j < 4; ++j)
#pragma unroll
                    for (int c = 0; c < 4; ++c) a += v[j][c] * rwv[j * 4 + c][e];
                lg[e] = wave_sum(a) + rb[e]; }
            int e0 = 0; float v0 = lg[0];
#pragma unroll
            for (int e = 1; e < 8; ++e) if (lg[e] > v0) { v0 = lg[e]; e0 = e; }
            int e1 = -1; float v1 = -INFINITY;
#pragma unroll
            for (int e = 0; e < 8; ++e) if (e != e0 && lg[e] > v1) { v1 = lg[e]; e1 = e; }
            const float p1 = 1.f / (1.f + __expf(v0 - v1)), p0 = 1.f - p1;
#pragma unroll
            for (int e = 0; e < 8; ++e) cnt[e] += (e == e0 || e == e1) ? 1 : 0;
            if (lane == 0) { tok_e[2 * row] = e0; tok_e[2 * row + 1] = e1; tok_g[2 * row] = p0; tok_g[2 * row + 1] = p1; }
        }
    }
    if constexpr (ROUTE) { if (lane < 8) { int c = 0;
#pragma unroll
            for (int e = 0; e < 8; ++e) c = (lane == e) ? cnt[e] : c;
            wvcnt[gw * 8 + lane] = c; } }
    __syncthreads();
}

__device__ __forceinline__ void assign_phase(Frame& F, const int* wvcnt, const int* tok_e, const float* tok_g, int* slot_of_tok, int* tok_of_slot, float* gate_of_slot, int* tiles, const float* SA, float* SAS) {
    LAS int* sh = (LAS int*)(F.lds + RING_OFF);
    const int tid_ = F.wave * 64 + lane_id_opaque(); const int tid = tid_, lane = tid & 63, wave = F.wave;
    const int gw0 = blockIdx.x * NWAVES;
    int tot[8], pre[8];
#pragma unroll
    for (int e = 0; e < 8; ++e) { tot[e] = 0; pre[e] = 0; }
#pragma unroll
    for (int k = 0; k < 4; ++k) { const int w = 4 * tid + k; const v4u* pp = (const v4u*)(wvcnt + (size_t)w * 8); const v4u a0 = pp[0], a1 = pp[1];
        const int cc[8] = {(int)a0.x, (int)a0.y, (int)a0.z, (int)a0.w, (int)a1.x, (int)a1.y, (int)a1.z, (int)a1.w};
#pragma unroll
        for (int e = 0; e < 8; ++e) { tot[e] += cc[e]; pre[e] += (w < gw0) ? cc[e] : 0; } }
#pragma unroll
    for (int e = 0; e < 8; ++e) {
#pragma unroll
        for (int o = 1; o < 64; o <<= 1) { tot[e] += __shfl_xor(tot[e], o); pre[e] += __shfl_xor(pre[e], o); } }
    if (lane == 0) {
#pragma unroll
        for (int e = 0; e < 8; ++e) { sh[wave * 16 + e] = tot[e]; sh[wave * 16 + 8 + e] = pre[e]; } }
    __syncthreads();
    int T[8], P[8], EB[8];
#pragma unroll
    for (int e = 0; e < 8; ++e) { int a = 0, b = 0;
#pragma unroll
        for (int w = 0; w < 8; ++w) { a += sh[w * 16 + e]; b += sh[w * 16 + 8 + e]; }
        T[e] = a; P[e] = b; }
    { int acc = 0;
#pragma unroll
      for (int e = 0; e < 8; ++e) { EB[e] = acc; acc += (T[e] + 255) & ~255; }
      if (blockIdx.x == 0) {
          const int ntile = acc >> 8;
          if (tid == 0) tiles[0] = ntile;
          for (int t = tid; t < ntile; t += NWAVES * 64) { int ex = 0;
#pragma unroll
              for (int e = 1; e < 8; ++e) if (t * 256 >= EB[e]) ex = e;
              tiles[16 + t] = ex; }
#pragma unroll
          for (int e = 0; e < 8; ++e) { const int lo = EB[e] + T[e], hi = EB[e] + ((T[e] + 255) & ~255);
              for (int s = lo + tid; s < hi; s += NWAVES * 64) { tok_of_slot[s] = 0; gate_of_slot[s] = 0.f; SAS[s] = 1.f; } } } }
    int WP[8];
#pragma unroll
    for (int e = 0; e < 8; ++e) WP[e] = 0;
    for (int w = 0; w < wave; ++w) { const v4u* pp = (const v4u*)(wvcnt + (size_t)(gw0 + w) * 8); const v4u a0 = pp[0], a1 = pp[1];
        WP[0] += (int)a0.x; WP[1] += (int)a0.y; WP[2] += (int)a0.z; WP[3] += (int)a0.w; WP[4] += (int)a1.x; WP[5] += (int)a1.y; WP[6] += (int)a1.z; WP[7] += (int)a1.w; }
    const int t = (gw0 + wave) * 32 + (lane & 31);
    const int e0 = tok_e[2 * t], e1 = tok_e[2 * t + 1]; const float g0 = tok_g[2 * t], g1 = tok_g[2 * t + 1];
    const bool act = lane < 32;
    int s0 = 0, s1 = 0;
#pragma unroll
    for (int e = 0; e < 8; ++e) { const unsigned long long mk = __ballot(act && (e0 == e || e1 == e)); const int rank = __popcll(mk & ((1ull << lane) - 1ull));
        const int sl = EB[e] + P[e] + WP[e] + rank; if (e0 == e) s0 = sl; if (e1 == e) s1 = sl; }
    if (act) { slot_of_tok[2 * t] = s0; slot_of_tok[2 * t + 1] = s1; tok_of_slot[s0] = t; tok_of_slot[s1] = t; gate_of_slot[s0] = g0; gate_of_slot[s1] = g1; const float sat = SA[t]; SAS[s0] = sat; SAS[s1] = sat; }
    __syncthreads();
}

__device__ __forceinline__ f32x4 mfma16(bf16x8 a, bf16x8 b, f32x4 c) { return __builtin_amdgcn_mfma_f32_16x16x32_bf16(a, b, c, 0, 0, 0); }
__device__ __forceinline__ bf16x8 lds_tr8(const LAS bf16* p, int rowstep4  ) {
    const s16x4 lo = __builtin_bit_cast(s16x4, __builtin_amdgcn_ds_read_tr16_b64_v4i16((LAS s16x4*)p));
    const s16x4 hi = __builtin_bit_cast(s16x4, __builtin_amdgcn_ds_read_tr16_b64_v4i16((LAS s16x4*)(p + rowstep4)));
    return (bf16x8){lo[0], lo[1], lo[2], lo[3], hi[0], hi[1], hi[2], hi[3]};
}

constexpr int SG_P = 136;
__device__ __forceinline__ void sgu_phase(Frame& F, const bf16* Wsb, const float* b_s, const float* ln_g, const float* ln_b, const bf16* U, const bf16* V, bf16* MIX) {
    LAS bf16* WS = (LAS bf16*)(F.lds + RING_OFF);
    LAS bf16* VN = WS + 128 * SG_P;
    const int tid_ = F.wave * 64 + lane_id_opaque(); const int tid = tid_, lane = tid & 63, wave = F.wave, fr = lane & 15, fq = lane >> 4;
    int gprev = -1;
    for (int u = F.vcu; u < BATCH * 32 * 4; u += F.G) {
        const int g = u & 3, c = (u >> 2) & 31, b = u >> 7; const size_t row0 = (size_t)b * SEQ + c * 128;
        if (g != gprev) {
            __syncthreads();
#pragma unroll
            for (int i = 0; i < 4; ++i) { const int id = tid + 512 * i, r = id >> 4, ch = id & 15;
                *(LAS v4u*)(WS + r * SG_P + ch * 8) = *(const v4u*)(Wsb + (size_t)g * 16384 + r * 128 + ch * 8); }
            gprev = g;
        }
        { const int s = tid >> 2, qd = tid & 3; const v4u* vp = (const v4u*)(V + (row0 + s) * 512 + g * 128 + qd * 32);
          float x[32];
#pragma unroll
          for (int i = 0; i < 4; ++i) { const v4u w = vp[i]; x[8 * i] = bflo(w.x); x[8 * i + 1] = bfhi(w.x); x[8 * i + 2] = bflo(w.y); x[8 * i + 3] = bfhi(w.y); x[8 * i + 4] = bflo(w.z); x[8 * i + 5] = bfhi(w.z); x[8 * i + 6] = bflo(w.w); x[8 * i + 7] = bfhi(w.w); }
          float sm = 0.f;
#pragma unroll
          for (int i = 0; i < 32; ++i) sm += x[i];
          sm = quad_sum(sm); const float mean = sm * (1.f / 128.f); float sq = 0.f;
#pragma unroll
          for (int i = 0; i < 32; ++i) { x[i] -= mean; sq += x[i] * x[i]; }
          sq = quad_sum(sq); const float rstd = 1.f / sqrtf(sq * (1.f / 128.f) + LN_EPS);
          const f32x4* gp = (const f32x4*)(ln_g + g * 128 + qd * 32); const f32x4* bp = (const f32x4*)(ln_b + g * 128 + qd * 32);
#pragma unroll
          for (int i = 0; i < 4; ++i) { const f32x4 g0 = gp[2 * i], g1 = gp[2 * i + 1], b0 = bp[2 * i], b1 = bp[2 * i + 1]; v4u w;
              w.x = pk2(x[8 * i] * rstd * g0[0] + b0[0], x[8 * i + 1] * rstd * g0[1] + b0[1]); w.y = pk2(x[8 * i + 2] * rstd * g0[2] + b0[2], x[8 * i + 3] * rstd * g0[3] + b0[3]);
              w.z = pk2(x[8 * i + 4] * rstd * g1[0] + b1[0], x[8 * i + 5] * rstd * g1[1] + b1[1]); w.w = pk2(x[8 * i + 6] * rstd * g1[2] + b1[2], x[8 * i + 7] * rstd * g1[3] + b1[3]);
              *(LAS v4u*)(VN + s * SG_P + qd * 32 + 8 * i) = w; } }
        __syncthreads();
        f32x4 acc[8];
#pragma unroll
        for (int j = 0; j < 8; ++j) acc[j] = (f32x4){0.f, 0.f, 0.f, 0.f};
        const int ks_end = (16 * wave + 15) >> 5;
        for (int ks = 0; ks <= ks_end; ++ks) {
            const bf16x8 wf = *(const LAS bf16x8*)(WS + (16 * wave + fr) * SG_P + ks * 32 + fq * 8);
#pragma unroll
            for (int j = 0; j < 8; ++j) { const bf16x8 vf = lds_tr8(VN + (32 * ks + 8 * fq + (fr >> 2)) * SG_P + 16 * j + 4 * (fr & 3), 4 * SG_P); acc[j] = mfma16(vf, wf, acc[j]); }
        }
        { const int t = 16 * wave + fr; const float bs = b_s[g * 128 + t];
          const bf16* up = U + (row0 + t) * 512 + g * 128 + 4 * fq; bf16* op = MIX + (row0 + t) * 1024 + g * 128 + 4 * fq;
#pragma unroll
          for (int j = 0; j < 8; ++j) { const v2u uw = *(const v2u*)(up + 16 * j); v2u w;
              w.x = pk2(bflo(uw.x) * (acc[j][0] + bs), bfhi(uw.x) * (acc[j][1] + bs)); w.y = pk2(bflo(uw.y) * (acc[j][2] + bs), bfhi(uw.y) * (acc[j][3] + bs));
              *(v2u*)(op + 16 * j) = w; } }
        __syncthreads();
    }
}

__device__ __forceinline__ void combine_phase(Frame& F, const bf16* O1, const bf16* O2, const float* lq1, const float* lk1, const float* lq2, const float* lk2, const float* subg, float lam_init, const bf16* MIX, signed char* MIX8, float* SA) {
    const int tid_ = F.wave * 64 + lane_id_opaque(); const int lane = tid_ & 63, gw = F.vcu * NWAVES + F.wave, NGW = F.G * NWAVES;
    const float lam = __expf(wave_sum(lq1[lane] * lk1[lane])) - __expf(wave_sum(lq2[lane] * lk2[lane])) + lam_init;
    const int h = lane >> 4, e0 = (lane & 15) * 8; const float post = 1.f - lam_init;
    float sg[8];
#pragma unroll
    for (int i = 0; i < 8; ++i) sg[i] = subg[e0 + i] * post;
    v4u na = *(const v4u*)(O1 + (size_t)gw * 512 + h * 128 + e0), nb = *(const v4u*)(O2 + (size_t)gw * 512 + h * 128 + e0), nml = *(const v4u*)(MIX + (size_t)gw * 1024 + lane * 8);
    for (int row = gw; row < M; row += NGW) {
        const v4u a = na, b = nb, ml = nml;
        if (row + NGW < M) { const int rn = row + NGW; na = *(const v4u*)(O1 + (size_t)rn * 512 + h * 128 + e0); nb = *(const v4u*)(O2 + (size_t)rn * 512 + h * 128 + e0); nml = *(const v4u*)(MIX + (size_t)rn * 1024 + lane * 8); }
        float o[8], xl[8];
        o[0] = bflo(a.x) - lam * bflo(b.x); o[1] = bfhi(a.x) - lam * bfhi(b.x); o[2] = bflo(a.y) - lam * bflo(b.y); o[3] = bfhi(a.y) - lam * bfhi(b.y);
        o[4] = bflo(a.z) - lam * bflo(b.z); o[5] = bfhi(a.z) - lam * bfhi(b.z); o[6] = bflo(a.w) - lam * bflo(b.w); o[7] = bfhi(a.w) - lam * bfhi(b.w);
        xl[0] = bflo(ml.x); xl[1] = bfhi(ml.x); xl[2] = bflo(ml.y); xl[3] = bfhi(ml.y); xl[4] = bflo(ml.z); xl[5] = bfhi(ml.z); xl[6] = bflo(ml.w); xl[7] = bfhi(ml.w);
        float ss = 0.f;
#pragma unroll
        for (int i = 0; i < 8; ++i) ss += o[i] * o[i];
        ss = row16_sum(ss);
        const float r = 1.f / sqrtf(ss * (1.f / 128.f) + LN_EPS);
        float am = 0.f;
#pragma unroll
        for (int i = 0; i < 8; ++i) { o[i] = o[i] * r * sg[i]; am = fmaxf(am, fmaxf(fabsf(o[i]), fabsf(xl[i]))); }
        am = wave_max(am);
        const float inv = am > 0.f ? 127.f / am : 0.f;
        v2u wl, wr;
        wl.x = (unsigned)(rni8(xl[0] * inv) & 255) | ((unsigned)(rni8(xl[1] * inv) & 255) << 8) | ((unsigned)(rni8(xl[2] * inv) & 255) << 16) | ((unsigned)rni8(xl[3] * inv) << 24);
        wl.y = (unsigned)(rni8(xl[4] * inv) & 255) | ((unsigned)(rni8(xl[5] * inv) & 255) << 8) | ((unsigned)(rni8(xl[6] * inv) & 255) << 16) | ((unsigned)rni8(xl[7] * inv) << 24);
        wr.x = (unsigned)(rni8(o[0] * inv) & 255) | ((unsigned)(rni8(o[1] * inv) & 255) << 8) | ((unsigned)(rni8(o[2] * inv) & 255) << 16) | ((unsigned)rni8(o[3] * inv) << 24);
        wr.y = (unsigned)(rni8(o[4] * inv) & 255) | ((unsigned)(rni8(o[5] * inv) & 255) << 8) | ((unsigned)(rni8(o[6] * inv) & 255) << 16) | ((unsigned)rni8(o[7] * inv) << 24);
        *(v2u*)(MIX8 + (size_t)row * 1024 + lane * 8) = wl; *(v2u*)(MIX8 + (size_t)row * 1024 + 512 + h * 128 + e0) = wr;
        if (lane == 0) SA[row] = am > 0.f ? am * (1.f / 127.f) : 1.f;
    }
}

constexpr int RC = 64, RQ_P = 272, RK_P = 272, RV_P = 136, RP_P = 80, RO_P = 136;
constexpr int R_DUMMY_ = 0;
constexpr int R_QS = 0, R_KS = R_QS + RC * RQ_P * 2, R_VS = R_KS + RC * RK_P * 2, R_PS = R_VS + RC * RV_P * 2, R_OS = R_PS + RC * RP_P * 2, R_END = R_OS + RC * RO_P * 2;
static_assert(R_END <= RING_BYTES, "retention LDS");
#define RKSW(r_) (8 * ((((r_) >> 2) ^ ((r_) >> 3)) & 1))
template <int VAR> __device__ __forceinline__ void retention_phase(Frame& F, const bf16* Q, const bf16* K, const bf16* V, bf16* O) {
    LAS bf16* QS = (LAS bf16*)(F.lds + RING_OFF + R_QS); LAS bf16* KS = (LAS bf16*)(F.lds + RING_OFF + R_KS);
    LAS bf16* VS = (LAS bf16*)(F.lds + RING_OFF + R_VS); LAS bf16* PS = (LAS bf16*)(F.lds + RING_OFF + R_PS);
    LAS bf16* OS = (LAS bf16*)(F.lds + RING_OFF + R_OS);
    const int wave = F.wave;
    for (int u = F.vcu; u < BATCH * 4 * 4; u += F.G) {
        const int sl = u & 3, h = (u >> 2) & 3, b = u >> 4;
        const float lg = __log2f(1.0f - __builtin_amdgcn_exp2f(-5.0f - (float)h));
        const float cdec = __builtin_amdgcn_exp2f(lg * (float)RC);
        const bf16* Qg = Q + (size_t)b * SEQ * 1024 + h * 256; const bf16* Kg = K + (size_t)b * SEQ * 1024 + h * 256;
        const bf16* Vg = V + (size_t)b * SEQ * 2048 + h * 512 + sl * 128; bf16* Og = O + (size_t)b * SEQ * 2048 + h * 512 + sl * 128;
        f32x4 st[16];
#pragma unroll
        for (int t = 0; t < 16; ++t) st[t] = (f32x4){0.f, 0.f, 0.f, 0.f};
        float qd[4], kdv[2][8];
        { const int l0 = lane_id_opaque(), fr0 = l0 & 15, fq0 = l0 >> 4;
#pragma unroll
          for (int mi = 0; mi < 4; ++mi) qd[mi] = __builtin_amdgcn_exp2f(lg * (float)(16 * mi + fr0 + 1));
#pragma unroll
          for (int ks = 0; ks < 2; ++ks)
#pragma unroll
              for (int j = 0; j < 8; ++j) kdv[ks][j] = __builtin_amdgcn_exp2f(lg * (float)(RC - 1 - (32 * ks + 8 * fq0 + j))); }
        float pdm[2][4];
        { const int l1 = lane_id_opaque(), q1 = 16 * (wave >> 1) + (l1 & 15);
#pragma unroll
          for (int j = 0; j < 2; ++j)
#pragma unroll
              for (int r = 0; r < 4; ++r) { const int k1 = 16 * (2 * (wave & 1) + j) + 4 * (l1 >> 4) + r; pdm[j][r] = (q1 >= k1) ? __builtin_amdgcn_exp2f(lg * (float)(q1 - k1)) : 0.f; } }
        v4u rq[4], rk[4], rv[2];
#define RET_TID() const int tid_ = F.wave * 64 + lane_id_opaque(); const int tid = tid_, lane = tid & 63, fr = lane & 15, fq = lane >> 4; (void)fr; (void)fq
#define RET_LOAD(c0) do { RET_TID(); const size_t t0_ = (size_t)(c0) * RC; \
            _Pragma("unroll") for (int i = 0; i < 4; ++i) { const int id = tid + 512 * i; rq[i] = *(const v4u*)(Qg + (t0_ + (id >> 5)) * 1024 + (id & 31) * 8); rk[i] = *(const v4u*)(Kg + (t0_ + (id >> 5)) * 1024 + (id & 31) * 8); } \
            _Pragma("unroll") for (int i = 0; i < 2; ++i) { const int id = tid + 512 * i; rv[i] = *(const v4u*)(Vg + (t0_ + (id >> 4)) * 2048 + (id & 15) * 8); } } while (0)
        RET_LOAD(0);
        if (VAR == 2) { asm volatile("" : "+v"(rq[0]), "+v"(rq[1]), "+v"(rq[2]), "+v"(rq[3]), "+v"(rk[0]), "+v"(rk[1]), "+v"(rk[2]), "+v"(rk[3]), "+v"(rv[0]), "+v"(rv[1])); }
#define RET_OUT(c_) do { if (VAR != 3) { RET_TID(); _Pragma("unroll") for (int i = 0; i < 2; ++i) { const int id = tid + 512 * i, r_ = id >> 4, k_ = id & 15; \
            const v4u w_ = *(const LAS v4u*)(OS + r_ * RO_P + k_ * 8); *(v4u*)(Og + ((size_t)(c_) * RC + r_) * 2048 + k_ * 8) = w_; } } } while (0)
        for (int c = 0; c < SEQ / RC; ++c) {
            if (c > 0) RET_OUT(c - 1);
            { RET_TID();
#pragma unroll
              for (int i = 0; i < 4; ++i) { const int id = tid + 512 * i; *(LAS v4u*)(QS + (id >> 5) * RQ_P + (id & 31) * 8) = rq[i]; *(LAS v4u*)(KS + (id >> 5) * RK_P + (((id & 31) ^ RKSW(id >> 5)) * 8)) = rk[i]; }
#pragma unroll
              for (int i = 0; i < 2; ++i) { const int id = tid + 512 * i; *(LAS v4u*)(VS + (id >> 4) * RV_P + (id & 15) * 8) = rv[i]; } }
            if (VAR != 2 && c + 1 < SEQ / RC) RET_LOAD(c + 1);
            __syncthreads();
            if (VAR != 1) {
            { RET_TID(); const int ti = wave >> 1, tj0 = 2 * (wave & 1);
              f32x4 sc[2] = {(f32x4){0.f, 0.f, 0.f, 0.f}, (f32x4){0.f, 0.f, 0.f, 0.f}};
#define LOADS(dst, g_) do { _Pragma("unroll") for (int k2 = 0; k2 < 2; ++k2) { dst[3 * k2] = *(const LAS bf16x8*)(QS + (16 * ti + fr) * RQ_P + (2 * (g_) + k2) * 32 + fq * 8); \
                  dst[3 * k2 + 1] = *(const LAS bf16x8*)(KS + (16 * tj0 + fr) * RK_P + ((((2 * (g_) + k2) * 4 + fq) ^ RKSW(fr)) * 8)); dst[3 * k2 + 2] = *(const LAS bf16x8*)(KS + (16 * (tj0 + 1) + fr) * RK_P + ((((2 * (g_) + k2) * 4 + fq) ^ RKSW(fr)) * 8)); } } while (0)
#define SCORE(f) do { __builtin_amdgcn_s_setprio(1); sc[0] = mfma16(f[1], f[0], sc[0]); sc[1] = mfma16(f[2], f[0], sc[1]); sc[0] = mfma16(f[4], f[3], sc[0]); sc[1] = mfma16(f[5], f[3], sc[1]); __builtin_amdgcn_s_setprio(0); } while (0)
              bf16x8 fa[6], fb[6];
              LOADS(fa, 0); __builtin_amdgcn_sched_barrier(0);
              LOADS(fb, 1); __builtin_amdgcn_sched_barrier(0); SCORE(fa); __builtin_amdgcn_sched_barrier(0);
              LOADS(fa, 2); __builtin_amdgcn_sched_barrier(0); SCORE(fb); __builtin_amdgcn_sched_barrier(0);
              LOADS(fb, 3); __builtin_amdgcn_sched_barrier(0); SCORE(fa); __builtin_amdgcn_sched_barrier(0);
              SCORE(fb); __builtin_amdgcn_sched_barrier(0);
#undef LOADS
#undef SCORE
              const int q = 16 * ti + fr;
#pragma unroll
              for (int j = 0; j < 2; ++j) { const int key0 = 16 * (tj0 + j) + 4 * fq; float p[4];
#pragma unroll
                  for (int r = 0; r < 4; ++r) p[r] = sc[j][r] * pdm[j][r];
                  v2u w; w.x = pk2(p[0], p[1]); w.y = pk2(p[2], p[3]); *(LAS v2u*)(PS + q * RP_P + key0) = w; } }
            }
            __syncthreads();
            if (VAR != 1) {
            RET_TID();
#define SB() __builtin_amdgcn_sched_barrier(0)
#define LOADQ(dst, ks_) do { _Pragma("unroll") for (int mi = 0; mi < 4; ++mi) dst[mi] = *(const LAS v4u*)(QS + (16 * mi + fr) * RQ_P + (ks_) * 32 + 8 * fq); } while (0)
#define LOADP(dst, ks_) do { _Pragma("unroll") for (int mi = 0; mi < 4; ++mi) dst[mi] = *(const LAS v4u*)(PS + (16 * mi + fr) * RP_P + (ks_) * 32 + fq * 8); } while (0)
#define LOADKT(dst, t_) do { _Pragma("unroll") for (int k2 = 0; k2 < 2; ++k2) { const int cl_ = (4 * ((t_) >> 1) + (fr & 3)) ^ (8 * (fq & 1));     \
                const LAS bf16* pl_ = KS + (32 * k2 + 8 * fq + (fr >> 2)) * RK_P + cl_ * 8 + 4 * ((t_) & 1); const LAS bf16* ph_ = KS + (32 * k2 + 8 * fq + (fr >> 2) + 4) * RK_P + (cl_ ^ 8) * 8 + 4 * ((t_) & 1); \
                const s16x4 lo_ = __builtin_bit_cast(s16x4, __builtin_amdgcn_ds_read_tr16_b64_v4i16((LAS s16x4*)pl_)); const s16x4 hi_ = __builtin_bit_cast(s16x4, __builtin_amdgcn_ds_read_tr16_b64_v4i16((LAS s16x4*)ph_)); \
                dst[k2] = (bf16x8){lo_[0], lo_[1], lo_[2], lo_[3], hi_[0], hi_[1], hi_[2], hi_[3]}; } } while (0)
#define CROSS(ks_, qf) do { const v4u pw_ = {pk2(st[2 * (ks_)][0], st[2 * (ks_)][1]), pk2(st[2 * (ks_)][2], st[2 * (ks_)][3]), pk2(st[2 * (ks_) + 1][0], st[2 * (ks_) + 1][1]), pk2(st[2 * (ks_) + 1][2], st[2 * (ks_) + 1][3])}; \
                const bf16x8 sb_ = __builtin_bit_cast(bf16x8, pw_); __builtin_amdgcn_s_setprio(1); _Pragma("unroll") for (int mi = 0; mi < 4; ++mi) acc[mi] = mfma16(sb_, __builtin_bit_cast(bf16x8, qf[mi]), acc[mi]); __builtin_amdgcn_s_setprio(0); } while (0)
            f32x4 acc[4];
#pragma unroll
            for (int mi = 0; mi < 4; ++mi) acc[mi] = (f32x4){0.f, 0.f, 0.f, 0.f};
            v4u qa[4], qb[4]; bf16x8 vb[2], vd[2], ka[2], kb[2];
            LOADQ(qa, 0); SB();
            LOADQ(qb, 1); SB(); CROSS(0, qa); SB();
            LOADQ(qa, 2); SB(); CROSS(1, qb); SB();
            LOADQ(qb, 3); SB(); CROSS(2, qa); SB();
            LOADQ(qa, 4); SB(); CROSS(3, qb); SB();
            LOADQ(qb, 5); SB(); CROSS(4, qa); SB();
            LOADQ(qa, 6); SB(); CROSS(5, qb); SB();
            LOADQ(qb, 7); SB(); CROSS(6, qa); SB();
#pragma unroll
            for (int ks = 0; ks < 2; ++ks) vb[ks] = lds_tr8(VS + (32 * ks + 8 * fq + (fr >> 2)) * RV_P + 16 * wave + 4 * (fr & 3), 4 * RV_P);
            LOADP(qa, 0); SB(); CROSS(7, qb); SB();
#pragma unroll
            for (int mi = 0; mi < 4; ++mi) acc[mi] = acc[mi] * qd[mi];
            LOADP(qb, 1); SB();
#pragma unroll
            for (int mi = 0; mi < 4; ++mi) acc[mi] = mfma16(vb[0], __builtin_bit_cast(bf16x8, qa[mi]), acc[mi]);
            SB(); LOADKT(ka, 0); SB();
#pragma unroll
            for (int mi = 0; mi < 4; ++mi) acc[mi] = mfma16(vb[1], __builtin_bit_cast(bf16x8, qb[mi]), acc[mi]);
            SB();
#pragma unroll
            for (int ks = 0; ks < 2; ++ks) { const v4u vw = __builtin_bit_cast(v4u, vb[ks]); v4u dw;
                dw.x = pk2(bflo(vw.x) * kdv[ks][0], bfhi(vw.x) * kdv[ks][1]); dw.y = pk2(bflo(vw.y) * kdv[ks][2], bfhi(vw.y) * kdv[ks][3]);
                dw.z = pk2(bflo(vw.z) * kdv[ks][4], bfhi(vw.z) * kdv[ks][5]); dw.w = pk2(bflo(vw.w) * kdv[ks][6], bfhi(vw.w) * kdv[ks][7]);
                vd[ks] = __builtin_bit_cast(bf16x8, dw); }
            if (VAR != 3) {
#pragma unroll
              for (int mi = 0; mi < 4; ++mi) { v2u w; w.x = pk2(acc[mi][0], acc[mi][1]); w.y = pk2(acc[mi][2], acc[mi][3]); *(LAS v2u*)(OS + (16 * mi + fr) * RO_P + 16 * wave + 4 * fq) = w; } }
            SB();
#define STATE(t_, kf) do { st[t_] = st[t_] * cdec; __builtin_amdgcn_s_setprio(1); st[t_] = mfma16(kf[0], vd[0], st[t_]); st[t_] = mfma16(kf[1], vd[1], st[t_]); __builtin_amdgcn_s_setprio(0); } while (0)
#pragma unroll
            for (int t = 0; t < 16; t += 2) {
                LOADKT(kb, t + 1); SB(); STATE(t, ka); SB();
                if (t + 2 < 16) { LOADKT(ka, t + 2); } SB(); STATE(t + 1, kb); SB(); }
#undef SB
#undef LOADQ
#undef LOADP
#undef LOADKT
#undef CROSS
#undef STATE
            }
            __syncthreads();
        }
        RET_OUT(SEQ / RC - 1);
        __syncthreads();
#undef RET_OUT
#undef RET_LOAD
#undef RET_TID
    }
}

__device__ __forceinline__ void gate_phase(Frame& F, const bf16* O, const bf16* G, const float* gn_g, signed char* G8, float* SA) {
    const int tid_ = F.wave * 64 + lane_id_opaque(); const int lane = tid_ & 63, gw = F.vcu * NWAVES + F.wave, NGW = F.G * NWAVES;
    float gg[32];
#pragma unroll
    for (int i = 0; i < 32; ++i) gg[i] = gn_g[lane * 32 + i];
    for (int row = gw; row < M; row += NGW) {
        const v4u* op = (const v4u*)(O + (size_t)row * 2048 + lane * 32); const v4u* gp = (const v4u*)(G + (size_t)row * 2048 + lane * 32);
        float x[32], gt[32];
#pragma unroll
        for (int i = 0; i < 4; ++i) { const v4u w = op[i], z = gp[i];
            x[8 * i] = bflo(w.x); x[8 * i + 1] = bfhi(w.x); x[8 * i + 2] = bflo(w.y); x[8 * i + 3] = bfhi(w.y); x[8 * i + 4] = bflo(w.z); x[8 * i + 5] = bfhi(w.z); x[8 * i + 6] = bflo(w.w); x[8 * i + 7] = bfhi(w.w);
            gt[8 * i] = bflo(z.x); gt[8 * i + 1] = bfhi(z.x); gt[8 * i + 2] = bflo(z.y); gt[8 * i + 3] = bfhi(z.y); gt[8 * i + 4] = bflo(z.z); gt[8 * i + 5] = bfhi(z.z); gt[8 * i + 6] = bflo(z.w); gt[8 * i + 7] = bfhi(z.w); }
        float sm = 0.f;
#pragma unroll
        for (int i = 0; i < 32; ++i) sm += x[i];
        sm = row16_sum(sm);
        const float mean = sm * (1.f / 512.f); float sq = 0.f;
#pragma unroll
        for (int i = 0; i < 32; ++i) { x[i] -= mean; sq += x[i] * x[i]; }
        sq = row16_sum(sq);
        const float rstd = 1.f / sqrtf(sq * (1.f / 512.f) + LN_EPS);
        float am = 0.f;
#pragma unroll
        for (int i = 0; i < 32; ++i) { x[i] = x[i] * rstd * gg[i] * gt[i]; am = fmaxf(am, fabsf(x[i])); }
        am = wave_max(am);
        const float inv = am > 0.f ? 127.f / am : 0.f;
        v4u* qp = (v4u*)(G8 + (size_t)row * 2048 + lane * 32);
#pragma unroll
        for (int i = 0; i < 2; ++i) { v4u w; unsigned d[4];
#pragma unroll
            for (int j = 0; j < 4; ++j) { const float* y = x + 16 * i + 4 * j;
                d[j] = (unsigned)(rni8(y[0] * inv) & 255) | ((unsigned)(rni8(y[1] * inv) & 255) << 8) | ((unsigned)(rni8(y[2] * inv) & 255) << 16) | ((unsigned)rni8(y[3] * inv) << 24); }
            w.x = d[0]; w.y = d[1]; w.z = d[2]; w.w = d[3]; qp[i] = w; }
        if (lane == 0) SA[row] = am > 0.f ? am * (1.f / 127.f) : 1.f;
    }
}

struct Args {
    const float* in[31]; float* out; unsigned char* ws; int ph_lo, ph_hi; int pad0, pad1;
};
enum { I_X = 0, I_EWIN, I_EWS, I_EBS, I_EVLG, I_EVLB, I_LQ1, I_LK1, I_LQ2, I_LK2, I_SUBG, I_EWO, I_ELN1G, I_ELN1B, I_FW1, I_FW3, I_FW2, I_ELN2G, I_ELN2B,
       I_OWIN, I_OGN, I_OWO, I_OLN1G, I_OLN1B, I_RW, I_RB, I_MW1, I_MW3, I_MW2, I_OLN2G, I_OLN2B };
constexpr int PH_EVEN = 8, PH_ODD = 9, PH_TOTAL = 1 + 2 * (PH_EVEN + PH_ODD);

__global__ void __launch_bounds__(NWAVES * 64, 2) mk_fwd(Args args) {
    extern __shared__ __attribute__((aligned(16))) unsigned char lds[];
    Frame F;
    F.lds = (LAS unsigned char*)lds;
    F.wave = __builtin_amdgcn_readfirstlane((int)threadIdx.x >> 6);
    F.G = gridDim.x; { const int bx = blockIdx.x; F.vcu = (F.G % 8 == 0) ? (bx % 8) * (F.G / 8) + bx / 8 : bx; }
    unsigned* ctl = (unsigned*)(args.ws + WS_CTL);
    for (int u = threadIdx.x; u < (LDS_BYTES - LDSCTL_OFF) / 4; u += NWAVES * 64) ((LAS unsigned*)(F.lds + LDSCTL_OFF))[u] = 0u;
    __syncthreads();
    const int lo = args.ph_lo, hi = args.ph_hi;
    XcdBarrier bar; bar.bar = ctl + CW_BAR; bar.x = 0; bar.st = nullptr;
    if (hi - lo > 1) bar = xcd_barrier_post(ctl + CW_BAR, (volatile LAS unsigned*)(F.lds + LDSCTL_OFF + 32));
#define IN(k) (lo <= (k) && (k) < hi)
#ifndef ONLY_PH
#define ONLY_PH -1
#endif
#define KEEP(n) (ONLY_PH < 0 || ONLY_PH == (n))
#ifndef DUP_MASK
#define DUP_MASK 0
#endif
#define NREP(n) ((((n) == 1 || (n) == 4 || (n) == 6 || (n) == 7 || (n) == 10 || (n) == 13) && (DUP_MASK & 1)) || (((n) == 16 || (n) == 17) && (DUP_MASK & 2)) || ((n) == 2 && (DUP_MASK & 4)) || ((n) == 11 && (DUP_MASK & 8)) || \
    (((n) == 0 || (n) == 3 || (n) == 5 || (n) == 8 || (n) == 9 || (n) == 14 || (n) == 15) && (DUP_MASK & 16)) ? 2 : 1)
#define SEAM(k) do { if (IN(k) && IN((k) + 1)) xcd_barrier(bar); } while (0)

#define PH_LOCALS int z_ = 0; asm volatile("" : "+s"(z_)); unsigned char* const ws = args.ws + z_; (void)ws; \
    bf16* const XB = (bf16*)(ws + WS_XB); (void)XB; signed char* const XQ = (signed char*)(ws + WS_WB + WB_XQ); (void)XQ; float* const SA = (float*)(ws + WS_SA); (void)SA; float* const SW = (float*)(ws + WS_SW); (void)SW; float* const SAS = (float*)(ws + WS_SAS); (void)SAS; float* const Y = args.out + z_; (void)Y; unsigned char* const act = ws + WS_ACT; (void)act; unsigned char* const wb = ws + WS_WB; (void)wb
#define INP(i) (args.in[(i) + z_])
#define MOE_PTRS int* const tok_e = (int*)(ws + WS_TOKE); float* const tok_g = (float*)(ws + WS_TOKG); int* const slot_of_tok = (int*)(ws + WS_SLOT); \
    int* const tok_of_slot = (int*)(ws + WS_TOKS); float* const gate_of_slot = (float*)(ws + WS_GATS); int* const wvcnt = (int*)(ws + WS_WCNT); int* const tiles = (int*)(ws + WS_TILE); \
    (void)tok_e; (void)tok_g; (void)slot_of_tok; (void)tok_of_slot; (void)gate_of_slot; (void)wvcnt; (void)tiles
#define EVEN_PTRS bf16* const WinT = (bf16*)(wb + WB_E_IN); bf16* const WoT = (bf16*)(wb + WB_E_O); bf16* const W13T = (bf16*)(wb + WB_E_13); bf16* const W2T = (bf16*)(wb + WB_E_2); \
    bf16* const Wsb = (bf16*)(ws + WS_WSB); \
    bf16* const U = (bf16*)(act + A_U); bf16* const Vg = (bf16*)(act + A_V); bf16* const Qa = (bf16*)(act + A_Q); bf16* const Ka = (bf16*)(act + A_K); bf16* const Va = (bf16*)(act + A_VA); \
    bf16* const O1 = (bf16*)(act + A_O1); bf16* const O2 = (bf16*)(act + A_O2); bf16* const MIX = (bf16*)(act + A_MIX); bf16* const Hh = (bf16*)(act + A_H); \
    (void)WinT; (void)WoT; (void)W13T; (void)W2T; (void)Wsb; (void)U; (void)Vg; (void)Qa; (void)Ka; (void)Va; (void)O1; (void)O2; (void)MIX; (void)Hh
#define ODD_PTRS bf16* const WinT = (bf16*)(wb + WB_O_IN); bf16* const WoT = (bf16*)(wb + WB_O_O); unsigned char* const MW13 = wb + WB_O_13; unsigned char* const MW2 = wb + WB_O_2; \
    bf16* const Qr = (bf16*)(act + AO_Q); bf16* const Kr = (bf16*)(act + AO_K); bf16* const Vr = (bf16*)(act + AO_V); bf16* const Gr = (bf16*)(act + AO_G); \
    bf16* const Or = (bf16*)Y; unsigned char* const HM = act + AM_H; bf16* const OUTB = (bf16*)(act + AM_OUT); \
    (void)WinT; (void)WoT; (void)MW13; (void)MW2; (void)Qr; (void)Kr; (void)Vr; (void)Gr; (void)Or; (void)HM; (void)OUTB

    int ph = 0;
    for (int l = 0; l < 4; ++l) {
        const int li = l >> 1;
        if ((l & 1) == 0) {
            if (l == 0) {
            if (KEEP(0) && IN(ph)) for (int rep_ = 0; rep_ < NREP(0); ++rep_) { PH_LOCALS; EVEN_PTRS;
                conv_q1024(F, QSet{INP(I_EWIN) + (size_t)li * DM * EVEN_IN, EVEN_IN, (signed char*)WinT, SW + SW_EIN, INP(I_FW1) + (size_t)li * DM * DFF, INP(I_FW3) + (size_t)li * DM * DFF, 1, (signed char*)W13T, SW + SW_E13,
                                   INP(I_EWO) + (size_t)li * DM * DM, (signed char*)WoT, SW + SW_EWO});
                const ConvJob J[1] = {
                    {INP(I_FW2) + (size_t)li * DFF * DM, W2T, DFF, DM, 128, 0, (DFF / 64) * (DM / 32), W8_SCALE, nullptr, nullptr, 1}};
                conv_jobs<1>(F, J);
                { float* const PN = (float*)(act + A_PMAX) + (size_t)((l + 1) & 1) * PMAX_FLOATS;
                  conv_wo_max(F, INP(I_OWO) + (size_t)li * 2 * DM * DM, PN + PM_WO); }
                const int tq = F.wave * 64 + lane_id_opaque();
                { const float* wsrc = INP(I_EWS) + (size_t)li * 4 * 128 * 128;
                  for (int i = blockIdx.x * 512 + tq; i < 4 * 128 * 128; i += F.G * 512) { const int s = i & 127, t = (i >> 7) & 127; Wsb[i] = (bf16)f2bf(s <= t ? wsrc[i] : 0.f); } }
                if (l == 0) ln_phase<3, false, false>(F, INP(I_X), XB, nullptr, INP(I_ELN1G), INP(I_ELN1B), nullptr, nullptr, nullptr, nullptr, nullptr, nullptr, nullptr, XQ, SA);
            }
            SEAM(ph); ++ph;
            }
            if (KEEP(1) && IN(ph)) for (int rep_ = 0; rep_ < NREP(1); ++rep_) { PH_LOCALS; EVEN_PTRS;
                pg8::Gemm g{(const bf16*)XQ, WinT, M, EVEN_IN, DM}; pg8::StaticOrder S; S.init(M, EVEN_IN, F.G, (int)blockIdx.x);
                pg8::EpiRouteQ E{{U, Vg, Qa, Ka, Va}, {512, 512, 512, 512, 512}, {0, 2, 4, 6, 8}, {1, 1, 0, 0, 0}, {1.f, 1.f, attn_body::C2, 1.f, 1.f}, 5, SA, SW + SW_EIN, nullptr};
                pg8::gemm_phase<pg8::EpiRouteQ, pg8::StaticOrder, true, true, 2>(F.lds + RING_OFF, g, S, E, F.wave);
            }
            SEAM(ph); ++ph;
            if (KEEP(2) && IN(ph)) for (int rep_ = 0; rep_ < NREP(2); ++rep_) { PH_LOCALS; EVEN_PTRS;
                attn_body::attn_phase<40>((char*)lds + RING_OFF, (const attn_body::bf16*)Qa, (const attn_body::bf16*)Ka, (const attn_body::bf16*)Va, (attn_body::bf16*)O1, (attn_body::bf16*)O2, F.vcu, F.G, F.wave);
                sgu_phase(F, Wsb, INP(I_EBS) + li * 512, INP(I_EVLG) + li * 512, INP(I_EVLB) + li * 512, U, Vg, MIX);
            }
            SEAM(ph); ++ph;
            if (KEEP(3) && IN(ph)) for (int rep_ = 0; rep_ < NREP(3); ++rep_) { PH_LOCALS; EVEN_PTRS;
                const float lam_init = 0.8f - 0.6f * __expf(-0.3f * (float)l);
                combine_phase(F, O1, O2, INP(I_LQ1) + li * 64, INP(I_LK1) + li * 64, INP(I_LQ2) + li * 64, INP(I_LK2) + li * 64, INP(I_SUBG) + li * 128, lam_init, MIX, (signed char*)(act + A_MIX8), SA);
            }
            SEAM(ph); ++ph;
            if (KEEP(4) && IN(ph)) for (int rep_ = 0; rep_ < NREP(4); ++rep_) { PH_LOCALS; EVEN_PTRS;
                pg8::Gemm g{(const bf16*)(act + A_MIX8), WoT, M, DM, DM}; pg8::StaticOrder S; S.init(M, DM, F.G, (int)blockIdx.x);
                if (l == 0) { pg8::EpiResFromF32Q E{INP(I_X), XB, DM, DN_ALPHA, SA, SW + SW_EWO, nullptr};
                    pg8::gemm_phase<pg8::EpiResFromF32Q, pg8::StaticOrder, true, true, 2>(F.lds + RING_OFF, g, S, E, F.wave); }
                else { pg8::EpiResInplaceQ E{XB, DM, DN_ALPHA, SA, SW + SW_EWO, nullptr};
                    pg8::gemm_phase<pg8::EpiResInplaceQ, pg8::StaticOrder, true, true, 2>(F.lds + RING_OFF, g, S, E, F.wave); }
            }
            SEAM(ph); ++ph;
            if (KEEP(5) && IN(ph)) for (int rep_ = 0; rep_ < NREP(5); ++rep_) { PH_LOCALS; EVEN_PTRS; ln_phase<2, false, false>(F, nullptr, XB, nullptr, INP(I_ELN1G) + li * DM, INP(I_ELN1B) + li * DM, nullptr, nullptr, nullptr, nullptr, nullptr, nullptr, nullptr, XQ, SA); }
            SEAM(ph); ++ph;
            if (KEEP(6) && IN(ph)) for (int rep_ = 0; rep_ < NREP(6); ++rep_) { PH_LOCALS; EVEN_PTRS;
                pg8::Gemm g{(const bf16*)XQ, W13T, M, 2 * DFF, DM}; pg8::StaticOrder S; S.init(M, 2 * DFF, F.G, (int)blockIdx.x);
                pg8::EpiSwigluQ<true> E{Hh, DFF, SA, SW + SW_E13, nullptr};
                pg8::gemm_phase<pg8::EpiSwigluQ<true>, pg8::StaticOrder, true, true, 2>(F.lds + RING_OFF, g, S, E, F.wave);
            }
            SEAM(ph); ++ph;
            if (KEEP(7) && IN(ph)) for (int rep_ = 0; rep_ < NREP(7); ++rep_) { PH_LOCALS; EVEN_PTRS;
                pg8::Gemm g{Hh, W2T, M, DM, DFF}; pg8::StaticOrder S; S.init(M, DM, F.G, (int)blockIdx.x);
                pg8::EpiResInplace E{XB, DM, DN_ALPHA, 1.f / W8_SCALE};
                pg8::gemm_phase<pg8::EpiResInplace, pg8::StaticOrder, true, true, 1, true>(F.lds + RING_OFF, g, S, E, F.wave);
            }
            SEAM(ph); ++ph;
            if (KEEP(8) && IN(ph)) for (int rep_ = 0; rep_ < NREP(8); ++rep_) { PH_LOCALS; EVEN_PTRS; ln_phase<2, false, false>(F, nullptr, XB, nullptr, INP(I_ELN2G) + li * DM, INP(I_ELN2B) + li * DM, nullptr, nullptr, nullptr, nullptr, nullptr, nullptr, nullptr, XQ, SA);
                { ODD_PTRS; MOE_PTRS;
                float* const PM = (float*)(act + A_PMAX) + (size_t)((l + 1) & 1) * PMAX_FLOATS;
                conv_q1024(F, QSet{INP(I_OWIN) + (size_t)li * DM * ODD_IN, ODD_IN, (signed char*)WinT, SW + SW_OIN, INP(I_MW1) + (size_t)li * NEXP * DM * DFF, INP(I_MW3) + (size_t)li * NEXP * DM * DFF, NEXP, (signed char*)MW13, SW + SW_M13});
                conv_wo_q(F, INP(I_OWO) + (size_t)li * 2 * DM * DM, (signed char*)WoT, SW + SW_OWO, PM + PM_WO);
                for (int e = 0; e < NEXP; ++e) { const ConvJob J[1] = {
                    {INP(I_MW2) + ((size_t)li * NEXP + e) * DFF * DM, (bf16*)(MW2 + (size_t)e * DM * DFF), DFF, DM, 128, 0, (DFF / 64) * (DM / 32), W8_SCALE, nullptr, nullptr, 1}};
                    conv_jobs<1>(F, J); }
                } }
            SEAM(ph); ++ph;
        } else {
            if (KEEP(10) && IN(ph)) for (int rep_ = 0; rep_ < NREP(10); ++rep_) { PH_LOCALS; ODD_PTRS; MOE_PTRS;
                pg8::Gemm g{(const bf16*)XQ, WinT, M, ODD_IN, DM}; pg8::StaticOrder S; S.init(M, ODD_IN, F.G, (int)blockIdx.x);
                pg8::EpiRouteQ E{{Qr, Kr, Vr, Gr, Gr}, {1024, 1024, 2048, 2048, 2048}, {0, 4, 8, 16, 1 << 30}, {0, 0, 0, 2, 0}, {1.f, 0.0625f, 1.f, 1.f, 1.f}, 4, SA, SW + SW_OIN, nullptr};
                pg8::gemm_phase<pg8::EpiRouteQ, pg8::StaticOrder, true, true, 2>(F.lds + RING_OFF, g, S, E, F.wave);
            }
            SEAM(ph); ++ph;
            if (KEEP(11) && IN(ph)) for (int rep_ = 0; rep_ < NREP(11); ++rep_) { PH_LOCALS; ODD_PTRS; MOE_PTRS;
#ifdef DUP_VARIANT
                if (args.pad0 == 1) retention_phase<1>(F, Qr, Kr, Vr, Or); else if (args.pad0 == 2) retention_phase<2>(F, Qr, Kr, Vr, Or); else if (args.pad0 == 3) retention_phase<3>(F, Qr, Kr, Vr, Or); else
#endif
                retention_phase<0>(F, Qr, Kr, Vr, Or); }
            SEAM(ph); ++ph;
            if (KEEP(12) && IN(ph)) for (int rep_ = 0; rep_ < NREP(12); ++rep_) { PH_LOCALS; ODD_PTRS; MOE_PTRS; gate_phase(F, Or, Gr, INP(I_OGN) + li * 2048, (signed char*)Qr, SA); }
            SEAM(ph); ++ph;
            if (KEEP(13) && IN(ph)) for (int rep_ = 0; rep_ < NREP(13); ++rep_) { PH_LOCALS; ODD_PTRS; MOE_PTRS;
                pg8::Gemm g{Qr, WoT, M, DM, 2 * DM}; pg8::StaticOrder S; S.init(M, DM, F.G, (int)blockIdx.x);
                pg8::EpiResInplaceQ E{XB, DM, DN_ALPHA, SA, SW + SW_OWO, nullptr};
                pg8::gemm_phase<pg8::EpiResInplaceQ, pg8::StaticOrder, true, true, 2>(F.lds + RING_OFF, g, S, E, F.wave);
            }
            SEAM(ph); ++ph;
            if (KEEP(14) && IN(ph)) for (int rep_ = 0; rep_ < NREP(14); ++rep_) { PH_LOCALS; ODD_PTRS; MOE_PTRS; ln_phase<2, true, false>(F, nullptr, XB, nullptr, INP(I_OLN1G) + li * DM, INP(I_OLN1B) + li * DM, nullptr, nullptr,
                                                 INP(I_RW) + (size_t)li * DM * NEXP, INP(I_RB) + li * NEXP, tok_e, tok_g, wvcnt, XQ, SA); }
            SEAM(ph); ++ph;
            if (KEEP(15) && IN(ph)) for (int rep_ = 0; rep_ < NREP(15); ++rep_) { PH_LOCALS; ODD_PTRS; MOE_PTRS; assign_phase(F, wvcnt, tok_e, tok_g, slot_of_tok, tok_of_slot, gate_of_slot, tiles, SA, SAS); }
            SEAM(ph); ++ph;
            if (KEEP(16) && IN(ph)) for (int rep_ = 0; rep_ < NREP(16); ++rep_) { PH_LOCALS; ODD_PTRS; MOE_PTRS;
                const int nt = tiles[0];
                pg8::Gemm g{(const bf16*)XQ, (const bf16*)MW13, 0, 0, DM}; pg8::MoeOrder<true> S; S.init(nt, 2 * DFF / 256, F.G, (int)blockIdx.x, tiles + 16, tok_of_slot);
                pg8::EpiSwigluQ<true> E{HM, DFF, SAS, SW + SW_M13, nullptr};
                pg8::gemm_phase<pg8::EpiSwigluQ<true>, pg8::MoeOrder<true>, true, true, 2>(F.lds + RING_OFF, g, S, E, F.wave);
            }
            SEAM(ph); ++ph;
            if (KEEP(17) && IN(ph)) for (int rep_ = 0; rep_ < NREP(17); ++rep_) { PH_LOCALS; ODD_PTRS; MOE_PTRS;
                const int nt = tiles[0];
                pg8::Gemm g{(const bf16*)HM, (const bf16*)MW2, 0, 0, DFF}; pg8::MoeOrder<false> S; S.init(nt, DM / 256, F.G, (int)blockIdx.x, tiles + 16, nullptr);
                pg8::EpiMoeDown E{OUTB, DM, gate_of_slot, 1.f / W8_SCALE, nullptr};
                pg8::gemm_phase<pg8::EpiMoeDown, pg8::MoeOrder<false>, true, true, 1, true>(F.lds + RING_OFF, g, S, E, F.wave);
            }
            SEAM(ph); ++ph;
            if (KEEP(18) && IN(ph)) for (int rep_ = 0; rep_ < NREP(18); ++rep_) { PH_LOCALS; ODD_PTRS; MOE_PTRS;
                if (l == 3) ln_phase<1, false, true>(F, nullptr, XB, Y, INP(I_OLN2G) + li * DM, INP(I_OLN2B) + li * DM, OUTB, slot_of_tok, nullptr, nullptr, nullptr, nullptr, nullptr);
                else        ln_phase<1, false, false>(F, nullptr, XB, nullptr, INP(I_OLN2G) + li * DM, INP(I_OLN2B) + li * DM, OUTB, slot_of_tok, nullptr, nullptr, nullptr, nullptr, nullptr, XQ, SA);
                if (l + 1 < 4) { EVEN_PTRS;
                conv_q1024(F, QSet{INP(I_EWIN) + (size_t)(li + 1) * DM * EVEN_IN, EVEN_IN, (signed char*)WinT, SW + SW_EIN, INP(I_FW1) + (size_t)(li + 1) * DM * DFF, INP(I_FW3) + (size_t)(li + 1) * DM * DFF, 1, (signed char*)W13T, SW + SW_E13,
                                   INP(I_EWO) + (size_t)(li + 1) * DM * DM, (signed char*)WoT, SW + SW_EWO});
                const ConvJob J[1] = {
                    {INP(I_FW2) + (size_t)(li + 1) * DFF * DM, W2T, DFF, DM, 128, 0, (DFF / 64) * (DM / 32), W8_SCALE, nullptr, nullptr, 1}};
                conv_jobs<1>(F, J);
                { float* const PN = (float*)(act + A_PMAX) + (size_t)((l + 2) & 1) * PMAX_FLOATS;
                  conv_wo_max(F, INP(I_OWO) + (size_t)(li + 1) * 2 * DM * DM, PN + PM_WO); }
                const int tq = F.wave * 64 + lane_id_opaque();
                { const float* wsrc = INP(I_EWS) + (size_t)(li + 1) * 4 * 128 * 128;
                  for (int i = blockIdx.x * 512 + tq; i < 4 * 128 * 128; i += F.G * 512) { const int s = i & 127, t = (i >> 7) & 127; Wsb[i] = (bf16)f2bf(s <= t ? wsrc[i] : 0.f); } }
                }
            }
            SEAM(ph); ++ph;
        }
    }
#undef IN
#undef SEAM
#undef PH_LOCALS
#undef INP
#undef MOE_PTRS
#undef EVEN_PTRS
#undef ODD_PTRS
}

extern "C" void kernel_launch(void* const* d_in, const int* in_sizes, int n_in, void* d_out, int out_size, void* d_ws, size_t ws_size, hipStream_t stream) {
    static int grid = 0;
    if (grid == 0) {
        if (n_in != 31 || in_sizes[0] != M * DM || out_size != M * DM || ws_size < WS_END) { fprintf(stderr, "kernel_launch: unexpected shapes (n_in %d, in0 %d, out %d, ws %zu < %zu); nothing launched\n", n_in, n_in > 0 ? in_sizes[0] : -1, out_size, ws_size, (size_t)WS_END); grid = -1; return; }
        int dev = 0, cus = 0, per_cu = 0;
        if (hipGetDevice(&dev) != hipSuccess || hipDeviceGetAttribute(&cus, hipDeviceAttributeMultiprocessorCount, dev) != hipSuccess) { grid = -1; return; }
        if (hipFuncSetAttribute((const void*)mk_fwd, hipFuncAttributeMaxDynamicSharedMemorySize, LDS_BYTES) != hipSuccess) { fprintf(stderr, "kernel_launch: hipFuncSetAttribute failed\n"); grid = -1; return; }
        if (hipOccupancyMaxActiveBlocksPerMultiprocessor(&per_cu, (const void*)mk_fwd, NWAVES * 64, LDS_BYTES) != hipSuccess || per_cu < 1) { fprintf(stderr, "kernel_launch: occupancy query says %d workgroups per CU\n", per_cu); }
        (void)hipGetLastError();
        grid = cus;
        if (grid != 256) { fprintf(stderr, "kernel_launch: built for a 256-CU device, found %d CUs; nothing launched\n", cus); grid = -1; return; }
    }
    if (grid < 0) return;
    if (hipMemsetAsync((char*)d_ws + WS_CTL, 0, CTL_ZERO_BYTES, stream) != hipSuccess) return;
    Args a{};
    for (int i = 0; i < 31; ++i) a.in[i] = (const float*)d_in[i];
    a.out = (float*)d_out; a.ws = (unsigned char*)d_ws;
#if MK_ONE_LAUNCH
    a.ph_lo = 0; a.ph_hi = PH_TOTAL;
    hipLaunchKernelGGL(mk_fwd, dim3(grid), dim3(NWAVES * 64), LDS_BYTES, stream, a);
#else
#ifndef DUP_N_MASK
#define DUP_N_MASK 0
#endif
    for (int p = 0; p < PH_TOTAL; ++p) { const int q = p == 0 ? 0 : (p - 1) % (PH_EVEN + PH_ODD); const int n = p == 0 ? 0 : (q < PH_EVEN ? q + 1 : 10 + (q - PH_EVEN));
        const int reps = ((DUP_N_MASK >> n) & 1) ? 2 : 1;
        for (int r = 0; r < reps; ++r) { a.ph_lo = p; a.ph_hi = p + 1;
#ifdef DUP_VARIANT
            a.pad0 = (reps == 2 && r == 0) ? DUP_VARIANT : 0;
#endif
            hipLaunchKernelGGL(mk_fwd, dim3(grid), dim3(NWAVES * 64), LDS_BYTES, stream, a); } }
#endif
}
```
